# Optimizing an MI355X kernel written in HIP

```python
import math
import jax
import jax.numpy as jnp
from jax import lax
import numpy as np

D_MODEL = 1024
BATCH = 8
SEQ = 2048
DEPTH = 2

CTX_LEN = 256
GRID_W = 64
EPS = 1e-6
N_MOD = 6

SSD_HEADS = 16
SSD_HEAD_DIM = 64
SSD_WIDTH = SSD_HEADS * SSD_HEAD_DIM
SSD_GROUPS = 4
SSD_STATE = 128
SSD_CONV = 3
SSD_CHUNK = 128
SSD_BC_WIDTH = SSD_GROUPS * SSD_STATE
SSD_CONV_CH = SSD_WIDTH + 2 * SSD_BC_WIDTH
SSD_DT_MIN = 1e-3
SSD_DT_MAX = 1e-1

ATT_HEADS = 8
ATT_HEAD_DIM = 64
ATT_V_DIM = 2 * ATT_HEAD_DIM
ATT_QK_WIDTH = ATT_HEADS * 2 * ATT_HEAD_DIM
ATT_WIDTH = ATT_HEADS * ATT_V_DIM
ATT_SCALE = ATT_HEAD_DIM ** -0.5
Q_BLOCK = 128
ROPE_BASE = 10000.0
ROPE_PAIRS = ATT_HEAD_DIM // 4

N_BRANCH = 2
D_FF = 2816
FFN_CONV = 3

IN_SIZES = (SSD_WIDTH, SSD_CONV_CH, 2 * SSD_HEADS, ATT_QK_WIDTH, ATT_QK_WIDTH, ATT_WIDTH, N_BRANCH * D_MODEL)
IN_WIDTH = SSD_WIDTH + SSD_CONV_CH + 2 * SSD_HEADS + 2 * ATT_QK_WIDTH + ATT_WIDTH + N_BRANCH * D_MODEL

kernel_name = 'hybrid_ssd_diffattn_dit_block'


def rmsnorm(x, w):
    xf = x.astype(jnp.float32)
    y = xf * lax.rsqrt(jnp.mean(xf * xf, axis=-1, keepdims=True) + EPS)
    return (y * w.astype(jnp.float32)).astype(x.dtype)


def modulate(h, shift, scale):
    return h * (1.0 + scale) + shift


def dwconv_centred(x, w, b):
    k_w = w.shape[0]
    pad = k_w // 2
    n = x.shape[1]
    xp = jnp.pad(x, ((0, 0), (pad, pad), (0, 0)))
    y = xp[:, 0:n] * w[0]
    for k in range(1, k_w):
        y = y + xp[:, k:k + n] * w[k]
    return y + b


def split_in(u):
    points = []
    acc = 0
    for s in IN_SIZES[:-1]:
        acc += s
        points.append(acc)
    return jnp.split(u, points, axis=-1)


def segsum(a):
    t = a.shape[-1]
    cs = jnp.cumsum(a, axis=-1)
    diff = cs[..., :, None] - cs[..., None, :]
    mask = jnp.tril(jnp.ones((t, t), dtype=bool))
    return jnp.where(mask, diff, -jnp.inf)


def ssd_scan(xs, dt, a_head, b_mat, c_mat, h0):
    bsz, n, n_heads, p = xs.shape
    g, s_dim = b_mat.shape[-2:]
    r = n_heads // g
    nc = n // SSD_CHUNK
    xd = (xs * dt[..., None]).reshape(bsz, nc, SSD_CHUNK, g, r, p)
    a = (dt * a_head).reshape(bsz, nc, SSD_CHUNK, g, r).transpose(0, 3, 4, 1, 2)
    a_cs = jnp.cumsum(a, axis=-1)
    bc = b_mat.reshape(bsz, nc, SSD_CHUNK, g, s_dim)
    cc = c_mat.reshape(bsz, nc, SSD_CHUNK, g, s_dim)
    cb = jnp.einsum('bclgn,bcsgn->bgcls', cc, bc)
    decay_in = jnp.exp(segsum(a))
    y_diag = jnp.einsum('bgcls,bgrcls,bcsgrp->bclgrp', cb, decay_in, xd)
    decay_to_end = jnp.exp(a_cs[..., -1:] - a_cs)
    states = jnp.einsum('bclgn,bgrcl,bclgrp->bcgrpn', bc, decay_to_end, xd)
    states = jnp.concatenate([h0.reshape(bsz, 1, g, r, p, s_dim).astype(states.dtype), states], axis=1)
    chunk_tot = jnp.pad(a_cs[..., -1], ((0, 0), (0, 0), (0, 0), (1, 0)))
    decay_chunk = jnp.exp(segsum(chunk_tot))
    states = jnp.einsum('bgrzc,bcgrpn->bzgrpn', decay_chunk, states)
    h_in, h_last = states[:, :-1], states[:, -1]
    y_off = jnp.einsum('bclgn,bcgrpn,bgrcl->bclgrp', cc, h_in, jnp.exp(a_cs))
    y = (y_diag + y_off).reshape(bsz, n, n_heads, p)
    return y, h_last.reshape(bsz, n_heads, p, s_dim)


def ssd_branch(xbc_l, dt_raw_l, z_l, xbc_c, dt_raw_c, z_c, conv_w, conv_b, a_log, dt_bias, d_skip, norm_w, with_ctx):
    a_dir = -jnp.exp(a_log.astype(jnp.float32))
    dt_b = dt_bias.astype(jnp.float32)

    def prep(xbc, dt_raw):
        bsz, n, _ = xbc.shape
        xbc = jax.nn.silu(dwconv_centred(xbc, conv_w, conv_b))
        xs, b_mat, c_mat = jnp.split(xbc, [SSD_WIDTH, SSD_WIDTH + SSD_BC_WIDTH], axis=-1)
        xs = xs.reshape(bsz, n, SSD_HEADS, SSD_HEAD_DIM)
        b_mat = b_mat.reshape(bsz, n, SSD_GROUPS, SSD_STATE)
        c_mat = c_mat.reshape(bsz, n, SSD_GROUPS, SSD_STATE)
        dt = jax.nn.softplus(dt_raw.astype(jnp.float32).reshape(bsz, n, 2, SSD_HEADS) + dt_b)
        return xs, b_mat, c_mat, dt

    def flip(t):
        return jnp.flip(t, axis=1)

    xs_c, b_c, c_c, dt_c = prep(xbc_c, dt_raw_c)
    xs_l, b_l, c_l, dt_l = prep(xbc_l, dt_raw_l)
    bsz = xs_l.shape[0]
    h0 = jnp.zeros((bsz, SSD_HEADS, SSD_HEAD_DIM, SSD_STATE), jnp.float32)
    yf_c, hf_c = ssd_scan(xs_c, dt_c[:, :, 0], a_dir[0], b_c, c_c, h0)
    yb_c, hb_c = ssd_scan(flip(xs_c), flip(dt_c[:, :, 1]), a_dir[1], flip(b_c), flip(c_c), h0)
    yf_l, _ = ssd_scan(xs_l, dt_l[:, :, 0], a_dir[0], b_l, c_l, hf_c)
    yb_l, _ = ssd_scan(flip(xs_l), flip(dt_l[:, :, 1]), a_dir[1], flip(b_l), flip(c_l), hb_c)

    def readout(xs, yf, yb_rev, z):
        bsz_, n, _, _ = xs.shape
        y = yf + flip(yb_rev) + d_skip.astype(jnp.float32)[:, None] * xs
        y = y.reshape(bsz_, n, SSD_WIDTH).astype(z.dtype) * jax.nn.silu(z)
        return rmsnorm(y, norm_w)

    y_l = readout(xs_l, yf_l, yb_l, z_l)
    y_c = readout(xs_c, yf_c, yb_c, z_c) if with_ctx else None
    return y_l, y_c


def rope_2d_tables(n_tokens):
    rows = n_tokens // GRID_W
    inv_freq = ROPE_BASE ** (-jnp.arange(ROPE_PAIRS, dtype=jnp.float32) / ROPE_PAIRS)
    row_pos = jnp.arange(rows, dtype=jnp.float32)
    col_pos = jnp.arange(GRID_W, dtype=jnp.float32)
    ang_r = jnp.broadcast_to(row_pos[:, None, None] * inv_freq, (rows, GRID_W, ROPE_PAIRS))
    ang_c = jnp.broadcast_to(col_pos[None, :, None] * inv_freq, (rows, GRID_W, ROPE_PAIRS))
    ang = jnp.stack([ang_r, ang_c], axis=2).reshape(n_tokens, 2, ROPE_PAIRS)
    return jnp.cos(ang), jnp.sin(ang)


def apply_rope_2d(x, cos, sin):
    xs = x.astype(jnp.float32).reshape(*x.shape[:-1], 2, 2, ROPE_PAIRS)
    x1, x2 = xs[..., 0, :], xs[..., 1, :]
    c = cos[None, :, None, None]
    s = sin[None, :, None, None]
    out = jnp.stack([x1 * c - x2 * s, x2 * c + x1 * s], axis=-2)
    return out.reshape(x.shape).astype(x.dtype)


def diff_softmax_attend(q, k, v, lam):
    s = jnp.einsum('bqhcd,bkhcd->bhcqk', q, k).astype(jnp.float32) * ATT_SCALE
    p = jax.nn.softmax(s, axis=-1)
    p_diff = p[:, :, 0] - lam * p[:, :, 1]
    return jnp.einsum('bhqk,bkhe->bqhe', p_diff.astype(v.dtype), v)


def diff_attn_branch(q_l, k_l, v_l, q_c, k_c, v_c, cos, sin, lambdas, subln_w, layer_idx, with_ctx):
    bsz, n, _ = q_l.shape
    n_ctx = q_c.shape[1]
    lam_init = 0.8 - 0.6 * math.exp(-0.3 * layer_idx)
    lf = lambdas.astype(jnp.float32)
    lam = jnp.exp(jnp.sum(lf[0] * lf[1])) - jnp.exp(jnp.sum(lf[2] * lf[3])) + lam_init
    qk_shape = (ATT_HEADS, 2, ATT_HEAD_DIM)
    q_l = apply_rope_2d(q_l.reshape(bsz, n, *qk_shape), cos, sin)
    k_l = apply_rope_2d(k_l.reshape(bsz, n, *qk_shape), cos, sin)
    v_l = v_l.reshape(bsz, n, ATT_HEADS, ATT_V_DIM)
    q_c = q_c.reshape(bsz, n_ctx, *qk_shape)
    k_c = k_c.reshape(bsz, n_ctx, *qk_shape)
    v_c = v_c.reshape(bsz, n_ctx, ATT_HEADS, ATT_V_DIM)
    k_all = jnp.concatenate([k_c, k_l], axis=1)
    v_all = jnp.concatenate([v_c, v_l], axis=1)
    nb = n // Q_BLOCK
    q_blocks = q_l.reshape(bsz, nb, Q_BLOCK, *qk_shape).swapaxes(0, 1)
    o_l = lax.map(lambda qb: diff_softmax_attend(qb, k_all, v_all, lam), q_blocks)
    o_l = o_l.swapaxes(0, 1).reshape(bsz, n, ATT_HEADS, ATT_V_DIM)

    def readout(o):
        return (rmsnorm(o, subln_w) * (1.0 - lam_init)).reshape(o.shape[0], o.shape[1], ATT_WIDTH)

    y_l = readout(o_l)
    y_c = readout(diff_softmax_attend(q_c, k_c, v_c, lam)) if with_ctx else None
    return y_l, y_c


def branch_merge(y_s, y_a, gates, w_br_s, w_br_a, w_o):
    g_s, g_a = jnp.split(jax.nn.sigmoid(gates), N_BRANCH, axis=-1)
    return (g_s * (y_s @ w_br_s) + g_a * (y_a @ w_br_a)) @ w_o


def conv_ffn(h, w_u, conv_w, conv_b, w_d):
    u = dwconv_centred(h @ w_u, conv_w, conv_b)
    a, v = jnp.split(u, 2, axis=-1)
    return (jax.nn.silu(a) * v) @ w_d


def setup_inputs(seed: int = 0) -> dict:
    key = jax.random.key(seed)
    ks = jax.random.split(key, 26)
    f32 = jnp.float32

    def nrm(k, shape, scale):
        return jax.random.normal(k, shape, f32) * scale

    x = nrm(ks[0], (BATCH, SEQ, D_MODEL), 1.0)
    c = nrm(ks[1], (BATCH, D_MODEL), 1.0)
    ctx = nrm(ks[2], (BATCH, CTX_LEN, D_MODEL), 1.0)
    c_ctx = nrm(ks[3], (D_MODEL,), 1.0)
    w_mod = nrm(ks[4], (DEPTH, D_MODEL, N_MOD * D_MODEL), 0.5 * D_MODEL ** -0.5)
    b_mod = nrm(ks[5], (DEPTH, N_MOD * D_MODEL), 0.02)
    norm1_w = 1.0 + nrm(ks[6], (DEPTH, D_MODEL), 0.02)
    w_in = nrm(ks[7], (DEPTH, D_MODEL, IN_WIDTH), D_MODEL ** -0.5)
    ssd_conv_w = nrm(ks[8], (DEPTH, SSD_CONV, SSD_CONV_CH), SSD_CONV ** -0.5)
    ssd_conv_b = nrm(ks[9], (DEPTH, SSD_CONV_CH), 0.02)
    ssd_a_log = jnp.log(jax.random.uniform(ks[10], (DEPTH, 2, SSD_HEADS), f32, 1.0, 16.0))
    u_dt = jax.random.uniform(ks[11], (DEPTH, 2, SSD_HEADS), f32)
    dt0 = jnp.exp(u_dt * (math.log(SSD_DT_MAX) - math.log(SSD_DT_MIN)) + math.log(SSD_DT_MIN))
    ssd_dt_bias = dt0 + jnp.log(-jnp.expm1(-dt0))
    ssd_d = 1.0 + nrm(ks[12], (DEPTH, SSD_HEADS), 0.1)
    ssd_norm_w = 1.0 + nrm(ks[13], (DEPTH, SSD_WIDTH), 0.02)
    diff_lambda = nrm(ks[14], (DEPTH, 4, ATT_HEAD_DIM), 0.1)
    att_subln_w = 1.0 + nrm(ks[15], (DEPTH, ATT_V_DIM), 0.02)
    w_br_ssd = nrm(ks[16], (DEPTH, SSD_WIDTH, D_MODEL), SSD_WIDTH ** -0.5)
    w_br_att = nrm(ks[17], (DEPTH, ATT_WIDTH, D_MODEL), ATT_WIDTH ** -0.5)
    w_out = nrm(ks[18], (DEPTH, D_MODEL, D_MODEL), D_MODEL ** -0.5)
    norm2_w = 1.0 + nrm(ks[19], (DEPTH, D_MODEL), 0.02)
    w_up = nrm(ks[20], (DEPTH, D_MODEL, 2 * D_FF), D_MODEL ** -0.5)
    ffn_conv_w = nrm(ks[21], (DEPTH, FFN_CONV, 2 * D_FF), FFN_CONV ** -0.5)
    ffn_conv_b = nrm(ks[22], (DEPTH, 2 * D_FF), 0.02)
    w_down = nrm(ks[23], (DEPTH, D_FF, D_MODEL), D_FF ** -0.5)
    final_norm_w = 1.0 + nrm(ks[24], (D_MODEL,), 0.02)
    return {'x': x, 'c': c, 'ctx': ctx, 'c_ctx': c_ctx, 'w_mod': w_mod, 'b_mod': b_mod,
            'norm1_w': norm1_w, 'w_in': w_in, 'ssd_conv_w': ssd_conv_w, 'ssd_conv_b': ssd_conv_b,
            'ssd_a_log': ssd_a_log, 'ssd_dt_bias': ssd_dt_bias, 'ssd_d': ssd_d, 'ssd_norm_w': ssd_norm_w,
            'diff_lambda': diff_lambda, 'att_subln_w': att_subln_w, 'w_br_ssd': w_br_ssd,
            'w_br_att': w_br_att, 'w_out': w_out, 'norm2_w': norm2_w, 'w_up': w_up,
            'ffn_conv_w': ffn_conv_w, 'ffn_conv_b': ffn_conv_b, 'w_down': w_down,
            'final_norm_w': final_norm_w}


def reference(x, c, ctx, c_ctx, w_mod, b_mod, norm1_w, w_in, ssd_conv_w, ssd_conv_b, ssd_a_log,
              ssd_dt_bias, ssd_d, ssd_norm_w, diff_lambda, att_subln_w, w_br_ssd, w_br_att, w_out,
              norm2_w, w_up, ffn_conv_w, ffn_conv_b, w_down, final_norm_w):
    n = x.shape[1]
    cos, sin = rope_2d_tables(n)
    xl, xc = x, ctx
    for i in range(DEPTH):
        with_ctx = i < DEPTH - 1
        mod_l = (jax.nn.silu(c) @ w_mod[i] + b_mod[i])[:, None, :]
        mod_c = (jax.nn.silu(c_ctx) @ w_mod[i] + b_mod[i])[None, None, :]
        sh1_l, sc1_l, g1_l, sh2_l, sc2_l, g2_l = jnp.split(mod_l, N_MOD, axis=-1)
        sh1_c, sc1_c, g1_c, sh2_c, sc2_c, g2_c = jnp.split(mod_c, N_MOD, axis=-1)
        u_l = modulate(rmsnorm(xl, norm1_w[i]), sh1_l, sc1_l) @ w_in[i]
        u_c = modulate(rmsnorm(xc, norm1_w[i]), sh1_c, sc1_c) @ w_in[i]
        z_l, xbc_l, dt_l, q_l, k_l, v_l, gate_l = split_in(u_l)
        z_c, xbc_c, dt_c, q_c, k_c, v_c, gate_c = split_in(u_c)
        ys_l, ys_c = ssd_branch(xbc_l, dt_l, z_l, xbc_c, dt_c, z_c, ssd_conv_w[i], ssd_conv_b[i],
                                ssd_a_log[i], ssd_dt_bias[i], ssd_d[i], ssd_norm_w[i], with_ctx)
        ya_l, ya_c = diff_attn_branch(q_l, k_l, v_l, q_c, k_c, v_c, cos, sin, diff_lambda[i],
                                      att_subln_w[i], i, with_ctx)
        xl = xl + g1_l * branch_merge(ys_l, ya_l, gate_l, w_br_ssd[i], w_br_att[i], w_out[i])
        h_l = modulate(rmsnorm(xl, norm2_w[i]), sh2_l, sc2_l)
        xl = xl + g2_l * conv_ffn(h_l, w_up[i], ffn_conv_w[i], ffn_conv_b[i], w_down[i])
        if with_ctx:
            xc = xc + g1_c * branch_merge(ys_c, ya_c, gate_c, w_br_ssd[i], w_br_att[i], w_out[i])
            h_c = modulate(rmsnorm(xc, norm2_w[i]), sh2_c, sc2_c)
            xc = xc + g2_c * conv_ffn(h_c, w_up[i], ffn_conv_w[i], ffn_conv_b[i], w_down[i])
    return rmsnorm(xl, final_norm_w)
```

```cpp
#include <hip/hip_runtime.h>
#include <hip/hip_cooperative_groups.h>
#include <cstdio>
#include <cstdint>
namespace cg = cooperative_groups;

#define DI __device__ __forceinline__
typedef unsigned short bf16_t;
typedef short bf16x8 __attribute__((ext_vector_type(8)));
typedef float f32x4 __attribute__((ext_vector_type(4)));
typedef unsigned u32x4 __attribute__((ext_vector_type(4)));
typedef unsigned u32x2 __attribute__((ext_vector_type(2)));

constexpr int D = 1024, SEQ = 2048, CTXL = 256, DFF = 2816, DFF2 = 5632;
constexpr int NIN = 8224, NINP = 8448, USTR = 6144;
constexpr int LDS_HALF = 73728;
constexpr int LDS_BYTES = 2 * LDS_HALF + 32;
#define VHALF __builtin_amdgcn_readfirstlane((int)(threadIdx.x >> 8))
#define VB (VHALF * (int)gridDim.x + (int)blockIdx.x)
#define VG ((int)gridDim.x * 2)
constexpr float EPSN = 1e-6f;
constexpr int CONV_TILES = 9872;

struct Params {
  const float *x, *c, *ctx, *c_ctx, *w_mod, *b_mod, *norm1_w, *w_in, *ssd_conv_w, *ssd_conv_b, *a_log, *dt_bias,
      *ssd_d, *ssd_norm_w, *diff_lambda, *subln_w, *w_br_ssd, *w_br_att, *w_out, *norm2_w, *w_up, *ffn_conv_w,
      *ffn_conv_b, *w_down, *final_norm_w;
  float* out;
  bf16_t *wt_in, *wt_brs, *wt_bra, *wt_o, *wt_up, *wt_down;
  bf16_t *U, *KK, *VT, *H, *YS, *YA, *MG, *H2;
  float *DT, *ST, *DEC, *SSQ, *XC, *MODP, *MOD, *ROPE, *LAM, *CSB;
  unsigned* BAR;
  int nbg, pad;
};

typedef __bf16 bf16v2_t __attribute__((ext_vector_type(2)));
typedef float f32v2_t __attribute__((ext_vector_type(2)));
DI unsigned pack2(float a, float b) { f32v2_t v = {a, b}; bf16v2_t r = __builtin_convertvector(v, bf16v2_t); return __builtin_bit_cast(unsigned, r); }
DI bf16_t f2bf(float x) { return (bf16_t)(pack2(x, 0.f) & 0xffffu); }
DI float bf2f(bf16_t h) { return __uint_as_float(((unsigned)h) << 16); }
DI float lo_f(unsigned u) { return __uint_as_float(u << 16); }
DI float hi_f(unsigned u) { return __uint_as_float(u & 0xffff0000u); }
DI void unpack8(u32x4 v, float (&f)[8]) {
  f[0] = lo_f(v.x); f[1] = hi_f(v.x); f[2] = lo_f(v.y); f[3] = hi_f(v.y);
  f[4] = lo_f(v.z); f[5] = hi_f(v.z); f[6] = lo_f(v.w); f[7] = hi_f(v.w);
}
DI float silu_f(float x) { return x * __builtin_amdgcn_rcpf(1.f + __expf(-x)); }
DI float sigm_f(float x) { return __builtin_amdgcn_rcpf(1.f + __expf(-x)); }
DI float softplus_f(float x) { return x > 20.f ? x : log1pf(expf(x)); }
DI float shfl_idx(float v, int src_lane) { return __builtin_bit_cast(float, __builtin_amdgcn_ds_bpermute(src_lane << 2, __builtin_bit_cast(int, v))); }
#define LAS3 __attribute__((address_space(3)))
DI void half_sync(unsigned char* vlds, int tid) {
  __builtin_amdgcn_fence(__ATOMIC_RELEASE, "workgroup");
  if ((tid & 63) == 0) {
    LAS3 unsigned* cnt = (LAS3 unsigned*)((LAS3 unsigned char*)vlds + (VHALF ? (LDS_HALF + 20) : (2 * LDS_HALF + 16)));
    const unsigned old = __hip_atomic_fetch_add(cnt, 1u, __ATOMIC_RELAXED, __HIP_MEMORY_SCOPE_WORKGROUP);
    const unsigned target = (old & ~3u) + 4u;
    while ((int)(__hip_atomic_load(cnt, __ATOMIC_RELAXED, __HIP_MEMORY_SCOPE_WORKGROUP) - target) < 0) __builtin_amdgcn_s_sleep(0);
  }
  __builtin_amdgcn_fence(__ATOMIC_ACQUIRE, "workgroup");
}
#define HSYNC() half_sync(lds, tid)
#define MFMA16(a, b, c) __builtin_amdgcn_mfma_f32_16x16x32_bf16((a), (b), (c), 0, 0, 0)

DI const float* xin_row(const Params& p, int layer, int g, int r) {
  const int nl = p.nbg * SEQ;
  if (r < nl) return (layer == 0 ? p.x : p.out) + ((size_t)g * nl + r) * D;
  return (layer == 0 ? p.ctx : p.XC) + ((size_t)g * p.nbg * CTXL + (r - nl)) * D;
}
DI float* xout_row(const Params& p, int g, int r) {
  const int nl = p.nbg * SEQ;
  if (r < nl) return p.out + ((size_t)g * nl + r) * D;
  return p.XC + ((size_t)g * p.nbg * CTXL + (r - nl)) * D;
}
DI int mod_row(const Params& p, int g, int r) {
  const int nl = p.nbg * SEQ;
  return r < nl ? g * p.nbg + r / SEQ : 8;
}

DI int xcd_lin(int round) {
  const int chunk = gridDim.x >> 3;
  return (round * 8 + (blockIdx.x & 7)) * chunk + (blockIdx.x >> 3);
}
DI void tile_map(int t, int MT, int NT, int& mt, int& nt) {
  const int fb = NT >> 3, rem = NT & 7, full = fb * 8 * MT;
  if (t < full) { const int band = t / (8 * MT), r = t - band * 8 * MT; mt = r >> 3; nt = band * 8 + (r & 7); }
  else { const int r = t - full; mt = r / rem; nt = fb * 8 + r % rem; }
}

template <int NI>
DI void gemm_mainloop(const bf16_t* __restrict__ A, int lda, const bf16_t* __restrict__ B, int ldb, int K,
                      f32x4 (&acc)[NI][4], unsigned char* lds, int tid) {
  bf16_t* sA = (bf16_t*)lds;
  bf16_t* sB = (bf16_t*)(lds + 32768);
  const int lane = tid & 63, w = tid >> 6, wm = w & 1, wn = w >> 1, l15 = lane & 15, quad = lane >> 4;
  u32x4 ra0[4], rb0[NI], ra1[4], rb1[NI];
  const int nk = K >> 6;
  const int srow = tid >> 3, skc = (tid & 7) * 8;
  const bf16_t* Ap = A + (size_t)srow * lda + skc;
  const bf16_t* Bp = B + (size_t)srow * ldb + skc;
  const int soff = srow * 64 + (((tid & 7) ^ (srow & 7)) * 8);
  const int sw7 = l15 & 7;
#define G_LOAD(RA, RB, KT)                                                              \
  _Pragma("unroll") for (int r = 0; r < 4; ++r) {                                       \
    RA[r] = *(const u32x4*)(Ap + (size_t)(32 * r) * lda + (KT) * 64);                   \
    if (r < NI) RB[r] = *(const u32x4*)(Bp + (size_t)(32 * r) * ldb + (KT) * 64);       \
  }
#define G_STORE(RA, RB, BUF)                                                            \
  _Pragma("unroll") for (int r = 0; r < 4; ++r) {                                       \
    *(u32x4*)(sA + (BUF) * 8192 + soff + 32 * r * 64) = RA[r];                          \
    if (r < NI) *(u32x4*)(sB + (BUF) * 8192 + soff + 32 * r * 64) = RB[r];              \
  }
#define G_COMPUTE(BUF)                                                                  \
  {                                                                                     \
    const bf16_t* cA = sA + (BUF) * 8192;                                               \
    const bf16_t* cB = sB + (BUF) * 8192;                                               \
    _Pragma("unroll") for (int ks = 0; ks < 2; ++ks) {                                  \
      bf16x8 af[NI], bfr[4];                                                            \
      _Pragma("unroll") for (int i = 0; i < NI; ++i)                                    \
        af[i] = *(const bf16x8*)(cB + (wn * (NI * 16) + i * 16 + l15) * 64 + (((ks * 4 + quad) ^ sw7) * 8)); \
      _Pragma("unroll") for (int j = 0; j < 4; ++j)                                     \
        bfr[j] = *(const bf16x8*)(cA + (wm * 64 + j * 16 + l15) * 64 + (((ks * 4 + quad) ^ sw7) * 8)); \
      _Pragma("unroll") for (int i = 0; i < NI; ++i)                                    \
        _Pragma("unroll") for (int j = 0; j < 4; ++j) acc[i][j] = MFMA16(af[i], bfr[j], acc[i][j]); \
    }                                                                                   \
  }
  G_LOAD(ra0, rb0, 0);
  if (nk > 1) { G_LOAD(ra1, rb1, 1); }
  G_STORE(ra0, rb0, 0);
  __syncthreads();
  for (int kt = 0; kt < nk; kt += 2) {
    if (kt + 2 < nk) { G_LOAD(ra0, rb0, kt + 2); }
    G_COMPUTE(0);
    if (kt + 1 < nk) { G_STORE(ra1, rb1, 1); }
    __syncthreads();
    if (kt + 1 < nk) {
      if (kt + 3 < nk) { G_LOAD(ra1, rb1, kt + 3); }
      G_COMPUTE(1);
      if (kt + 2 < nk) { G_STORE(ra0, rb0, 0); }
      __syncthreads();
    }
  }
#undef G_LOAD
#undef G_STORE
#undef G_COMPUTE
}

template <int NI>
DI void zero_acc(f32x4 (&acc)[NI][4]) {
#pragma unroll
  for (int i = 0; i < NI; ++i)
#pragma unroll
    for (int j = 0; j < 4; ++j) acc[i][j] = (f32x4){0.f, 0.f, 0.f, 0.f};
}

DI void phase0(const Params& p, unsigned char* lds, int tid) {
  if (VB == 0) {
    for (int idx = tid; idx < 1024; idx += 256) {
      const int pos = idx >> 4, f = idx & 15;
      const float inv = powf(10000.f, -(float)f / 16.f);
      const float ang = (float)pos * inv;
      p.ROPE[idx * 2] = cosf(ang);
      p.ROPE[idx * 2 + 1] = sinf(ang);
    }
    if (tid < 2) {
      const float* lf = p.diff_lambda + tid * 256;
      float s1 = 0.f, s2 = 0.f;
      for (int i = 0; i < 64; ++i) { s1 += lf[i] * lf[64 + i]; s2 += lf[128 + i] * lf[192 + i]; }
      const float lam_init = 0.8f - 0.6f * expf(-0.3f * (float)tid);
      p.LAM[tid * 2] = expf(s1) - expf(s2) + lam_init;
      p.LAM[tid * 2 + 1] = 1.f - lam_init;
    }
  }
  {
    const u32x4 z = {0u, 0u, 0u, 0u};
    for (int i = VB * 256 + tid; i < 2 * 28672; i += VG * 256) {
      const int layer = i / 28672, e = i % 28672;
      *(u32x4*)(p.wt_in + (size_t)layer * NINP * D + (size_t)NIN * D + (size_t)e * 8) = z;
    }
  }
  float* sc = (float*)lds;
  for (int item = VB; item < 384; item += VG) {
    const int l = item / 192, rem = item % 192, nc = rem >> 3, kc = rem & 7;
    for (int idx = tid; idx < 1152; idx += 256) {
      const int r = idx >> 7, k = idx & 127;
      const float cv = r < 8 ? p.c[r * D + kc * 128 + k] : p.c_ctx[kc * 128 + k];
      sc[idx] = cv / (1.f + expf(-cv));
    }
    HSYNC();
    float a0 = 0, a1 = 0, a2 = 0, a3 = 0, a4 = 0, a5 = 0, a6 = 0, a7 = 0, a8 = 0;
    const int n = nc * 256 + tid;
    const float* wp = p.w_mod + ((size_t)l * D + kc * 128) * 6144 + n;
#pragma unroll 8
    for (int k = 0; k < 128; ++k) {
      const float wv = wp[(size_t)k * 6144];
      a0 += sc[k] * wv; a1 += sc[128 + k] * wv; a2 += sc[256 + k] * wv; a3 += sc[384 + k] * wv; a4 += sc[512 + k] * wv;
      a5 += sc[640 + k] * wv; a6 += sc[768 + k] * wv; a7 += sc[896 + k] * wv; a8 += sc[1024 + k] * wv;
    }
    float* op = p.MODP + ((size_t)(kc * 2 + l) * 9) * 6144 + n;
    op[0] = a0; op[6144] = a1; op[2 * 6144] = a2; op[3 * 6144] = a3; op[4 * 6144] = a4;
    op[5 * 6144] = a5; op[6 * 6144] = a6; op[7 * 6144] = a7; op[8 * 6144] = a8;
    HSYNC();
  }
  float* tile = (float*)lds;
  for (int item = VB; item < 2 * CONV_TILES; item += VG) {
    const int layer = item / CONV_TILES;
    int t = item % CONV_TILES;
    const float* src; bf16_t* dst; const float* scale = nullptr; int ld, sc0, dr0, ncols, K;
    if (t < 4112) {
      src = p.w_in + (size_t)layer * D * NIN; dst = p.wt_in + (size_t)layer * NINP * D; ld = NIN; K = D;
      if (t < 1536) { sc0 = 0; dr0 = 0; ncols = 3072; }
      else if (t < 3072) { t -= 1536; sc0 = 3104; dr0 = 3072; ncols = 3072; }
      else if (t < 4096) { t -= 3072; sc0 = 6176; dr0 = 6144; ncols = 2048; }
      else { t -= 4096; sc0 = 3072; dr0 = 8192; ncols = 32; }
    } else if (t < 4112 + 1536) {
      t -= 4112; const int which = t >> 9; t &= 511;
      ld = D; K = D; sc0 = 0; dr0 = 0; ncols = D;
      if (which == 0) { src = p.w_br_ssd + (size_t)layer * D * D; dst = p.wt_brs + (size_t)layer * D * D; scale = p.ssd_norm_w + layer * D; }
      else if (which == 1) { src = p.w_br_att + (size_t)layer * D * D; dst = p.wt_bra + (size_t)layer * D * D; }
      else { src = p.w_out + (size_t)layer * D * D; dst = p.wt_o + (size_t)layer * D * D; }
    } else if (t < 4112 + 1536 + 2816) {
      t -= 4112 + 1536;
      src = p.w_up + (size_t)layer * D * DFF2; dst = p.wt_up + (size_t)layer * DFF2 * D; ld = DFF2; K = D; sc0 = 0; dr0 = 0; ncols = DFF2;
    } else {
      t -= 4112 + 1536 + 2816;
      src = p.w_down + (size_t)layer * DFF * D; dst = p.wt_down + (size_t)layer * D * DFF; ld = D; K = DFF; sc0 = 0; dr0 = 0; ncols = D;
    }
    const int nct = ncols >> 5;
    const int tn = t % nct, tk = t / nct;
    const int k0 = tk * 64, n0 = tn * 32;
#pragma unroll
    for (int i = 0; i < 2; ++i) {
      const int kk = (tid >> 3) + 32 * i, n4 = (tid & 7) * 4;
      f32x4 v = *(const f32x4*)(src + (size_t)(k0 + kk) * ld + sc0 + n0 + n4);
      if (scale) { const float sv = scale[k0 + kk]; v[0] *= sv; v[1] *= sv; v[2] *= sv; v[3] *= sv; }
      tile[kk * 33 + n4] = v[0]; tile[kk * 33 + n4 + 1] = v[1]; tile[kk * 33 + n4 + 2] = v[2]; tile[kk * 33 + n4 + 3] = v[3];
    }
    HSYNC();
    {
      const int nn = tid >> 3, k8 = (tid & 7) * 8;
      const float* tp = tile + k8 * 33 + nn;
      u32x4 pk = {pack2(tp[0], tp[33]), pack2(tp[66], tp[99]), pack2(tp[132], tp[165]), pack2(tp[198], tp[231])};
      *(u32x4*)(dst + (size_t)(dr0 + n0 + nn) * K + k0 + k8) = pk;
    }
    HSYNC();
  }
}

DI void phase0b(const Params& p, int tid) {
  for (int i = VB * 256 + tid; i < 2 * 9 * 6144; i += VG * 256) {
    const int n = i % 6144, lr = i / 6144, l = lr / 9, r = lr % 9;
    float s = p.b_mod[l * 6144 + n];
#pragma unroll
    for (int kc = 0; kc < 8; ++kc) s += p.MODP[((size_t)(kc * 2 + l) * 9 + r) * 6144 + n];
    p.MOD[i] = s;
  }
}

DI void norm_phase(const Params& p, int layer, int g, int which, int nrows, bf16_t* Hdst, int sub_idx, int sub_cnt, int tid) {
  const int lane = tid & 63, w = __builtin_amdgcn_readfirstlane(tid >> 6);
  const float* nw = (which == 0 ? p.norm1_w : p.norm2_w) + layer * D;
  bf16_t* __restrict__ Hout = Hdst;
  int r = sub_idx * 4 + w;
  f32x4 v[4];
  if (r < nrows) {
    const float* src = which == 0 ? xin_row(p, layer, g, r) : xout_row(p, g, r);
#pragma unroll
    for (int i = 0; i < 4; ++i) v[i] = *(const f32x4*)(src + lane * 4 + 256 * i);
  }
  while (r < nrows) {
    const int rn = r + sub_cnt * 4;
    f32x4 vn[4];
    if (rn < nrows) {
      const float* srcn = which == 0 ? xin_row(p, layer, g, rn) : xout_row(p, g, rn);
#pragma unroll
      for (int i = 0; i < 4; ++i) vn[i] = *(const f32x4*)(srcn + lane * 4 + 256 * i);
    }
    const float* mod = p.MOD + (size_t)(layer * 9 + mod_row(p, g, r)) * 6144 + (which ? 3072 : 0);
    f32x4 wv[4], sh[4], scv[4];
#pragma unroll
    for (int i = 0; i < 4; ++i) {
      const int col = lane * 4 + 256 * i;
      wv[i] = *(const f32x4*)(nw + col); sh[i] = *(const f32x4*)(mod + col); scv[i] = *(const f32x4*)(mod + 1024 + col);
    }
    float ss = 0.f;
#pragma unroll
    for (int i = 0; i < 4; ++i) ss += v[i][0] * v[i][0] + v[i][1] * v[i][1] + v[i][2] * v[i][2] + v[i][3] * v[i][3];
#pragma unroll
    for (int o = 32; o > 0; o >>= 1) ss += shfl_idx(ss, lane ^ o);
    const float rstd = rsqrtf(ss * (1.f / D) + EPSN);
#pragma unroll
    for (int i = 0; i < 4; ++i) {
      const int col = lane * 4 + 256 * i;
      float o0 = v[i][0] * rstd * wv[i][0] * (1.f + scv[i][0]) + sh[i][0];
      float o1 = v[i][1] * rstd * wv[i][1] * (1.f + scv[i][1]) + sh[i][1];
      float o2 = v[i][2] * rstd * wv[i][2] * (1.f + scv[i][2]) + sh[i][2];
      float o3 = v[i][3] * rstd * wv[i][3] * (1.f + scv[i][3]) + sh[i][3];
      u32x2 pk = {pack2(o0, o1), pack2(o2, o3)};
      *(u32x2*)(Hout + (size_t)r * D + col) = pk;
    }
#pragma unroll
    for (int i = 0; i < 4; ++i) v[i] = vn[i];
    r = rn;
  }
}


DI void conv_silu8(const bf16_t* __restrict__ Up, bool hp, bool hn, const float* __restrict__ cw, const float* __restrict__ cb,
                   int ci, float (&o)[8]) {
  const u32x4 z4 = {0u, 0u, 0u, 0u};
  const u32x4 cur = *(const u32x4*)Up;
  const u32x4 prv = hp ? *(const u32x4*)(Up - USTR) : z4;
  const u32x4 nxt = hn ? *(const u32x4*)(Up + USTR) : z4;
  float c[8], pv[8], nx[8];
  unpack8(cur, c); unpack8(prv, pv); unpack8(nxt, nx);
  const f32x4 w0a = *(const f32x4*)(cw + ci), w0b = *(const f32x4*)(cw + ci + 4);
  const f32x4 w1a = *(const f32x4*)(cw + 2048 + ci), w1b = *(const f32x4*)(cw + 2048 + ci + 4);
  const f32x4 w2a = *(const f32x4*)(cw + 4096 + ci), w2b = *(const f32x4*)(cw + 4096 + ci + 4);
  const f32x4 ba = *(const f32x4*)(cb + ci), bb = *(const f32x4*)(cb + ci + 4);
#pragma unroll
  for (int e = 0; e < 4; ++e) {
    const float xa = w0a[e] * pv[e] + w1a[e] * c[e] + w2a[e] * nx[e] + ba[e];
    const float xb = w0b[e] * pv[4 + e] + w1b[e] * c[4 + e] + w2b[e] * nx[4 + e] + bb[e];
    o[e] = silu_f(xa); o[4 + e] = silu_f(xb);
  }
}

DI int chunk_row0(const Params& p, int lb, int cid) {
  return cid < 2 ? p.nbg * SEQ + lb * CTXL + cid * 128 : lb * SEQ + (cid - 2) * 128;
}

DI void ssd_scan_prep(const Params& p, int layer, int row0, int h, float* fl, unsigned char* lds, int tid) {
  float* dtf = fl; float* dtb = fl + 128; float* csf = fl + 256; float* rsb = fl + 384;
  if (tid < 128) {
    const float rf = p.DT[(size_t)(row0 + tid) * 32 + h] + p.dt_bias[layer * 32 + h];
    const float rb = p.DT[(size_t)(row0 + tid) * 32 + 16 + h] + p.dt_bias[layer * 32 + 16 + h];
    dtf[tid] = softplus_f(rf); dtb[tid] = softplus_f(rb);
  }
  HSYNC();
  if (tid < 64) {
    const float Af = -expf(p.a_log[layer * 32 + h]), Ab = -expf(p.a_log[layer * 32 + 16 + h]);
    const float v0 = dtf[2 * tid] * Af, v1 = dtf[2 * tid + 1] * Af;
    const float s = v0 + v1;
    float inc = s;
#pragma unroll
    for (int o = 1; o < 64; o <<= 1) { const float t = shfl_idx(inc, tid >= o ? tid - o : tid); if (tid >= o) inc += t; }
    const float ex = inc - s;
    csf[2 * tid] = ex + v0; csf[2 * tid + 1] = ex + v0 + v1;
    const float w0 = dtb[2 * tid] * Ab, w1 = dtb[2 * tid + 1] * Ab;
    const float s2 = w0 + w1;
    float inc2 = s2;
#pragma unroll
    for (int o = 1; o < 64; o <<= 1) { const float t = shfl_idx(inc2, tid + o < 64 ? tid + o : tid); if (tid + o < 64) inc2 += t; }
    const float ex2 = inc2 - s2;
    rsb[2 * tid + 1] = ex2 + w1; rsb[2 * tid] = ex2 + w1 + w0;
  }
  HSYNC();
}

DI void ssd_state_item(const Params& p, int layer, int lb, int cid, int h, unsigned char* lds, int tid) {
  bf16_t* XfT = (bf16_t*)lds;
  bf16_t* XbT = (bf16_t*)(lds + 17408);
  bf16_t* BT = (bf16_t*)(lds + 34816);
  float* fl = (float*)(lds + 69632);
  const int lane = tid & 63, w = tid >> 6, l15 = lane & 15, quad = lane >> 4;
  const int row0 = chunk_row0(p, lb, cid);
  const int seqlen = cid < 2 ? CTXL : SEQ;
  const int t0 = cid < 2 ? cid * 128 : (cid - 2) * 128;
  const int grp = h >> 2;
  const float* cw = p.ssd_conv_w + layer * 3 * 2048;
  const float* cb = p.ssd_conv_b + layer * 2048;
  ssd_scan_prep(p, layer, row0, h, fl, lds, tid);
  if (tid < 128) *(f32x4*)(p.CSB + (size_t)((lb * 18 + cid) * 16 + h) * 512 + tid * 4) = *(const f32x4*)(fl + tid * 4);
  const float* dtf = fl; const float* dtb = fl + 128; const float* csf = fl + 256; const float* rsb = fl + 384;
  const float cf_end = csf[127], rb_0 = rsb[0];
#pragma unroll 4
  for (int r = 0; r < 4; ++r) {
    const int unit = tid + 256 * r, cgp = unit & 7, l = unit >> 3;
    const int ci = h * 64 + cgp * 8;
    float o[8];
    conv_silu8(p.U + (size_t)(row0 + l) * USTR + 1024 + ci, (t0 + l) > 0, (t0 + l) < seqlen - 1, cw, cb, ci, o);
    const float wf = __expf(cf_end - csf[l]) * dtf[l], wb = __expf(rb_0 - rsb[l]) * dtb[l];
#pragma unroll
    for (int e = 0; e < 8; ++e) {
      XfT[(cgp * 8 + e) * 136 + l] = f2bf(o[e] * wf);
      XbT[(cgp * 8 + e) * 136 + l] = f2bf(o[e] * wb);
    }
  }
#pragma unroll 4
  for (int r = 0; r < 8; ++r) {
    const int unit = tid + 256 * r, cgp = unit & 15, l = unit >> 4;
    const int ci = 1024 + grp * 128 + cgp * 8;
    float o[8];
    conv_silu8(p.U + (size_t)(row0 + l) * USTR + 1024 + ci, (t0 + l) > 0, (t0 + l) < seqlen - 1, cw, cb, ci, o);
#pragma unroll
    for (int e = 0; e < 8; ++e) BT[(cgp * 8 + e) * 136 + l] = f2bf(o[e]);
  }
  HSYNC();
  f32x4 acc[2][4][2];
#pragma unroll
  for (int d = 0; d < 2; ++d)
#pragma unroll
    for (int pt = 0; pt < 4; ++pt)
#pragma unroll
      for (int n2 = 0; n2 < 2; ++n2) acc[d][pt][n2] = (f32x4){0.f, 0.f, 0.f, 0.f};
#pragma unroll
  for (int ks = 0; ks < 4; ++ks) {
    bf16x8 bb[2];
#pragma unroll
    for (int n2 = 0; n2 < 2; ++n2) bb[n2] = *(const bf16x8*)(BT + ((2 * w + n2) * 16 + l15) * 136 + ks * 32 + quad * 8);
#pragma unroll
    for (int pt = 0; pt < 4; ++pt) {
      const bf16x8 af = *(const bf16x8*)(XfT + (pt * 16 + l15) * 136 + ks * 32 + quad * 8);
      const bf16x8 ab = *(const bf16x8*)(XbT + (pt * 16 + l15) * 136 + ks * 32 + quad * 8);
#pragma unroll
      for (int n2 = 0; n2 < 2; ++n2) {
        acc[0][pt][n2] = MFMA16(af, bb[n2], acc[0][pt][n2]);
        acc[1][pt][n2] = MFMA16(ab, bb[n2], acc[1][pt][n2]);
      }
    }
  }
#pragma unroll
  for (int d = 0; d < 2; ++d) {
    bf16_t* sp = (bf16_t*)p.ST + ((size_t)(((lb * 2 + d) * 16 + h) * 18 + cid)) * 8192;
#pragma unroll
    for (int pt = 0; pt < 4; ++pt)
#pragma unroll
      for (int n2 = 0; n2 < 2; ++n2)
#pragma unroll
        for (int reg = 0; reg < 4; ++reg)
          sp[(pt * 16 + quad * 4 + reg) * 128 + (2 * w + n2) * 16 + l15] = f2bf(acc[d][pt][n2][reg]);
  }
  if (tid == 0) {
    p.DEC[((lb * 2 + 0) * 16 + h) * 18 + cid] = expf(cf_end);
    p.DEC[((lb * 2 + 1) * 16 + h) * 18 + cid] = expf(rb_0);
  }
  HSYNC();
}

DI void attn_item(const Params& p, int layer, int lb, int h, int qb, bool is_ctx, unsigned char* lds, int tid) {
  bf16_t* Ks = (bf16_t*)lds;
  bf16_t* Vs = (bf16_t*)(lds + 34816);
  float* XB = (float*)lds;
  const int lane = tid & 63, w = tid >> 6, l15 = lane & 15, quad = lane >> 4;
  const int comp = w >> 1, qh = w & 1;
  const int nl = p.nbg * SEQ;
  const int ntiles = is_ctx ? 4 : 36;
  const int qrow0 = (is_ctx ? nl + lb * CTXL : lb * SEQ) + qb * 64;
  const bf16_t* KKp = p.KK + (size_t)(lb * 8 + h) * 2304 * 128;
  const bf16_t* VTp = p.VT + (size_t)(lb * 8 + h) * 128 * 2304;
  bf16x8 Qf[2][2];
#pragma unroll
  for (int qt = 0; qt < 2; ++qt)
#pragma unroll
    for (int ks = 0; ks < 2; ++ks)
      Qf[qt][ks] = *(const bf16x8*)(p.U + (size_t)(qrow0 + qh * 32 + qt * 16 + l15) * USTR + 3072 + h * 128 + comp * 64 + ks * 32 + quad * 8);
  f32x4 O[8][2];
#pragma unroll
  for (int et = 0; et < 8; ++et) { O[et][0] = (f32x4){0.f, 0.f, 0.f, 0.f}; O[et][1] = (f32x4){0.f, 0.f, 0.f, 0.f}; }
  float mrun[2] = {-1e30f, -1e30f}, lsum[2] = {0.f, 0.f};
  const float CS = 0.125f * 1.44269504088896f;
  u32x4 rk[4], rv[4];
#pragma unroll
  for (int r = 0; r < 4; ++r) {
    const int q = tid + 256 * r;
    rk[r] = *(const u32x4*)(KKp + (size_t)(q >> 4) * 128 + (q & 15) * 8);
    rv[r] = *(const u32x4*)(VTp + (size_t)(q >> 3) * 2304 + (q & 7) * 8);
  }
#pragma unroll
  for (int r = 0; r < 4; ++r) {
    const int q = tid + 256 * r;
    *(u32x4*)(Ks + (q >> 4) * 136 + (q & 15) * 8) = rk[r];
    *(u32x4*)(Vs + (q >> 3) * 72 + (q & 7) * 8) = rv[r];
  }
  HSYNC();
  for (int kt = 0; kt < ntiles; ++kt) {
    const int cur = kt & 1;
    if (kt + 1 < ntiles) {
#pragma unroll
      for (int r = 0; r < 4; ++r) {
        const int q = tid + 256 * r;
        rk[r] = *(const u32x4*)(KKp + (size_t)((kt + 1) * 64 + (q >> 4)) * 128 + (q & 15) * 8);
        rv[r] = *(const u32x4*)(VTp + (size_t)(q >> 3) * 2304 + (kt + 1) * 64 + (q & 7) * 8);
      }
    }
    const bf16_t* cK = Ks + cur * 8704;
    const bf16_t* cV = Vs + cur * 9216;
    f32x4 S[4][2];
#pragma unroll
    for (int t = 0; t < 4; ++t) { S[t][0] = (f32x4){0.f, 0.f, 0.f, 0.f}; S[t][1] = (f32x4){0.f, 0.f, 0.f, 0.f}; }
#pragma unroll
    for (int ks = 0; ks < 2; ++ks)
#pragma unroll
      for (int t = 0; t < 4; ++t) {
        const bf16x8 a = *(const bf16x8*)(cK + (t * 16 + l15) * 136 + comp * 64 + ks * 32 + quad * 8);
        S[t][0] = MFMA16(a, Qf[0][ks], S[t][0]);
        S[t][1] = MFMA16(a, Qf[1][ks], S[t][1]);
      }
    bf16x8 Pf[2][2];
#pragma unroll
    for (int qt = 0; qt < 2; ++qt) {
      float mx = S[0][qt][0];
#pragma unroll
      for (int t = 0; t < 4; ++t)
#pragma unroll
        for (int reg = 0; reg < 4; ++reg) mx = fmaxf(mx, S[t][qt][reg]);
      mx = fmaxf(mx, shfl_idx(mx, lane ^ 16));
      mx = fmaxf(mx, shfl_idx(mx, lane ^ 32));
      const float mxc = mx * CS;
      const bool need = mxc - mrun[qt] > 8.f;
      if (__builtin_amdgcn_ballot_w64(need) != 0ull) {
        const float mnew = fmaxf(mrun[qt], mxc);
        const float alpha = __builtin_amdgcn_exp2f(mrun[qt] - mnew);
        mrun[qt] = mnew;
        lsum[qt] *= alpha;
#pragma unroll
        for (int et = 0; et < 8; ++et) { O[et][qt][0] *= alpha; O[et][qt][1] *= alpha; O[et][qt][2] *= alpha; O[et][qt][3] *= alpha; }
      }
      const float mc = mrun[qt];
      float ps = 0.f;
      float pv[4][4];
#pragma unroll
      for (int t = 0; t < 4; ++t)
#pragma unroll
        for (int reg = 0; reg < 4; ++reg) { pv[t][reg] = __builtin_amdgcn_exp2f(S[t][qt][reg] * CS - mc); ps += pv[t][reg]; }
      lsum[qt] += ps;
#pragma unroll
      for (int k2 = 0; k2 < 2; ++k2) {
        u32x4 pk = {pack2(pv[2 * k2][0], pv[2 * k2][1]), pack2(pv[2 * k2][2], pv[2 * k2][3]),
                    pack2(pv[2 * k2 + 1][0], pv[2 * k2 + 1][1]), pack2(pv[2 * k2 + 1][2], pv[2 * k2 + 1][3])};
        Pf[qt][k2] = __builtin_bit_cast(bf16x8, pk);
      }
    }
#pragma unroll
    for (int k2 = 0; k2 < 2; ++k2)
#pragma unroll
      for (int et = 0; et < 8; ++et) {
        const u32x2 a0 = *(const u32x2*)(cV + (et * 16 + l15) * 72 + (2 * k2) * 16 + quad * 4);
        const u32x2 a1 = *(const u32x2*)(cV + (et * 16 + l15) * 72 + (2 * k2 + 1) * 16 + quad * 4);
        const u32x4 a4 = {a0.x, a0.y, a1.x, a1.y};
        const bf16x8 a = __builtin_bit_cast(bf16x8, a4);
        O[et][0] = MFMA16(a, Pf[0][k2], O[et][0]);
        O[et][1] = MFMA16(a, Pf[1][k2], O[et][1]);
      }
    if (kt + 1 < ntiles) {
      bf16_t* nK = Ks + (cur ^ 1) * 8704;
      bf16_t* nV = Vs + (cur ^ 1) * 9216;
#pragma unroll
      for (int r = 0; r < 4; ++r) {
        const int q = tid + 256 * r;
        *(u32x4*)(nK + (q >> 4) * 136 + (q & 15) * 8) = rk[r];
        *(u32x4*)(nV + (q >> 3) * 72 + (q & 7) * 8) = rv[r];
      }
    }
    HSYNC();
  }
  const float lam = p.LAM[layer * 2], oml = p.LAM[layer * 2 + 1];
#pragma unroll
  for (int qt = 0; qt < 2; ++qt) {
    float l = lsum[qt];
    l += shfl_idx(l, lane ^ 16);
    l += shfl_idx(l, lane ^ 32);
    const float inv = (comp == 1 ? lam : 1.f) / l;
#pragma unroll
    for (int et = 0; et < 8; ++et) { O[et][qt][0] *= inv; O[et][qt][1] *= inv; O[et][qt][2] *= inv; O[et][qt][3] *= inv; }
  }
  if (comp == 1) {
#pragma unroll
    for (int qt = 0; qt < 2; ++qt)
#pragma unroll
      for (int et = 0; et < 8; ++et) *(f32x4*)(XB + (qh * 32 + qt * 16 + l15) * 132 + et * 16 + quad * 4) = O[et][qt];
  }
  HSYNC();
  if (comp == 0) {
    const float* sw = p.subln_w + layer * 128;
#pragma unroll
    for (int qt = 0; qt < 2; ++qt) {
      float ss = 0.f;
#pragma unroll
      for (int et = 0; et < 8; ++et) {
        const f32x4 o1 = *(const f32x4*)(XB + (qh * 32 + qt * 16 + l15) * 132 + et * 16 + quad * 4);
        O[et][qt][0] -= o1[0]; O[et][qt][1] -= o1[1]; O[et][qt][2] -= o1[2]; O[et][qt][3] -= o1[3];
        ss += O[et][qt][0] * O[et][qt][0] + O[et][qt][1] * O[et][qt][1] + O[et][qt][2] * O[et][qt][2] + O[et][qt][3] * O[et][qt][3];
      }
      ss += shfl_idx(ss, lane ^ 16);
      ss += shfl_idx(ss, lane ^ 32);
      const float rstd = rsqrtf(ss * (1.f / 128.f) + EPSN) * oml;
      const int row = qrow0 + qh * 32 + qt * 16 + l15;
#pragma unroll
      for (int et = 0; et < 8; ++et) {
        const f32x4 wv = *(const f32x4*)(sw + et * 16 + quad * 4);
        u32x2 pk = {pack2(O[et][qt][0] * rstd * wv[0], O[et][qt][1] * rstd * wv[1]),
                    pack2(O[et][qt][2] * rstd * wv[2], O[et][qt][3] * rstd * wv[3])};
        *(u32x2*)(p.YA + (size_t)row * D + h * 128 + et * 16 + quad * 4) = pk;
      }
    }
  }
  HSYNC();
}

DI void attn_item8(const Params& p, int layer, int lb, int h, int qb, bool is_ctx, unsigned char* lds, int tid) {
  bf16_t* Ks = (bf16_t*)lds;
  bf16_t* Vs = (bf16_t*)(lds + 34816);
  float* XB = (float*)lds;
  const int lane = tid & 63, w = tid >> 6, l15 = lane & 15, quad = lane >> 4;
  const int comp = w >> 2, qh = w & 3;
  const int nl = p.nbg * SEQ;
  const int ntiles = is_ctx ? 4 : 36;
  const int qrow0 = (is_ctx ? nl + lb * CTXL : lb * SEQ) + qb * 128;
  const bf16_t* KKp = p.KK + (size_t)(lb * 8 + h) * 2304 * 128;
  const bf16_t* VTp = p.VT + (size_t)(lb * 8 + h) * 128 * 2304;
  bf16x8 Qf[2][2];
#pragma unroll
  for (int qt = 0; qt < 2; ++qt)
#pragma unroll
    for (int ks = 0; ks < 2; ++ks)
      Qf[qt][ks] = *(const bf16x8*)(p.U + (size_t)(qrow0 + qh * 32 + qt * 16 + l15) * USTR + 3072 + h * 128 + comp * 64 + ks * 32 + quad * 8);
  f32x4 O[8][2];
#pragma unroll
  for (int et = 0; et < 8; ++et) { O[et][0] = (f32x4){0.f, 0.f, 0.f, 0.f}; O[et][1] = (f32x4){0.f, 0.f, 0.f, 0.f}; }
  float mrun[2] = {-1e30f, -1e30f}, lsum[2] = {0.f, 0.f};
  const float CS = 0.125f * 1.44269504088896f;
  u32x4 rk[2], rv[2];
#pragma unroll
  for (int r = 0; r < 2; ++r) {
    const int q = tid + 512 * r;
    rk[r] = *(const u32x4*)(KKp + (size_t)(q >> 4) * 128 + (q & 15) * 8);
    rv[r] = *(const u32x4*)(VTp + (size_t)(q >> 3) * 2304 + (q & 7) * 8);
  }
#pragma unroll
  for (int r = 0; r < 2; ++r) {
    const int q = tid + 512 * r;
    *(u32x4*)(Ks + (q >> 4) * 136 + (q & 15) * 8) = rk[r];
    *(u32x4*)(Vs + (q >> 3) * 72 + (q & 7) * 8) = rv[r];
  }
  __syncthreads();
  for (int kt = 0; kt < ntiles; ++kt) {
    const int cur = kt & 1;
    if (kt + 1 < ntiles) {
#pragma unroll
      for (int r = 0; r < 2; ++r) {
        const int q = tid + 512 * r;
        rk[r] = *(const u32x4*)(KKp + (size_t)((kt + 1) * 64 + (q >> 4)) * 128 + (q & 15) * 8);
        rv[r] = *(const u32x4*)(VTp + (size_t)(q >> 3) * 2304 + (kt + 1) * 64 + (q & 7) * 8);
      }
    }
    const bf16_t* cK = Ks + cur * 8704;
    const bf16_t* cV = Vs + cur * 9216;
    f32x4 S[4][2];
#pragma unroll
    for (int t = 0; t < 4; ++t) { S[t][0] = (f32x4){0.f, 0.f, 0.f, 0.f}; S[t][1] = (f32x4){0.f, 0.f, 0.f, 0.f}; }
#pragma unroll
    for (int ks = 0; ks < 2; ++ks)
#pragma unroll
      for (int t = 0; t < 4; ++t) {
        const bf16x8 a = *(const bf16x8*)(cK + (t * 16 + l15) * 136 + comp * 64 + ks * 32 + quad * 8);
        S[t][0] = MFMA16(a, Qf[0][ks], S[t][0]);
        S[t][1] = MFMA16(a, Qf[1][ks], S[t][1]);
      }
    bf16x8 Pf[2][2];
#pragma unroll
    for (int qt = 0; qt < 2; ++qt) {
      float mx = S[0][qt][0];
#pragma unroll
      for (int t = 0; t < 4; ++t)
#pragma unroll
        for (int reg = 0; reg < 4; ++reg) mx = fmaxf(mx, S[t][qt][reg]);
      mx = fmaxf(mx, shfl_idx(mx, lane ^ 16));
      mx = fmaxf(mx, shfl_idx(mx, lane ^ 32));
      const float mxc = mx * CS;
      const bool need = mxc - mrun[qt] > 8.f;
      if (__builtin_amdgcn_ballot_w64(need) != 0ull) {
        const float mnew = fmaxf(mrun[qt], mxc);
        const float alpha = __builtin_amdgcn_exp2f(mrun[qt] - mnew);
        mrun[qt] = mnew;
        lsum[qt] *= alpha;
#pragma unroll
        for (int et = 0; et < 8; ++et) { O[et][qt][0] *= alpha; O[et][qt][1] *= alpha; O[et][qt][2] *= alpha; O[et][qt][3] *= alpha; }
      }
      const float mc = mrun[qt];
      float ps = 0.f;
      float pv[4][4];
#pragma unroll
      for (int t = 0; t < 4; ++t)
#pragma unroll
        for (int reg = 0; reg < 4; ++reg) { pv[t][reg] = __builtin_amdgcn_exp2f(S[t][qt][reg] * CS - mc); ps += pv[t][reg]; }
      lsum[qt] += ps;
#pragma unroll
      for (int k2 = 0; k2 < 2; ++k2) {
        u32x4 pk = {pack2(pv[2 * k2][0], pv[2 * k2][1]), pack2(pv[2 * k2][2], pv[2 * k2][3]),
                    pack2(pv[2 * k2 + 1][0], pv[2 * k2 + 1][1]), pack2(pv[2 * k2 + 1][2], pv[2 * k2 + 1][3])};
        Pf[qt][k2] = __builtin_bit_cast(bf16x8, pk);
      }
    }
#pragma unroll
    for (int k2 = 0; k2 < 2; ++k2)
#pragma unroll
      for (int et = 0; et < 8; ++et) {
        const u32x2 a0 = *(const u32x2*)(cV + (et * 16 + l15) * 72 + (2 * k2) * 16 + quad * 4);
        const u32x2 a1 = *(const u32x2*)(cV + (et * 16 + l15) * 72 + (2 * k2 + 1) * 16 + quad * 4);
        const u32x4 a4 = {a0.x, a0.y, a1.x, a1.y};
        const bf16x8 a = __builtin_bit_cast(bf16x8, a4);
        O[et][0] = MFMA16(a, Pf[0][k2], O[et][0]);
        O[et][1] = MFMA16(a, Pf[1][k2], O[et][1]);
      }
    if (kt + 1 < ntiles) {
      bf16_t* nK = Ks + (cur ^ 1) * 8704;
      bf16_t* nV = Vs + (cur ^ 1) * 9216;
#pragma unroll
      for (int r = 0; r < 2; ++r) {
        const int q = tid + 512 * r;
        *(u32x4*)(nK + (q >> 4) * 136 + (q & 15) * 8) = rk[r];
        *(u32x4*)(nV + (q >> 3) * 72 + (q & 7) * 8) = rv[r];
      }
    }
    __syncthreads();
  }
  const float lam = p.LAM[layer * 2], oml = p.LAM[layer * 2 + 1];
#pragma unroll
  for (int qt = 0; qt < 2; ++qt) {
    float l = lsum[qt];
    l += shfl_idx(l, lane ^ 16);
    l += shfl_idx(l, lane ^ 32);
    const float inv = (comp == 1 ? lam : 1.f) / l;
#pragma unroll
    for (int et = 0; et < 8; ++et) { O[et][qt][0] *= inv; O[et][qt][1] *= inv; O[et][qt][2] *= inv; O[et][qt][3] *= inv; }
  }
  if (comp == 1) {
#pragma unroll
    for (int qt = 0; qt < 2; ++qt)
#pragma unroll
      for (int et = 0; et < 8; ++et) *(f32x4*)(XB + (qh * 32 + qt * 16 + l15) * 132 + et * 16 + quad * 4) = O[et][qt];
  }
  __syncthreads();
  if (comp == 0) {
    const float* sw = p.subln_w + layer * 128;
#pragma unroll
    for (int qt = 0; qt < 2; ++qt) {
      float ss = 0.f;
#pragma unroll
      for (int et = 0; et < 8; ++et) {
        const f32x4 o1 = *(const f32x4*)(XB + (qh * 32 + qt * 16 + l15) * 132 + et * 16 + quad * 4);
        O[et][qt][0] -= o1[0]; O[et][qt][1] -= o1[1]; O[et][qt][2] -= o1[2]; O[et][qt][3] -= o1[3];
        ss += O[et][qt][0] * O[et][qt][0] + O[et][qt][1] * O[et][qt][1] + O[et][qt][2] * O[et][qt][2] + O[et][qt][3] * O[et][qt][3];
      }
      ss += shfl_idx(ss, lane ^ 16);
      ss += shfl_idx(ss, lane ^ 32);
      const float rstd = rsqrtf(ss * (1.f / 128.f) + EPSN) * oml;
      const int row = qrow0 + qh * 32 + qt * 16 + l15;
#pragma unroll
      for (int et = 0; et < 8; ++et) {
        const f32x4 wv = *(const f32x4*)(sw + et * 16 + quad * 4);
        u32x2 pk = {pack2(O[et][qt][0] * rstd * wv[0], O[et][qt][1] * rstd * wv[1]),
                    pack2(O[et][qt][2] * rstd * wv[2], O[et][qt][3] * rstd * wv[3])};
        *(u32x2*)(p.YA + (size_t)row * D + h * 128 + et * 16 + quad * 4) = pk;
      }
    }
  }
  __syncthreads();
}

DI int inproj_main_tiles(int MT, int NT);
DI void inproj_tile(const Params& p, int layer, int g, int item, unsigned char* lds, int tid_);
DI void mix_phase(const Params& p, int layer, int g, unsigned char* lds, int tid_) {
  const int n_al = p.nbg * 8 * 16;
  const int n_ac = layer == 0 ? p.nbg * 8 * 2 : 0;
  const int n_st = p.nbg * 18 * 16;
  for (int item = blockIdx.x; item < n_al; item += gridDim.x) {
    int tid = tid_;
    asm volatile("" : "+v"(tid));
    attn_item8(p, layer, item >> 7, (item >> 4) & 7, item & 15, false, lds, tid);
  }
  {
    const int cshift = (int)gridDim.x >= 128 ? 64 : 0;
    for (int it = ((int)blockIdx.x - cshift + (int)gridDim.x) % (int)gridDim.x; it < n_ac; it += gridDim.x) {
      int tid = tid_;
      asm volatile("" : "+v"(tid));
      attn_item8(p, layer, it >> 4, (it >> 1) & 7, it & 1, true, lds, tid);
    }
  }
  {
    const int MT = (p.nbg * (SEQ + CTXL)) >> 8, NT = NINP >> 8;
    const int n_main = inproj_main_tiles(MT, NT), ntail = MT * NT - n_main;
    const int back = (int)gridDim.x - 1 - (int)blockIdx.x;
    if (back < ntail) {
      inproj_tile(p, layer, g, n_main + back, lds, tid_);
      __syncthreads();
    }
  }
  unsigned char* vlds = lds + VHALF * LDS_HALF;
  for (int item = VB; item < n_st; item += VG) {
    int tid = tid_ & 255;
    asm volatile("" : "+v"(tid));
    const int hh = item & 15, rest = item >> 4, cid = rest % 18, lb = rest / 18;
    ssd_state_item(p, layer, lb, cid, hh, vlds, tid);
  }
}

DI void recur_phase(const Params& p, int tid) {
  const int total = p.nbg * 2 * 16 * 1024;
  for (int idx = VB * 256 + tid; idx < total; idx += VG * 256) {
    const int lbdh = idx >> 10, e8 = idx & 1023;
    const int dir = (lbdh >> 4) & 1;
    bf16_t* base = (bf16_t*)p.ST + (size_t)lbdh * 18 * 8192 + e8 * 8;
    const float* dec = p.DEC + lbdh * 18;
    u32x4 sv[18];
    float dc[18];
#pragma unroll
    for (int k = 0; k < 18; ++k) {
      const int cid = dir == 0 ? k : (k < 2 ? 1 - k : 19 - k);
      sv[k] = *(const u32x4*)(base + (size_t)cid * 8192);
      dc[k] = dec[cid];
    }
    float zf = 0.f;
    asm volatile("" : "+v"(zf));
    float hst[8] = {zf, zf, zf, zf, zf, zf, zf, zf};
#pragma unroll
    for (int k = 0; k < 18; ++k) {
      const int cid = dir == 0 ? k : (k < 2 ? 1 - k : 19 - k);
      u32x4 pk = {pack2(hst[0], hst[1]), pack2(hst[2], hst[3]), pack2(hst[4], hst[5]), pack2(hst[6], hst[7])};
      *(u32x4*)(base + (size_t)cid * 8192) = pk;
      float sf[8];
      unpack8(sv[k], sf);
#pragma unroll
      for (int e = 0; e < 8; ++e) hst[e] = hst[e] * dc[k] + sf[e];
    }
  }
}

DI void ssd_out_item(const Params& p, int layer, int lb, int cid, int h, unsigned char* lds, int tid) {
  bf16_t* Bs = (bf16_t*)lds;
  bf16_t* XT = (bf16_t*)(lds + 34816);
  float* fl = (float*)(lds + 52224);
  const int lane = tid & 63, w = tid >> 6, l15_ = lane & 15, quad_ = lane >> 4;
  const int row0 = chunk_row0(p, lb, cid);
  const int seqlen = cid < 2 ? CTXL : SEQ;
  const int t0 = cid < 2 ? cid * 128 : (cid - 2) * 128;
  const int grp = h >> 2;
  const float* cw = p.ssd_conv_w + layer * 3 * 2048;
  const float* cb = p.ssd_conv_b + layer * 2048;
  if (tid < 128) *(f32x4*)(fl + tid * 4) = *(const f32x4*)(p.CSB + (size_t)((lb * 18 + cid) * 16 + h) * 512 + tid * 4);
  const float* dtf = fl; const float* dtb = fl + 128; const float* csf = fl + 256; const float* rsb = fl + 384;
#pragma unroll 4
  for (int r = 0; r < 8; ++r) {
    const int unit = tid + 256 * r, cgp = unit & 15, l = unit >> 4;
    const int ci = 1024 + grp * 128 + cgp * 8;
    float o[8];
    conv_silu8(p.U + (size_t)(row0 + l) * USTR + 1024 + ci, (t0 + l) > 0, (t0 + l) < seqlen - 1, cw, cb, ci, o);
    u32x4 pk = {pack2(o[0], o[1]), pack2(o[2], o[3]), pack2(o[4], o[5]), pack2(o[6], o[7])};
    *(u32x4*)(Bs + l * 136 + cgp * 8) = pk;
  }
#pragma unroll 4
  for (int r = 0; r < 4; ++r) {
    const int unit = tid + 256 * r, cgp = unit & 7, l = unit >> 3;
    const int ci = h * 64 + cgp * 8;
    float o[8];
    conv_silu8(p.U + (size_t)(row0 + l) * USTR + 1024 + ci, (t0 + l) > 0, (t0 + l) < seqlen - 1, cw, cb, ci, o);
#pragma unroll
    for (int e = 0; e < 8; ++e) XT[(cgp * 8 + e) * 136 + l] = f2bf(o[e]);
  }
  HSYNC();
  bf16_t* Pw = (bf16_t*)(lds + 54272) + w * (16 * 136);
  const float dsk = p.ssd_d[layer * 16 + h];
#pragma unroll 1
  for (int lt = 0; lt < 2; ++lt) {
    int l15 = l15_, quad = quad_;
    asm volatile("" : "+v"(l15), "+v"(quad));
    const int l = w * 32 + lt * 16 + l15;
    bf16x8 Cf[4];
#pragma unroll
    for (int ks = 0; ks < 4; ++ks) {
      const int ci = 1536 + grp * 128 + ks * 32 + quad * 8;
      float o[8];
      conv_silu8(p.U + (size_t)(row0 + l) * USTR + 1024 + ci, (t0 + l) > 0, (t0 + l) < seqlen - 1, cw, cb, ci, o);
      u32x4 pk = {pack2(o[0], o[1]), pack2(o[2], o[3]), pack2(o[4], o[5]), pack2(o[6], o[7])};
      Cf[ks] = __builtin_bit_cast(bf16x8, pk);
    }
    f32x4 cbT[8];
#pragma unroll
    for (int st = 0; st < 8; ++st) cbT[st] = (f32x4){0.f, 0.f, 0.f, 0.f};
#pragma unroll
    for (int ks = 0; ks < 4; ++ks)
#pragma unroll
      for (int st = 0; st < 8; ++st) {
        const bf16x8 a = *(const bf16x8*)(Bs + (st * 16 + l15) * 136 + ks * 32 + quad * 8);
        cbT[st] = MFMA16(a, Cf[ks], cbT[st]);
      }
    f32x4 Y[4];
#pragma unroll
    for (int pt = 0; pt < 4; ++pt) Y[pt] = (f32x4){0.f, 0.f, 0.f, 0.f};
#pragma unroll
    for (int dir = 0; dir < 2; ++dir) {
      const float cl = dir == 0 ? csf[l] : rsb[l];
#pragma unroll
      for (int st = 0; st < 8; ++st) {
        float pv[4];
#pragma unroll
        for (int reg = 0; reg < 4; ++reg) {
          const int s = st * 16 + quad * 4 + reg;
          const bool ok = dir == 0 ? (s <= l) : (s >= l);
          const float cs_s = dir == 0 ? csf[s] : rsb[s];
          const float dts = dir == 0 ? dtf[s] : dtb[s];
          pv[reg] = ok ? cbT[st][reg] * __expf(fminf(cl - cs_s, 0.f)) * dts : 0.f;
        }
        u32x2 pk = {pack2(pv[0], pv[1]), pack2(pv[2], pv[3])};
        *(u32x2*)(Pw + l15 * 136 + st * 16 + quad * 4) = pk;
      }
      asm volatile("s_waitcnt lgkmcnt(0)" ::: "memory");
#pragma unroll
      for (int ks = 0; ks < 4; ++ks) {
        const bf16x8 b0 = *(const bf16x8*)(Pw + l15 * 136 + ks * 32 + quad * 8);
#pragma unroll
        for (int pt = 0; pt < 4; ++pt) {
          const bf16x8 a = *(const bf16x8*)(XT + (pt * 16 + l15) * 136 + ks * 32 + quad * 8);
          Y[pt] = MFMA16(a, b0, Y[pt]);
        }
      }
      asm volatile("s_waitcnt lgkmcnt(0)" ::: "memory");
    }
#pragma unroll
    for (int dir = 0; dir < 2; ++dir) {
      const bf16_t* hp = (const bf16_t*)p.ST + ((size_t)(((lb * 2 + dir) * 16 + h) * 18 + cid)) * 8192;
      f32x4 T[4];
#pragma unroll
      for (int pt = 0; pt < 4; ++pt) T[pt] = (f32x4){0.f, 0.f, 0.f, 0.f};
#pragma unroll
      for (int ks = 0; ks < 4; ++ks)
#pragma unroll
        for (int pt = 0; pt < 4; ++pt) {
          const bf16x8 a = *(const bf16x8*)(hp + (pt * 16 + l15) * 128 + ks * 32 + quad * 8);
          T[pt] = MFMA16(a, Cf[ks], T[pt]);
        }
      const float e = __expf(dir == 0 ? csf[l] : rsb[l]);
#pragma unroll
      for (int pt = 0; pt < 4; ++pt) { Y[pt][0] += e * T[pt][0]; Y[pt][1] += e * T[pt][1]; Y[pt][2] += e * T[pt][2]; Y[pt][3] += e * T[pt][3]; }
    }
    const int row = row0 + l;
    float ss = 0.f;
#pragma unroll
    for (int pt = 0; pt < 4; ++pt) {
      const int pp = pt * 16 + quad * 4;
      const u32x2 zz = *(const u32x2*)(p.U + (size_t)row * USTR + h * 64 + pp);
      const float z0 = lo_f(zz.x), z1 = hi_f(zz.x), z2 = lo_f(zz.y), z3 = hi_f(zz.y);
      float y0 = Y[pt][0] + dsk * bf2f(XT[(pp + 0) * 136 + l]);
      float y1 = Y[pt][1] + dsk * bf2f(XT[(pp + 1) * 136 + l]);
      float y2 = Y[pt][2] + dsk * bf2f(XT[(pp + 2) * 136 + l]);
      float y3 = Y[pt][3] + dsk * bf2f(XT[(pp + 3) * 136 + l]);
      y0 *= silu_f(z0); y1 *= silu_f(z1); y2 *= silu_f(z2); y3 *= silu_f(z3);
      ss += y0 * y0 + y1 * y1 + y2 * y2 + y3 * y3;
      u32x2 pk = {pack2(y0, y1), pack2(y2, y3)};
      *(u32x2*)(p.YS + (size_t)row * D + h * 64 + pp) = pk;
    }
    ss += shfl_idx(ss, lane ^ 16);
    ss += shfl_idx(ss, lane ^ 32);
    if (quad == 0) p.SSQ[(size_t)row * 16 + h] = ss;
  }
  HSYNC();
}

DI void ssdout_phase(const Params& p, int layer, int g, unsigned char* lds, int tid_) {
  const int cid0 = layer == 0 ? 0 : 2;
  const int ncid = 18 - cid0;
  const int n = p.nbg * ncid * 16;
  for (int item = VB; item < n; item += VG) {
    int tid = tid_;
    asm volatile("" : "+v"(tid));
    const int hh = item & 15, rest = item >> 4, cid = cid0 + rest % ncid, lb = rest / ncid;
    ssd_out_item(p, layer, lb, cid, hh, lds, tid);
  }
}

DI void merge_phase(const Params& p, int layer, int g, int mrows, unsigned char* lds, int tid_) {
  const int MT = mrows >> 7, NT = D >> 6;
  const bf16_t* Bs_ = p.wt_brs + (size_t)layer * D * D;
  const bf16_t* Ba_ = p.wt_bra + (size_t)layer * D * D;
  for (int round = 0; (int)blockIdx.x + round * VG < MT * NT; ++round) {
    const int item = VB + round * VG;
    if (item >= MT * NT) {
      for (int i = 0; i < 2 * (1 + (D >> 6)); ++i) __syncthreads();
      continue;
    }
    int tid = tid_;
    asm volatile("" : "+v"(tid));
    const int lane = tid & 63, w = tid >> 6, wm = w & 1, wn = w >> 1, l15 = lane & 15, quad = lane >> 4;
    const int mt = item % MT, nt = item / MT;
    f32x4 as[2][4], aa[2][4];
    zero_acc<2>(as); zero_acc<2>(aa);
    gemm_mainloop<2>(p.YS + (size_t)mt * 128 * D, D, Bs_ + (size_t)nt * 64 * D, D, D, as, lds, tid);
    gemm_mainloop<2>(p.YA + (size_t)mt * 128 * D, D, Ba_ + (size_t)nt * 64 * D, D, D, aa, lds, tid);
    const int mb = mt * 128 + wm * 64, nb = nt * 64 + wn * 32;
#pragma unroll
    for (int j = 0; j < 4; ++j) {
      const int r = mb + j * 16 + l15;
      float ssq = 0.f;
      const f32x4* sq = (const f32x4*)(p.SSQ + (size_t)r * 16);
#pragma unroll
      for (int q = 0; q < 4; ++q) { const f32x4 t = sq[q]; ssq += t[0] + t[1] + t[2] + t[3]; }
      const float rstd = rsqrtf(ssq * (1.f / D) + EPSN);
#pragma unroll
      for (int i = 0; i < 2; ++i) {
        const int n = nb + i * 16 + quad * 4;
        const u32x2 gs = *(const u32x2*)(p.U + (size_t)r * USTR + 4096 + n);
        const u32x2 ga = *(const u32x2*)(p.U + (size_t)r * USTR + 5120 + n);
        const float m0 = sigm_f(lo_f(gs.x)) * rstd * as[i][j][0] + sigm_f(lo_f(ga.x)) * aa[i][j][0];
        const float m1 = sigm_f(hi_f(gs.x)) * rstd * as[i][j][1] + sigm_f(hi_f(ga.x)) * aa[i][j][1];
        const float m2 = sigm_f(lo_f(gs.y)) * rstd * as[i][j][2] + sigm_f(lo_f(ga.y)) * aa[i][j][2];
        const float m3 = sigm_f(hi_f(gs.y)) * rstd * as[i][j][3] + sigm_f(hi_f(ga.y)) * aa[i][j][3];
        u32x2 pk = {pack2(m0, m1), pack2(m2, m3)};
        *(u32x2*)(p.MG + (size_t)r * D + n) = pk;
      }
    }
  }
}

DI void resid_gemm_phase(const Params& p, int layer, int g, int mrows, const bf16_t* A, int K, const bf16_t* Bt, int gate_off,
                         bool src_is_in, unsigned char* lds, int tid_) {
  const int MT = mrows >> 7, NT = D >> 7;
  for (int round = 0; (int)blockIdx.x + round * VG < MT * NT; ++round) {
    const int item = VB + round * VG;
    if (item >= MT * NT) {
      for (int i = 0; i < 1 + (K >> 6); ++i) __syncthreads();
      continue;
    }
    int tid = tid_;
    asm volatile("" : "+v"(tid));
    const int lane = tid & 63, w = tid >> 6, wm = w & 1, wn = w >> 1, l15 = lane & 15, quad = lane >> 4;
    const int mt = item % MT, nt = item / MT;
    f32x4 acc[4][4];
    zero_acc<4>(acc);
    gemm_mainloop<4>(A + (size_t)mt * 128 * K, K, Bt + (size_t)nt * 128 * K, K, K, acc, lds, tid);
    const int mb = mt * 128 + wm * 64, nb = nt * 128 + wn * 64;
#pragma unroll
    for (int j = 0; j < 4; ++j) {
      const int r = mb + j * 16 + l15;
      const float* src = src_is_in ? xin_row(p, layer, g, r) : xout_row(p, g, r);
      float* dst = xout_row(p, g, r);
      const float* gate = p.MOD + (size_t)(layer * 9 + mod_row(p, g, r)) * 6144 + gate_off;
#pragma unroll
      for (int i = 0; i < 4; ++i) {
        const int n = nb + i * 16 + quad * 4;
        const f32x4 xv = *(const f32x4*)(src + n), gv = *(const f32x4*)(gate + n);
        f32x4 o;
        o[0] = xv[0] + gv[0] * acc[i][j][0]; o[1] = xv[1] + gv[1] * acc[i][j][1];
        o[2] = xv[2] + gv[2] * acc[i][j][2]; o[3] = xv[3] + gv[3] * acc[i][j][3];
        *(f32x4*)(dst + n) = o;
      }
    }
  }
}


DI int g8_lds_byte(int r, int c) {
  const int st = (r >> 4) * 2 + (c >> 5), rr = r & 15, cc = c & 31, ob = rr * 64 + cc * 2;
  return st * 1024 + (ob ^ (((ob >> 9) & 1) << 5));
}
DI void g8_stage_rc(int b, int& R, int& C) {
  const int st = b / 1024, sb = b % 1024, swz = sb ^ (((sb >> 9) & 1) << 5);
  R = (st >> 1) * 16 + swz / 64; C = (st & 1) * 32 + (swz % 64) / 2;
}
DI void gemm8p(const bf16_t* __restrict__ Wp, const bf16_t* __restrict__ Xp, f32x4 (&acc)[2][2][4][2], unsigned char* lds, int tid) {
  constexpr int GK = 1024, GBK = 64, GHALF = 128, GHT = GHALF * GBK;
  bf16_t* shm = (bf16_t*)lds;
#define SA(b, h) (shm + ((b) * 2 + (h)) * GHT)
#define SB(b, h) (shm + (4 + (b) * 2 + (h)) * GHT)
  const int wid = tid >> 6, lane = tid & 63, wr = wid >> 2, wc = wid & 3, fr = lane & 15, fq = lane >> 4;
  int goff0, goff1;
  { int r_, c_; g8_stage_rc(tid * 16, r_, c_); goff0 = r_ * GK + c_; g8_stage_rc(tid * 16 + 8192, r_, c_); goff1 = r_ * GK + c_; }
#define STAGE(P, BASE, br, kt) do { \
    __builtin_amdgcn_global_load_lds((const unsigned*)((BASE) + (br) * GK + (kt) * GBK + goff0), (unsigned*)((char*)(P) + tid * 16), 16, 0, 0); \
    __builtin_amdgcn_global_load_lds((const unsigned*)((BASE) + (br) * GK + (kt) * GBK + goff1), (unsigned*)((char*)(P) + tid * 16 + 8192), 16, 0, 0); } while (0)
#define LDA(dst, b, h) _Pragma("unroll") for (int m = 0; m < 4; ++m) _Pragma("unroll") for (int k = 0; k < 2; ++k) \
    dst[m][k] = *reinterpret_cast<const bf16x8*>((char*)SA(b, h) + g8_lds_byte(wr * 64 + m * 16 + fr, k * 32 + fq * 8))
#define LDB(dst, b, h) _Pragma("unroll") for (int n = 0; n < 2; ++n) _Pragma("unroll") for (int k = 0; k < 2; ++k) \
    dst[n][k] = *reinterpret_cast<const bf16x8*>((char*)SB(b, h) + g8_lds_byte(wc * 32 + n * 16 + fr, k * 32 + fq * 8))
#define MMA(ai, bj, At_, Bt_) do { __builtin_amdgcn_s_setprio(1); \
    _Pragma("unroll") for (int m = 0; m < 4; ++m) _Pragma("unroll") for (int n = 0; n < 2; ++n) _Pragma("unroll") for (int k = 0; k < 2; ++k) \
      acc[ai][bj][m][n] = __builtin_amdgcn_mfma_f32_16x16x32_bf16(At_[m][k], Bt_[n][k], acc[ai][bj][m][n], 0, 0, 0); \
    __builtin_amdgcn_s_setprio(0); } while (0)
#define WAIT_V(n) asm volatile("s_waitcnt vmcnt(" #n ")" ::: "memory")
#define WAIT_L(n) asm volatile("s_waitcnt lgkmcnt(" #n ")" ::: "memory")
#define BAR __builtin_amdgcn_s_barrier()
#define SCHED __builtin_amdgcn_sched_barrier(0)
  bf16x8 At[4][2], B0[2][2], B1[2][2];
  constexpr int nt = GK / GBK;
  STAGE(SB(0, 0), Xp, 0, 0); STAGE(SA(0, 0), Wp, 0, 0);
  STAGE(SB(0, 1), Xp, GHALF, 0); STAGE(SA(0, 1), Wp, GHALF, 0);
  if (wr == 1) BAR;
  WAIT_V(4); BAR;
  STAGE(SB(1, 0), Xp, 0, 1); STAGE(SA(1, 0), Wp, 0, 1); STAGE(SB(1, 1), Xp, GHALF, 1);
  WAIT_V(6); BAR;
  for (int t = 0; t < nt - 2; t += 2) {
    LDB(B0, 0, 0); SCHED; LDA(At, 0, 0); STAGE(SA(1, 1), Wp, GHALF, t + 1);
    WAIT_L(8); BAR; WAIT_L(0); MMA(0, 0, At, B0); BAR; SCHED;
    LDB(B1, 0, 1); STAGE(SB(0, 0), Xp, 0, t + 2);
    BAR; WAIT_L(0); MMA(0, 1, At, B1); BAR;
    LDA(At, 0, 1); STAGE(SA(0, 0), Wp, 0, t + 2);
    BAR; WAIT_L(0); MMA(1, 0, At, B0); BAR; SCHED;
    STAGE(SB(0, 1), Xp, GHALF, t + 2);
    WAIT_V(6); BAR; MMA(1, 1, At, B1); BAR;
    LDB(B0, 1, 0); SCHED; LDA(At, 1, 0); STAGE(SA(0, 1), Wp, GHALF, t + 2);
    WAIT_L(8); BAR; WAIT_L(0); MMA(0, 0, At, B0); BAR; SCHED;
    LDB(B1, 1, 1); STAGE(SB(1, 0), Xp, 0, t + 3);
    BAR; WAIT_L(0); MMA(0, 1, At, B1); BAR;
    LDA(At, 1, 1); STAGE(SA(1, 0), Wp, 0, t + 3);
    BAR; WAIT_L(0); MMA(1, 0, At, B0); BAR; SCHED;
    STAGE(SB(1, 1), Xp, GHALF, t + 3);
    WAIT_V(6); BAR; MMA(1, 1, At, B1); BAR;
  }
  { LDB(B0, 0, 0); LDA(At, 0, 0); STAGE(SA(1, 1), Wp, GHALF, nt - 1);
    BAR; WAIT_L(0); MMA(0, 0, At, B0); BAR;
    LDB(B1, 0, 1); BAR; WAIT_L(0); MMA(0, 1, At, B1); BAR;
    LDA(At, 0, 1); WAIT_V(4); BAR; WAIT_L(0); MMA(1, 0, At, B0); MMA(1, 1, At, B1); BAR; }
  { LDB(B0, 1, 0); LDA(At, 1, 0); WAIT_V(2); BAR; WAIT_L(0); MMA(0, 0, At, B0); BAR;
    LDB(B1, 1, 1); WAIT_V(0); BAR; WAIT_L(0); MMA(0, 1, At, B1); BAR;
    LDA(At, 1, 1); BAR; WAIT_L(0); MMA(1, 0, At, B0); MMA(1, 1, At, B1); BAR; }
  if (wr == 0) BAR;
#undef SA
#undef SB
#undef STAGE
#undef LDA
#undef LDB
#undef MMA
#undef WAIT_V
#undef WAIT_L
#undef BAR
#undef SCHED
}
DI void zero_acc8p(f32x4 (&acc)[2][2][4][2]) {
#pragma unroll
  for (int a = 0; a < 2; ++a)
#pragma unroll
    for (int b = 0; b < 2; ++b)
#pragma unroll
      for (int m = 0; m < 4; ++m) { acc[a][b][m][0] = (f32x4){0.f, 0.f, 0.f, 0.f}; acc[a][b][m][1] = (f32x4){0.f, 0.f, 0.f, 0.f}; }
}

DI int inproj_main_tiles(int MT, int NT) {
  const int total = MT * NT, whole = (total / (int)gridDim.x) * (int)gridDim.x;
  return (whole > 0 && whole / MT >= 25 && total - whole <= (int)gridDim.x) ? whole : total;
}
DI void inproj_tile(const Params& p, int layer, int g, int item, unsigned char* lds, int tid_) {
  const int nl = p.nbg * SEQ, mg = p.nbg * (SEQ + CTXL);
  const int MT = mg >> 8;
  const bf16_t* Wt = p.wt_in + (size_t)layer * NINP * D;
  {
    int tid = tid_;
    asm volatile("" : "+v"(tid));
    const int wid = tid >> 6, lane = tid & 63, wr = wid >> 2, wc = wid & 3, fr = lane & 15, fq = lane >> 4;
    const int mt = item % MT, kpos = item / MT;
    const int nt = kpos == 0 ? 32 : (kpos <= 28 ? kpos + 3 : kpos - 29);
    const int m0 = mt * 256, n0 = nt * 256;
    asm volatile("s_waitcnt vmcnt(0)" ::: "memory");
    __syncthreads();
    f32x4 acc[2][2][4][2];
    zero_acc8p(acc);
    gemm8p(Wt + (size_t)n0 * D, (layer == 0 ? p.H2 : p.H) + (size_t)m0 * D, acc, lds, tid);
    const bool lat = m0 < nl;
#pragma unroll
    for (int ai = 0; ai < 2; ++ai) {
      const int c0 = n0 + ai * 128 + wr * 64;
      if (c0 >= 3072 && c0 < 5120 && lat) {
#pragma unroll
        for (int bj = 0; bj < 2; ++bj)
#pragma unroll
          for (int ni = 0; ni < 2; ++ni) {
            const int r = m0 + bj * 128 + wc * 32 + ni * 16 + fr, t = r & (SEQ - 1), pr = t >> 6, pc = t & 63;
#pragma unroll
            for (int j = 0; j < 4; ++j) {
              const int f = fq * 4 + j;
              const float cr = p.ROPE[(pr * 16 + f) * 2], sr = p.ROPE[(pr * 16 + f) * 2 + 1];
              const float cc = p.ROPE[(pc * 16 + f) * 2], sc = p.ROPE[(pc * 16 + f) * 2 + 1];
              float x1 = acc[ai][bj][0][ni][j], x2 = acc[ai][bj][1][ni][j];
              acc[ai][bj][0][ni][j] = x1 * cr - x2 * sr; acc[ai][bj][1][ni][j] = x2 * cr + x1 * sr;
              x1 = acc[ai][bj][2][ni][j]; x2 = acc[ai][bj][3][ni][j];
              acc[ai][bj][2][ni][j] = x1 * cc - x2 * sc; acc[ai][bj][3][ni][j] = x2 * cc + x1 * sc;
            }
            asm volatile("" ::: "memory");
          }
      }
    }
    if (n0 < 5120 || (n0 >= 6144 && n0 < 8192)) {
      bf16_t* stg = (bf16_t*)lds + wid * (64 * 136);
#pragma unroll
      for (int ai = 0; ai < 2; ++ai)
#pragma unroll
        for (int bj = 0; bj < 2; ++bj)
#pragma unroll
          for (int ni = 0; ni < 2; ++ni)
#pragma unroll
            for (int mi = 0; mi < 4; ++mi) {
              const f32x4 v = acc[ai][bj][mi][ni];
              u32x2 pk = {pack2(v[0], v[1]), pack2(v[2], v[3])};
              *(u32x2*)(stg + (bj * 32 + ni * 16 + fr) * 136 + ai * 64 + mi * 16 + fq * 4) = pk;
            }
      __syncthreads();
#pragma unroll
      for (int ai = 0; ai < 2; ++ai) {
        const int c0 = n0 + ai * 128 + wr * 64;
#pragma unroll
        for (int k = 0; k < 8; ++k) {
          const int c = lane + 64 * k, rl = c >> 3, cc = c & 7;
          const u32x4 v = *(const u32x4*)(stg + rl * 136 + ai * 64 + cc * 8);
          const int r = m0 + (rl >> 5) * 128 + wc * 32 + (rl & 31);
          bf16_t* dst;
          if (n0 >= 4096 && n0 < 5120) {
            int lb, kj;
            if (lat) { lb = r >> 11; kj = CTXL + (r & (SEQ - 1)); } else { const int rc = r - nl; lb = rc >> 8; kj = rc & 255; }
            const int hh = (c0 - 4096) >> 7, cd0 = (c0 - 4096) & 127;
            dst = p.KK + ((size_t)(lb * 8 + hh) * 2304 + kj) * 128 + cd0;
          } else {
            dst = p.U + (size_t)r * USTR + (n0 < 4096 ? c0 : c0 - 2048);
          }
          *(u32x4*)(dst + cc * 8) = v;
        }
      }
    } else if (n0 < 6144) {
      bf16_t* stg = (bf16_t*)lds + wid * (128 * 72);
#pragma unroll
      for (int ai = 0; ai < 2; ++ai)
#pragma unroll
        for (int bj = 0; bj < 2; ++bj)
#pragma unroll
          for (int ni = 0; ni < 2; ++ni)
#pragma unroll
            for (int mi = 0; mi < 4; ++mi)
#pragma unroll
              for (int j = 0; j < 4; ++j)
                stg[(ai * 64 + mi * 16 + fq * 4 + j) * 72 + bj * 32 + ni * 16 + fr] = f2bf(acc[ai][bj][mi][ni][j]);
      __syncthreads();
#pragma unroll
      for (int k = 0; k < 16; ++k) {
        const int c = lane + 64 * k, el = c >> 3, cc = c & 7;
        const u32x4 v = *(const u32x4*)(stg + el * 72 + cc * 8);
        const int r = m0 + (cc >> 2) * 128 + wc * 32 + (cc & 3) * 8;
        int lb, kj;
        if (lat) { lb = r >> 11; kj = CTXL + (r & (SEQ - 1)); } else { const int rc = r - nl; lb = rc >> 8; kj = rc & 255; }
        const int n = n0 + (el >> 6) * 128 + wr * 64 + (el & 63);
        const int hh = (n - 5120) >> 7, e = (n - 5120) & 127;
        *(u32x4*)(p.VT + ((size_t)(lb * 8 + hh) * 128 + e) * 2304 + kj) = v;
      }
    } else if (n0 == 8192 && wr == 0) {
#pragma unroll
      for (int bj = 0; bj < 2; ++bj)
#pragma unroll
        for (int ni = 0; ni < 2; ++ni) {
          const int r = m0 + bj * 128 + wc * 32 + ni * 16 + fr;
#pragma unroll
          for (int mi = 0; mi < 2; ++mi) *(f32x4*)(p.DT + (size_t)r * 32 + mi * 16 + fq * 4) = acc[0][bj][mi][ni];
        }
    }
  }
}
DI void inproj_phase(const Params& p, int layer, int g, unsigned char* lds, int tid_) {
  const int MT = (p.nbg * (SEQ + CTXL)) >> 8, NT = NINP >> 8;
  const int n_main = inproj_main_tiles(MT, NT);
  for (int item = blockIdx.x; item < n_main; item += gridDim.x) inproj_tile(p, layer, g, item, lds, tid_);
}

DI void up_phase(const Params& p, int layer, int mrows, unsigned char* lds, int tid_) {
  const int MT = mrows >> 8, NT = DFF2 >> 8;
  const bf16_t* Wt = p.wt_up + (size_t)layer * DFF2 * D;
  bf16_t* UF = p.U;
  for (int item = blockIdx.x; item < MT * NT; item += gridDim.x) {
    int tid = tid_;
    asm volatile("" : "+v"(tid));
    const int wid = tid >> 6, lane = tid & 63, wr = wid >> 2, wc = wid & 3, fr = lane & 15, fq = lane >> 4;
    const int mt = item % MT, nt = item / MT;
    const int m0 = mt * 256, n0 = nt * 256;
    asm volatile("s_waitcnt vmcnt(0)" ::: "memory");
    __syncthreads();
    f32x4 acc[2][2][4][2];
    zero_acc8p(acc);
    gemm8p(Wt + (size_t)n0 * D, p.H + (size_t)m0 * D, acc, lds, tid);
    bf16_t* stg = (bf16_t*)lds + wid * (64 * 136);
#pragma unroll
    for (int ai = 0; ai < 2; ++ai)
#pragma unroll
      for (int bj = 0; bj < 2; ++bj)
#pragma unroll
        for (int ni = 0; ni < 2; ++ni)
#pragma unroll
          for (int mi = 0; mi < 4; ++mi) {
            const f32x4 v = acc[ai][bj][mi][ni];
            u32x2 pk = {pack2(v[0], v[1]), pack2(v[2], v[3])};
            *(u32x2*)(stg + (bj * 32 + ni * 16 + fr) * 136 + ai * 64 + mi * 16 + fq * 4) = pk;
          }
    __syncthreads();
#pragma unroll
    for (int ai = 0; ai < 2; ++ai) {
      const int c0 = n0 + ai * 128 + wr * 64;
#pragma unroll
      for (int k = 0; k < 8; ++k) {
        const int c = lane + 64 * k, rl = c >> 3, cc = c & 7;
        const u32x4 v = *(const u32x4*)(stg + rl * 136 + ai * 64 + cc * 8);
        const int r = m0 + (rl >> 5) * 128 + wc * 32 + (rl & 31);
        *(u32x4*)(UF + (size_t)r * DFF2 + c0 + cc * 8) = v;
      }
    }
  }
}

DI void act_phase(const Params& p, int layer, int mrows, int tid) {
  const bf16_t* __restrict__ UF = p.U;
  bf16_t* __restrict__ HID = (bf16_t*)p.ST;
  const int nl = p.nbg * SEQ;
  const float* __restrict__ cw = p.ffn_conv_w + (size_t)layer * 3 * DFF2;
  const float* cb = p.ffn_conv_b + (size_t)layer * DFF2;
  const int total = mrows * (DFF / 8);
  const u32x4 z4 = {0u, 0u, 0u, 0u};
#pragma unroll 4
  for (int idx = VB * 256 + tid; idx < total; idx += VG * 256) {
    const int r = idx / (DFF / 8), j0 = (idx % (DFF / 8)) * 8;
    int t, sl;
    if (r < nl) { t = r & (SEQ - 1); sl = SEQ; } else { t = (r - nl) & (CTXL - 1); sl = CTXL; }
    const bool hp = t > 0, hn = t < sl - 1;
    const bf16_t* up = UF + (size_t)r * DFF2 + j0;
    float res[8];
    float av[8], vv[8];
#pragma unroll
    for (int half = 0; half < 2; ++half) {
      const bf16_t* q = up + half * DFF;
      const int ci = half * DFF + j0;
      float c[8], pv[8], nx[8];
      unpack8(*(const u32x4*)q, c);
      unpack8(hp ? *(const u32x4*)(q - DFF2) : z4, pv);
      unpack8(hn ? *(const u32x4*)(q + DFF2) : z4, nx);
#pragma unroll
      for (int e = 0; e < 8; ++e) {
        const float xx = cw[ci + e] * pv[e] + cw[DFF2 + ci + e] * c[e] + cw[2 * DFF2 + ci + e] * nx[e] + cb[ci + e];
        if (half == 0) av[e] = xx; else vv[e] = xx;
      }
    }
#pragma unroll
    for (int e = 0; e < 8; ++e) res[e] = silu_f(av[e]) * vv[e];
    u32x4 pk = {pack2(res[0], res[1]), pack2(res[2], res[3]), pack2(res[4], res[5]), pack2(res[6], res[7])};
    *(u32x4*)(HID + (size_t)r * DFF + j0) = pk;
  }
}

DI void final_phase(const Params& p, int tid) {
  const int lane = tid & 63, w = __builtin_amdgcn_readfirstlane(tid >> 6);
  f32x4 wv[4];
#pragma unroll
  for (int i = 0; i < 4; ++i) wv[i] = *(const f32x4*)(p.final_norm_w + lane * 4 + 256 * i);
  int r = VB * 4 + w;
  f32x4 v[4];
  if (r < 8 * SEQ) {
#pragma unroll
    for (int i = 0; i < 4; ++i) v[i] = *(const f32x4*)(p.out + (size_t)r * D + lane * 4 + 256 * i);
  }
  while (r < 8 * SEQ) {
    const int rn = r + VG * 4;
    f32x4 vn[4];
    if (rn < 8 * SEQ) {
#pragma unroll
      for (int i = 0; i < 4; ++i) vn[i] = *(const f32x4*)(p.out + (size_t)rn * D + lane * 4 + 256 * i);
    }
    float ss = 0.f;
#pragma unroll
    for (int i = 0; i < 4; ++i) ss += v[i][0] * v[i][0] + v[i][1] * v[i][1] + v[i][2] * v[i][2] + v[i][3] * v[i][3];
#pragma unroll
    for (int o = 32; o > 0; o >>= 1) ss += shfl_idx(ss, lane ^ o);
    const float rstd = rsqrtf(ss * (1.f / D) + EPSN);
    float* dst = p.out + (size_t)r * D;
#pragma unroll
    for (int i = 0; i < 4; ++i) {
      f32x4 o;
      o[0] = v[i][0] * rstd * wv[i][0]; o[1] = v[i][1] * rstd * wv[i][1]; o[2] = v[i][2] * rstd * wv[i][2]; o[3] = v[i][3] * rstd * wv[i][3];
      *(f32x4*)(dst + lane * 4 + 256 * i) = o;
    }
#pragma unroll
    for (int i = 0; i < 4; ++i) v[i] = vn[i];
    r = rn;
  }
}


#define XB_TMO      128
#define XB_XCNT(j)  (256  + 64 * (j))
#define XB_XSUB(j)  (1280 + 64 * (j))
#define XB_XGEN(j)  (2304 + 64 * (j))
#define XB_TOP      3328
#define XB_TOPGEN   3392
#define XCD_BAR_WORDS 3456
#define XB_SPIN_CAP (1u << 22)
#define LAS __attribute__((address_space(3)))
DI unsigned xb_ld(unsigned* p) { return __hip_atomic_load(p, __ATOMIC_RELAXED, __HIP_MEMORY_SCOPE_AGENT); }
DI unsigned xb_add(unsigned* p, unsigned v) { return __hip_atomic_fetch_add(p, v, __ATOMIC_RELAXED, __HIP_MEMORY_SCOPE_AGENT); }
DI unsigned xb_xcc_id() { return (unsigned)__builtin_amdgcn_s_getreg((3 << 11) | 20) & 0xFu; }
#define XB_SPIN(cond, bar) do { unsigned _sp = 0; while (cond) { __builtin_amdgcn_s_sleep(1); \
    if ((++_sp & 255u) == 0u) { if (xb_ld(&(bar)[XB_TMO])) break; if (_sp > XB_SPIN_CAP) { atomicAdd(&(bar)[XB_TMO], 1u); break; } } } } while (0)
struct XcdBarrier { unsigned* bar; unsigned x; volatile LAS unsigned* st; };
DI XcdBarrier xcd_barrier_post(unsigned* bar, volatile LAS unsigned* st) {
  XcdBarrier b; b.bar = bar; b.x = xb_xcc_id(); b.st = st;
  if (threadIdx.x == 0) (void)xb_add(&bar[XB_XCNT(b.x)], 1u);
  return b;
}
DI void xcd_barrier_complete(unsigned* bar, unsigned x, unsigned& nloc, unsigned& nx) {
  const unsigned G = gridDim.x * gridDim.y * gridDim.z;
  unsigned sum, cnt, sp = 0u;
  for (;;) {
    sum = 0u; cnt = 0u;
#pragma unroll 1
    for (unsigned j = 0; j < 16; ++j) { const unsigned c = xb_ld(&bar[XB_XCNT(j)]); sum += c; cnt += (c > 0u) ? 1u : 0u; }
    if (sum == G) break;
    __builtin_amdgcn_s_sleep(1);
    if ((++sp & 255u) == 0u) { if (xb_ld(&bar[XB_TMO])) break; if (sp > XB_SPIN_CAP) { atomicAdd(&bar[XB_TMO], 1u); break; } }
  }
  const unsigned mine = xb_ld(&bar[XB_XCNT(x)]);
  nloc = mine > 0u ? mine : 1u; nx = cnt > 0u ? cnt : 1u;
}
template <bool FIRST>
DI void xcd_barrier_t(const XcdBarrier& b) {
  asm volatile("s_waitcnt vmcnt(0)" ::: "memory");
  __syncthreads();
  if (threadIdx.x == 0) {
    unsigned* bar = b.bar;
    __builtin_amdgcn_s_waitcnt(0);
    unsigned nloc = b.st[0], nx = b.st[1];
    if (FIRST) { xcd_barrier_complete(bar, b.x, nloc, nx); b.st[0] = nloc; b.st[1] = nx; }
    const unsigned old = xb_add(&bar[XB_XSUB(b.x)], 1u);
    const unsigned gen = old / nloc;
    if (old + 1u == (gen + 1u) * nloc) {
      __builtin_amdgcn_fence(__ATOMIC_RELEASE, "agent");
      asm volatile("s_waitcnt vmcnt(0)" ::: "memory");
      const unsigned og = xb_add(&bar[XB_TOP], 1u);
      const unsigned tg = og / nx;
      if (og + 1u == (tg + 1u) * nx) xb_add(&bar[XB_TOPGEN], 1u);
      else XB_SPIN(xb_ld(&bar[XB_TOPGEN]) == tg, bar);
      __builtin_amdgcn_fence(__ATOMIC_ACQUIRE, "agent");
      xb_add(&bar[XB_XGEN(b.x)], 1u);
      asm volatile("s_waitcnt vmcnt(0)" ::: "memory");
    } else {
      XB_SPIN(xb_ld(&bar[XB_XGEN(b.x)]) == gen, bar);
      __builtin_amdgcn_fence(__ATOMIC_ACQUIRE, "agent");
      asm volatile("s_waitcnt vmcnt(0)" ::: "memory");
    }
  }
  __syncthreads();
}
DI void xcd_barrier(const XcdBarrier& b) { xcd_barrier_t<false>(b); }

__global__ void __launch_bounds__(512) mega_fwd(Params p) {
  extern __shared__ __attribute__((aligned(16))) unsigned char lds[];
  cg::grid_group grid = cg::this_grid();
  const int tid0 = threadIdx.x;
#define OPQ() ({ int t_ = tid0; asm volatile("" : "+v"(t_)); t_; })
#define OPQV() (OPQ() & 255)
  unsigned char* vlds = lds + VHALF * LDS_HALF;
  volatile LAS unsigned* xst = (volatile LAS unsigned*)(lds + 2 * LDS_HALF);
  if (tid0 == 0) { xst[0] = 0u; xst[1] = 0u; xst[2] = 0u; xst[3] = 0u; xst[4] = 0u; xst[5] = 0u; xst[6] = 0u; xst[7] = 0u; }
  __syncthreads();
  const XcdBarrier xb = xcd_barrier_post(p.BAR, xst);
  phase0(p, vlds, OPQV());
  if (p.pad == 0x7fffffff) grid.sync();
  xcd_barrier_t<true>(xb);
  phase0b(p, OPQV());
  xcd_barrier(xb);
  const int ngroups = 8 / p.nbg;
  const int nl = p.nbg * SEQ, mg = p.nbg * (SEQ + CTXL);
  for (int g = 0; g < ngroups; ++g) {
    for (int layer = 0; layer < 2; ++layer) {
      const int mrows = layer == 0 ? mg : nl;
      if (layer != 0 || g == 0) {
        norm_phase(p, layer, g, 0, mg, layer == 0 ? p.H2 : p.H, VB, VG, OPQV());
        xcd_barrier(xb);
      }
      inproj_phase(p, layer, g, lds, OPQ());
      xcd_barrier(xb);
      mix_phase(p, layer, g, lds, OPQ());
      xcd_barrier(xb);
      recur_phase(p, OPQV());
      xcd_barrier(xb);
      ssdout_phase(p, layer, g, vlds, OPQV());
      xcd_barrier(xb);
      merge_phase(p, layer, g, mrows, vlds, OPQV());
      xcd_barrier(xb);
      resid_gemm_phase(p, layer, g, mrows, p.MG, D, p.wt_o + (size_t)layer * D * D, 2048, true, vlds, OPQV());
      xcd_barrier(xb);
      norm_phase(p, layer, g, 1, mrows, p.H, VB, VG, OPQV());
      xcd_barrier(xb);
      up_phase(p, layer, mrows, lds, OPQ());
      if (layer == 1 && g + 1 < ngroups) {
        const int ntile = (mrows >> 8) * (DFF2 >> 8);
        const int nbusy = ntile > (int)gridDim.x ? ntile - (int)gridDim.x : 0;
        if ((int)blockIdx.x >= nbusy && nbusy < (int)gridDim.x)
          norm_phase(p, 0, g + 1, 0, mg, p.H2, ((int)blockIdx.x - nbusy) * 2 + VHALF, 2 * ((int)gridDim.x - nbusy), OPQV());
      }
      xcd_barrier(xb);
      act_phase(p, layer, mrows, OPQV());
      xcd_barrier(xb);
      resid_gemm_phase(p, layer, g, mrows, (const bf16_t*)p.ST, DFF, p.wt_down + (size_t)layer * D * DFF, 5120, false, vlds, OPQV());
      xcd_barrier(xb);
    }
  }
  final_phase(p, OPQV());
}

static size_t ws_need(int nbg, size_t* offs) {
  size_t o = 0;
  auto take = [&](size_t bytes) { size_t r = o; o += (bytes + 255) & ~(size_t)255; return r; };
  offs[0] = take((size_t)2 * NINP * D * 2);
  offs[1] = take((size_t)2 * D * D * 2);
  offs[2] = take((size_t)2 * D * D * 2);
  offs[3] = take((size_t)2 * D * D * 2);
  offs[4] = take((size_t)2 * DFF2 * D * 2);
  offs[5] = take((size_t)2 * D * DFF * 2);
  const size_t mg = (size_t)nbg * 2304;
  offs[6] = take(mg * USTR * 2);
  offs[7] = take((size_t)nbg * 8 * 2304 * 128 * 2);
  offs[8] = take((size_t)nbg * 8 * 128 * 2304 * 2);
  offs[9] = take(mg * D * 2);
  offs[10] = take(mg * D * 2);
  offs[11] = take(mg * D * 2);
  offs[12] = take(mg * D * 2);
  offs[13] = take(mg * 32 * 4);
  offs[14] = take((size_t)nbg * 2 * 16 * 18 * 8192 * 4);
  offs[15] = take((size_t)nbg * 2 * 16 * 18 * 4);
  offs[16] = take(mg * 16 * 4);
  offs[17] = take((size_t)8 * CTXL * D * 4);
  offs[18] = take((size_t)8 * 2 * 9 * 6144 * 4);
  offs[19] = take((size_t)2 * 9 * 6144 * 4);
  offs[20] = take((size_t)1024 * 2 * 4);
  offs[21] = take(256);
  offs[22] = take(XCD_BAR_WORDS * 4);
  offs[23] = take((size_t)nbg * 18 * 16 * 512 * 4);
  offs[24] = take(mg * D * 2);
  return o;
}

extern "C" void kernel_launch(void* const* d_in, const int* in_sizes, int n_in, void* d_out, int out_size, void* d_ws,
                              size_t ws_size, hipStream_t stream) {
  static int grid_blocks = 0;
  if (grid_blocks == 0) {
    int dev = 0, cus = 0, per_cu = 0;
    hipGetDevice(&dev);
    hipDeviceGetAttribute(&cus, hipDeviceAttributeMultiprocessorCount, dev);
    hipFuncSetAttribute((const void*)mega_fwd, hipFuncAttributeMaxDynamicSharedMemorySize, LDS_BYTES);
    hipOccupancyMaxActiveBlocksPerMultiprocessor(&per_cu, (const void*)mega_fwd, 512, LDS_BYTES);
    if (per_cu < 1) { fprintf(stderr, "occupancy query returned %d\n", per_cu); per_cu = 1; }
    if (per_cu > 1) per_cu = 1;
    grid_blocks = cus * per_cu;
  }
  size_t offs[32];
  int nbg = 8;
  while (nbg > 1 && ws_need(nbg, offs) > ws_size) nbg >>= 1;
  const size_t need = ws_need(nbg, offs);
  if (need > ws_size) { fprintf(stderr, "workspace too small: need %zu have %zu\n", need, ws_size); return; }
  Params p{};
  const float** ins = (const float**)&p.x;
  for (int i = 0; i < 25; ++i) ins[i] = (const float*)d_in[i];
  p.out = (float*)d_out;
  unsigned char* ws = (unsigned char*)d_ws;
  p.wt_in = (bf16_t*)(ws + offs[0]); p.wt_brs = (bf16_t*)(ws + offs[1]); p.wt_bra = (bf16_t*)(ws + offs[2]);
  p.wt_o = (bf16_t*)(ws + offs[3]); p.wt_up = (bf16_t*)(ws + offs[4]); p.wt_down = (bf16_t*)(ws + offs[5]);
  p.U = (bf16_t*)(ws + offs[6]); p.KK = (bf16_t*)(ws + offs[7]); p.VT = (bf16_t*)(ws + offs[8]);
  p.H = (bf16_t*)(ws + offs[9]); p.YS = (bf16_t*)(ws + offs[10]); p.YA = (bf16_t*)(ws + offs[11]); p.MG = (bf16_t*)(ws + offs[12]);
  p.DT = (float*)(ws + offs[13]); p.ST = (float*)(ws + offs[14]); p.DEC = (float*)(ws + offs[15]); p.SSQ = (float*)(ws + offs[16]);
  p.XC = (float*)(ws + offs[17]); p.MODP = (float*)(ws + offs[18]); p.MOD = (float*)(ws + offs[19]);
  p.ROPE = (float*)(ws + offs[20]); p.LAM = (float*)(ws + offs[21]);
  p.BAR = (unsigned*)(ws + offs[22]);
  p.CSB = (float*)(ws + offs[23]);
  p.H2 = (bf16_t*)(ws + offs[24]);
  p.nbg = nbg; p.pad = 0;
  hipMemsetAsync(p.BAR, 0, XCD_BAR_WORDS * 4, stream);
  void* args[] = {&p};
  hipError_t e = hipLaunchCooperativeKernel((const void*)mega_fwd, dim3(grid_blocks), dim3(512), args, LDS_BYTES, stream);
  if (e != hipSuccess) fprintf(stderr, "cooperative launch failed: %s (grid %d)\n", hipGetErrorString(e), grid_blocks);
}
```

```cpp
#include <hip/hip_runtime.h>
#include <hip/hip_cooperative_groups.h>
#include <cstdio>
#include <cstdint>
namespace cg = cooperative_groups;

#define DI __device__ __forceinline__
typedef unsigned short bf16_t;
typedef short bf16x8 __attribute__((ext_vector_type(8)));
typedef float f32x4 __attribute__((ext_vector_type(4)));
typedef unsigned u32x4 __attribute__((ext_vector_type(4)));
typedef unsigned u32x2 __attribute__((ext_vector_type(2)));

constexpr int D = 1024, SEQ = 2048, CTXL = 256, DFF = 2816, DFF2 = 5632;
constexpr int NIN = 8224, NINP = 8448, USTR = 6144;
constexpr int LDS_HALF = 73728;
constexpr int LDS_BYTES = 2 * LDS_HALF + 32;
#define VHALF __builtin_amdgcn_readfirstlane((int)(threadIdx.x >> 8))
#define VB (VHALF * (int)gridDim.x + (int)blockIdx.x)
#define VG ((int)gridDim.x * 2)
constexpr float EPSN = 1e-6f;
constexpr int CONV_TILES = 9872;

struct Params {
  const float *x, *c, *ctx, *c_ctx, *w_mod, *b_mod, *norm1_w, *w_in, *ssd_conv_w, *ssd_conv_b, *a_log, *dt_bias,
      *ssd_d, *ssd_norm_w, *diff_lambda, *subln_w, *w_br_ssd, *w_br_att, *w_out, *norm2_w, *w_up, *ffn_conv_w,
      *ffn_conv_b, *w_down, *final_norm_w;
  float* out;
  bf16_t *wt_in, *wt_brs, *wt_bra, *wt_o, *wt_up, *wt_down;
  bf16_t *U, *KK, *VT, *H, *YS, *YA, *MG;
  float *DT, *ST, *DEC, *SSQ, *XC, *MODP, *MOD, *ROPE, *LAM, *CSB;
  unsigned* BAR;
  int nbg, pad;
};

typedef __bf16 bf16v2_t __attribute__((ext_vector_type(2)));
typedef float f32v2_t __attribute__((ext_vector_type(2)));
DI unsigned pack2(float a, float b) { f32v2_t v = {a, b}; bf16v2_t r = __builtin_convertvector(v, bf16v2_t); return __builtin_bit_cast(unsigned, r); }
DI bf16_t f2bf(float x) { return (bf16_t)(pack2(x, 0.f) & 0xffffu); }
DI float bf2f(bf16_t h) { return __uint_as_float(((unsigned)h) << 16); }
DI float lo_f(unsigned u) { return __uint_as_float(u << 16); }
DI float hi_f(unsigned u) { return __uint_as_float(u & 0xffff0000u); }
DI void unpack8(u32x4 v, float (&f)[8]) {
  f[0] = lo_f(v.x); f[1] = hi_f(v.x); f[2] = lo_f(v.y); f[3] = hi_f(v.y);
  f[4] = lo_f(v.z); f[5] = hi_f(v.z); f[6] = lo_f(v.w); f[7] = hi_f(v.w);
}
DI float silu_f(float x) { return x * __builtin_amdgcn_rcpf(1.f + __expf(-x)); }
DI float sigm_f(float x) { return __builtin_amdgcn_rcpf(1.f + __expf(-x)); }
DI float softplus_f(float x) { return x > 20.f ? x : log1pf(expf(x)); }
DI float shfl_idx(float v, int src_lane) { return __builtin_bit_cast(float, __builtin_amdgcn_ds_bpermute(src_lane << 2, __builtin_bit_cast(int, v))); }
#define LAS3 __attribute__((address_space(3)))
DI void half_sync(unsigned char* vlds, int tid) {
  __builtin_amdgcn_fence(__ATOMIC_RELEASE, "workgroup");
  if ((tid & 63) == 0) {
    LAS3 unsigned* cnt = (LAS3 unsigned*)((LAS3 unsigned char*)vlds + (VHALF ? (LDS_HALF + 20) : (2 * LDS_HALF + 16)));
    const unsigned old = __hip_atomic_fetch_add(cnt, 1u, __ATOMIC_RELAXED, __HIP_MEMORY_SCOPE_WORKGROUP);
    const unsigned target = (old & ~3u) + 4u;
    while ((int)(__hip_atomic_load(cnt, __ATOMIC_RELAXED, __HIP_MEMORY_SCOPE_WORKGROUP) - target) < 0) __builtin_amdgcn_s_sleep(0);
  }
  __builtin_amdgcn_fence(__ATOMIC_ACQUIRE, "workgroup");
}
#define HSYNC() half_sync(lds, tid)
#define MFMA16(a, b, c) __builtin_amdgcn_mfma_f32_16x16x32_bf16((a), (b), (c), 0, 0, 0)

DI const float* xin_row(const Params& p, int layer, int g, int r) {
  const int nl = p.nbg * SEQ;
  if (r < nl) return (layer == 0 ? p.x : p.out) + ((size_t)g * nl + r) * D;
  return (layer == 0 ? p.ctx : p.XC) + ((size_t)g * p.nbg * CTXL + (r - nl)) * D;
}
DI float* xout_row(const Params& p, int g, int r) {
  const int nl = p.nbg * SEQ;
  if (r < nl) return p.out + ((size_t)g * nl + r) * D;
  return p.XC + ((size_t)g * p.nbg * CTXL + (r - nl)) * D;
}
DI int mod_row(const Params& p, int g, int r) {
  const int nl = p.nbg * SEQ;
  return r < nl ? g * p.nbg + r / SEQ : 8;
}

DI int xcd_lin(int round) {
  const int chunk = gridDim.x >> 3;
  return (round * 8 + (blockIdx.x & 7)) * chunk + (blockIdx.x >> 3);
}
DI void tile_map(int t, int MT, int NT, int& mt, int& nt) {
  const int fb = NT >> 3, rem = NT & 7, full = fb * 8 * MT;
  if (t < full) { const int band = t / (8 * MT), r = t - band * 8 * MT; mt = r >> 3; nt = band * 8 + (r & 7); }
  else { const int r = t - full; mt = r / rem; nt = fb * 8 + r % rem; }
}

template <int NI>
DI void gemm_mainloop(const bf16_t* __restrict__ A, int lda, const bf16_t* __restrict__ B, int ldb, int K,
                      f32x4 (&acc)[NI][4], unsigned char* lds, int tid) {
  bf16_t* sA = (bf16_t*)lds;
  bf16_t* sB = (bf16_t*)(lds + 32768);
  const int lane = tid & 63, w = tid >> 6, wm = w & 1, wn = w >> 1, l15 = lane & 15, quad = lane >> 4;
  u32x4 ra0[4], rb0[NI], ra1[4], rb1[NI];
  const int nk = K >> 6;
  const int srow = tid >> 3, skc = (tid & 7) * 8;
  const bf16_t* Ap = A + (size_t)srow * lda + skc;
  const bf16_t* Bp = B + (size_t)srow * ldb + skc;
  const int soff = srow * 64 + (((tid & 7) ^ (srow & 7)) * 8);
  const int sw7 = l15 & 7;
#define G_LOAD(RA, RB, KT)                                                              \
  _Pragma("unroll") for (int r = 0; r < 4; ++r) {                                       \
    RA[r] = *(const u32x4*)(Ap + (size_t)(32 * r) * lda + (KT) * 64);                   \
    if (r < NI) RB[r] = *(const u32x4*)(Bp + (size_t)(32 * r) * ldb + (KT) * 64);       \
  }
#define G_STORE(RA, RB, BUF)                                                            \
  _Pragma("unroll") for (int r = 0; r < 4; ++r) {                                       \
    *(u32x4*)(sA + (BUF) * 8192 + soff + 32 * r * 64) = RA[r];                          \
    if (r < NI) *(u32x4*)(sB + (BUF) * 8192 + soff + 32 * r * 64) = RB[r];              \
  }
#define G_COMPUTE(BUF)                                                                  \
  {                                                                                     \
    const bf16_t* cA = sA + (BUF) * 8192;                                               \
    const bf16_t* cB = sB + (BUF) * 8192;                                               \
    _Pragma("unroll") for (int ks = 0; ks < 2; ++ks) {                                  \
      bf16x8 af[NI], bfr[4];                                                            \
      _Pragma("unroll") for (int i = 0; i < NI; ++i)                                    \
        af[i] = *(const bf16x8*)(cB + (wn * (NI * 16) + i * 16 + l15) * 64 + (((ks * 4 + quad) ^ sw7) * 8)); \
      _Pragma("unroll") for (int j = 0; j < 4; ++j)                                     \
        bfr[j] = *(const bf16x8*)(cA + (wm * 64 + j * 16 + l15) * 64 + (((ks * 4 + quad) ^ sw7) * 8)); \
      _Pragma("unroll") for (int i = 0; i < NI; ++i)                                    \
        _Pragma("unroll") for (int j = 0; j < 4; ++j) acc[i][j] = MFMA16(af[i], bfr[j], acc[i][j]); \
    }                                                                                   \
  }
  G_LOAD(ra0, rb0, 0);
  if (nk > 1) { G_LOAD(ra1, rb1, 1); }
  G_STORE(ra0, rb0, 0);
  __syncthreads();
  for (int kt = 0; kt < nk; kt += 2) {
    if (kt + 2 < nk) { G_LOAD(ra0, rb0, kt + 2); }
    G_COMPUTE(0);
    if (kt + 1 < nk) { G_STORE(ra1, rb1, 1); }
    __syncthreads();
    if (kt + 1 < nk) {
      if (kt + 3 < nk) { G_LOAD(ra1, rb1, kt + 3); }
      G_COMPUTE(1);
      if (kt + 2 < nk) { G_STORE(ra0, rb0, 0); }
      __syncthreads();
    }
  }
#undef G_LOAD
#undef G_STORE
#undef G_COMPUTE
}

template <int NI>
DI void zero_acc(f32x4 (&acc)[NI][4]) {
#pragma unroll
  for (int i = 0; i < NI; ++i)
#pragma unroll
    for (int j = 0; j < 4; ++j) acc[i][j] = (f32x4){0.f, 0.f, 0.f, 0.f};
}

DI void phase0(const Params& p, unsigned char* lds, int tid) {
  if (VB == 0) {
    for (int idx = tid; idx < 1024; idx += 256) {
      const int pos = idx >> 4, f = idx & 15;
      const float inv = powf(10000.f, -(float)f / 16.f);
      const float ang = (float)pos * inv;
      p.ROPE[idx * 2] = cosf(ang);
      p.ROPE[idx * 2 + 1] = sinf(ang);
    }
    if (tid < 2) {
      const float* lf = p.diff_lambda + tid * 256;
      float s1 = 0.f, s2 = 0.f;
      for (int i = 0; i < 64; ++i) { s1 += lf[i] * lf[64 + i]; s2 += lf[128 + i] * lf[192 + i]; }
      const float lam_init = 0.8f - 0.6f * expf(-0.3f * (float)tid);
      p.LAM[tid * 2] = expf(s1) - expf(s2) + lam_init;
      p.LAM[tid * 2 + 1] = 1.f - lam_init;
    }
  }
  {
    const u32x4 z = {0u, 0u, 0u, 0u};
    for (int i = VB * 256 + tid; i < 2 * 28672; i += VG * 256) {
      const int layer = i / 28672, e = i % 28672;
      *(u32x4*)(p.wt_in + (size_t)layer * NINP * D + (size_t)NIN * D + (size_t)e * 8) = z;
    }
  }
  float* sc = (float*)lds;
  for (int item = VB; item < 384; item += VG) {
    const int l = item / 192, rem = item % 192, nc = rem >> 3, kc = rem & 7;
    for (int idx = tid; idx < 1152; idx += 256) {
      const int r = idx >> 7, k = idx & 127;
      const float cv = r < 8 ? p.c[r * D + kc * 128 + k] : p.c_ctx[kc * 128 + k];
      sc[idx] = cv / (1.f + expf(-cv));
    }
    HSYNC();
    float a0 = 0, a1 = 0, a2 = 0, a3 = 0, a4 = 0, a5 = 0, a6 = 0, a7 = 0, a8 = 0;
    const int n = nc * 256 + tid;
    const float* wp = p.w_mod + ((size_t)l * D + kc * 128) * 6144 + n;
#pragma unroll 8
    for (int k = 0; k < 128; ++k) {
      const float wv = wp[(size_t)k * 6144];
      a0 += sc[k] * wv; a1 += sc[128 + k] * wv; a2 += sc[256 + k] * wv; a3 += sc[384 + k] * wv; a4 += sc[512 + k] * wv;
      a5 += sc[640 + k] * wv; a6 += sc[768 + k] * wv; a7 += sc[896 + k] * wv; a8 += sc[1024 + k] * wv;
    }
    float* op = p.MODP + ((size_t)(kc * 2 + l) * 9) * 6144 + n;
    op[0] = a0; op[6144] = a1; op[2 * 6144] = a2; op[3 * 6144] = a3; op[4 * 6144] = a4;
    op[5 * 6144] = a5; op[6 * 6144] = a6; op[7 * 6144] = a7; op[8 * 6144] = a8;
    HSYNC();
  }
  float* tile = (float*)lds;
  for (int item = VB; item < 2 * CONV_TILES; item += VG) {
    const int layer = item / CONV_TILES;
    int t = item % CONV_TILES;
    const float* src; bf16_t* dst; const float* scale = nullptr; int ld, sc0, dr0, ncols, K;
    if (t < 4112) {
      src = p.w_in + (size_t)layer * D * NIN; dst = p.wt_in + (size_t)layer * NINP * D; ld = NIN; K = D;
      if (t < 1536) { sc0 = 0; dr0 = 0; ncols = 3072; }
      else if (t < 3072) { t -= 1536; sc0 = 3104; dr0 = 3072; ncols = 3072; }
      else if (t < 4096) { t -= 3072; sc0 = 6176; dr0 = 6144; ncols = 2048; }
      else { t -= 4096; sc0 = 3072; dr0 = 8192; ncols = 32; }
    } else if (t < 4112 + 1536) {
      t -= 4112; const int which = t >> 9; t &= 511;
      ld = D; K = D; sc0 = 0; dr0 = 0; ncols = D;
      if (which == 0) { src = p.w_br_ssd + (size_t)layer * D * D; dst = p.wt_brs + (size_t)layer * D * D; scale = p.ssd_norm_w + layer * D; }
      else if (which == 1) { src = p.w_br_att + (size_t)layer * D * D; dst = p.wt_bra + (size_t)layer * D * D; }
      else { src = p.w_out + (size_t)layer * D * D; dst = p.wt_o + (size_t)layer * D * D; }
    } else if (t < 4112 + 1536 + 2816) {
      t -= 4112 + 1536;
      src = p.w_up + (size_t)layer * D * DFF2; dst = p.wt_up + (size_t)layer * DFF2 * D; ld = DFF2; K = D; sc0 = 0; dr0 = 0; ncols = DFF2;
    } else {
      t -= 4112 + 1536 + 2816;
      src = p.w_down + (size_t)layer * DFF * D; dst = p.wt_down + (size_t)layer * D * DFF; ld = D; K = DFF; sc0 = 0; dr0 = 0; ncols = D;
    }
    const int nct = ncols >> 5;
    const int tn = t % nct, tk = t / nct;
    const int k0 = tk * 64, n0 = tn * 32;
#pragma unroll
    for (int i = 0; i < 2; ++i) {
      const int kk = (tid >> 3) + 32 * i, n4 = (tid & 7) * 4;
      f32x4 v = *(const f32x4*)(src + (size_t)(k0 + kk) * ld + sc0 + n0 + n4);
      if (scale) { const float sv = scale[k0 + kk]; v[0] *= sv; v[1] *= sv; v[2] *= sv; v[3] *= sv; }
      tile[kk * 33 + n4] = v[0]; tile[kk * 33 + n4 + 1] = v[1]; tile[kk * 33 + n4 + 2] = v[2]; tile[kk * 33 + n4 + 3] = v[3];
    }
    HSYNC();
    {
      const int nn = tid >> 3, k8 = (tid & 7) * 8;
      const float* tp = tile + k8 * 33 + nn;
      u32x4 pk = {pack2(tp[0], tp[33]), pack2(tp[66], tp[99]), pack2(tp[132], tp[165]), pack2(tp[198], tp[231])};
      *(u32x4*)(dst + (size_t)(dr0 + n0 + nn) * K + k0 + k8) = pk;
    }
    HSYNC();
  }
}

DI void phase0b(const Params& p, int tid) {
  for (int i = VB * 256 + tid; i < 2 * 9 * 6144; i += VG * 256) {
    const int n = i % 6144, lr = i / 6144, l = lr / 9, r = lr % 9;
    float s = p.b_mod[l * 6144 + n];
#pragma unroll
    for (int kc = 0; kc < 8; ++kc) s += p.MODP[((size_t)(kc * 2 + l) * 9 + r) * 6144 + n];
    p.MOD[i] = s;
  }
}

DI void norm_phase(const Params& p, int layer, int g, int which, int nrows, int tid) {
  const int lane = tid & 63, w = __builtin_amdgcn_readfirstlane(tid >> 6);
  const float* nw = (which == 0 ? p.norm1_w : p.norm2_w) + layer * D;
  bf16_t* __restrict__ Hout = p.H;
  int r = VB * 4 + w;
  f32x4 v[4];
  if (r < nrows) {
    const float* src = which == 0 ? xin_row(p, layer, g, r) : xout_row(p, g, r);
#pragma unroll
    for (int i = 0; i < 4; ++i) v[i] = *(const f32x4*)(src + lane * 4 + 256 * i);
  }
  while (r < nrows) {
    const int rn = r + VG * 4;
    f32x4 vn[4];
    if (rn < nrows) {
      const float* srcn = which == 0 ? xin_row(p, layer, g, rn) : xout_row(p, g, rn);
#pragma unroll
      for (int i = 0; i < 4; ++i) vn[i] = *(const f32x4*)(srcn + lane * 4 + 256 * i);
    }
    const float* mod = p.MOD + (size_t)(layer * 9 + mod_row(p, g, r)) * 6144 + (which ? 3072 : 0);
    f32x4 wv[4], sh[4], scv[4];
#pragma unroll
    for (int i = 0; i < 4; ++i) {
      const int col = lane * 4 + 256 * i;
      wv[i] = *(const f32x4*)(nw + col); sh[i] = *(const f32x4*)(mod + col); scv[i] = *(const f32x4*)(mod + 1024 + col);
    }
    float ss = 0.f;
#pragma unroll
    for (int i = 0; i < 4; ++i) ss += v[i][0] * v[i][0] + v[i][1] * v[i][1] + v[i][2] * v[i][2] + v[i][3] * v[i][3];
#pragma unroll
    for (int o = 32; o > 0; o >>= 1) ss += shfl_idx(ss, lane ^ o);
    const float rstd = rsqrtf(ss * (1.f / D) + EPSN);
#pragma unroll
    for (int i = 0; i < 4; ++i) {
      const int col = lane * 4 + 256 * i;
      float o0 = v[i][0] * rstd * wv[i][0] * (1.f + scv[i][0]) + sh[i][0];
      float o1 = v[i][1] * rstd * wv[i][1] * (1.f + scv[i][1]) + sh[i][1];
      float o2 = v[i][2] * rstd * wv[i][2] * (1.f + scv[i][2]) + sh[i][2];
      float o3 = v[i][3] * rstd * wv[i][3] * (1.f + scv[i][3]) + sh[i][3];
      u32x2 pk = {pack2(o0, o1), pack2(o2, o3)};
      *(u32x2*)(Hout + (size_t)r * D + col) = pk;
    }
#pragma unroll
    for (int i = 0; i < 4; ++i) v[i] = vn[i];
    r = rn;
  }
}


DI void conv_silu8(const bf16_t* __restrict__ Up, bool hp, bool hn, const float* __restrict__ cw, const float* __restrict__ cb,
                   int ci, float (&o)[8]) {
  const u32x4 z4 = {0u, 0u, 0u, 0u};
  const u32x4 cur = *(const u32x4*)Up;
  const u32x4 prv = hp ? *(const u32x4*)(Up - USTR) : z4;
  const u32x4 nxt = hn ? *(const u32x4*)(Up + USTR) : z4;
  float c[8], pv[8], nx[8];
  unpack8(cur, c); unpack8(prv, pv); unpack8(nxt, nx);
  const f32x4 w0a = *(const f32x4*)(cw + ci), w0b = *(const f32x4*)(cw + ci + 4);
  const f32x4 w1a = *(const f32x4*)(cw + 2048 + ci), w1b = *(const f32x4*)(cw + 2048 + ci + 4);
  const f32x4 w2a = *(const f32x4*)(cw + 4096 + ci), w2b = *(const f32x4*)(cw + 4096 + ci + 4);
  const f32x4 ba = *(const f32x4*)(cb + ci), bb = *(const f32x4*)(cb + ci + 4);
#pragma unroll
  for (int e = 0; e < 4; ++e) {
    const float xa = w0a[e] * pv[e] + w1a[e] * c[e] + w2a[e] * nx[e] + ba[e];
    const float xb = w0b[e] * pv[4 + e] + w1b[e] * c[4 + e] + w2b[e] * nx[4 + e] + bb[e];
    o[e] = silu_f(xa); o[4 + e] = silu_f(xb);
  }
}

DI int chunk_row0(const Params& p, int lb, int cid) {
  return cid < 2 ? p.nbg * SEQ + lb * CTXL + cid * 128 : lb * SEQ + (cid - 2) * 128;
}

DI void ssd_scan_prep(const Params& p, int layer, int row0, int h, float* fl, unsigned char* lds, int tid) {
  float* dtf = fl; float* dtb = fl + 128; float* csf = fl + 256; float* rsb = fl + 384;
  if (tid < 128) {
    const float rf = p.DT[(size_t)(row0 + tid) * 32 + h] + p.dt_bias[layer * 32 + h];
    const float rb = p.DT[(size_t)(row0 + tid) * 32 + 16 + h] + p.dt_bias[layer * 32 + 16 + h];
    dtf[tid] = softplus_f(rf); dtb[tid] = softplus_f(rb);
  }
  HSYNC();
  if (tid < 64) {
    const float Af = -expf(p.a_log[layer * 32 + h]), Ab = -expf(p.a_log[layer * 32 + 16 + h]);
    const float v0 = dtf[2 * tid] * Af, v1 = dtf[2 * tid + 1] * Af;
    const float s = v0 + v1;
    float inc = s;
#pragma unroll
    for (int o = 1; o < 64; o <<= 1) { const float t = shfl_idx(inc, tid >= o ? tid - o : tid); if (tid >= o) inc += t; }
    const float ex = inc - s;
    csf[2 * tid] = ex + v0; csf[2 * tid + 1] = ex + v0 + v1;
    const float w0 = dtb[2 * tid] * Ab, w1 = dtb[2 * tid + 1] * Ab;
    const float s2 = w0 + w1;
    float inc2 = s2;
#pragma unroll
    for (int o = 1; o < 64; o <<= 1) { const float t = shfl_idx(inc2, tid + o < 64 ? tid + o : tid); if (tid + o < 64) inc2 += t; }
    const float ex2 = inc2 - s2;
    rsb[2 * tid + 1] = ex2 + w1; rsb[2 * tid] = ex2 + w1 + w0;
  }
  HSYNC();
}

DI void ssd_state_item(const Params& p, int layer, int lb, int cid, int h, unsigned char* lds, int tid) {
  bf16_t* XfT = (bf16_t*)lds;
  bf16_t* XbT = (bf16_t*)(lds + 17408);
  bf16_t* BT = (bf16_t*)(lds + 34816);
  float* fl = (float*)(lds + 69632);
  const int lane = tid & 63, w = tid >> 6, l15 = lane & 15, quad = lane >> 4;
  const int row0 = chunk_row0(p, lb, cid);
  const int seqlen = cid < 2 ? CTXL : SEQ;
  const int t0 = cid < 2 ? cid * 128 : (cid - 2) * 128;
  const int grp = h >> 2;
  const float* cw = p.ssd_conv_w + layer * 3 * 2048;
  const float* cb = p.ssd_conv_b + layer * 2048;
  ssd_scan_prep(p, layer, row0, h, fl, lds, tid);
  if (tid < 128) *(f32x4*)(p.CSB + (size_t)((lb * 18 + cid) * 16 + h) * 512 + tid * 4) = *(const f32x4*)(fl + tid * 4);
  const float* dtf = fl; const float* dtb = fl + 128; const float* csf = fl + 256; const float* rsb = fl + 384;
  const float cf_end = csf[127], rb_0 = rsb[0];
#pragma unroll 4
  for (int r = 0; r < 4; ++r) {
    const int unit = tid + 256 * r, cgp = unit & 7, l = unit >> 3;
    const int ci = h * 64 + cgp * 8;
    float o[8];
    conv_silu8(p.U + (size_t)(row0 + l) * USTR + 1024 + ci, (t0 + l) > 0, (t0 + l) < seqlen - 1, cw, cb, ci, o);
    const float wf = __expf(cf_end - csf[l]) * dtf[l], wb = __expf(rb_0 - rsb[l]) * dtb[l];
#pragma unroll
    for (int e = 0; e < 8; ++e) {
      XfT[(cgp * 8 + e) * 136 + l] = f2bf(o[e] * wf);
      XbT[(cgp * 8 + e) * 136 + l] = f2bf(o[e] * wb);
    }
  }
#pragma unroll 4
  for (int r = 0; r < 8; ++r) {
    const int unit = tid + 256 * r, cgp = unit & 15, l = unit >> 4;
    const int ci = 1024 + grp * 128 + cgp * 8;
    float o[8];
    conv_silu8(p.U + (size_t)(row0 + l) * USTR + 1024 + ci, (t0 + l) > 0, (t0 + l) < seqlen - 1, cw, cb, ci, o);
#pragma unroll
    for (int e = 0; e < 8; ++e) BT[(cgp * 8 + e) * 136 + l] = f2bf(o[e]);
  }
  HSYNC();
  f32x4 acc[2][4][2];
#pragma unroll
  for (int d = 0; d < 2; ++d)
#pragma unroll
    for (int pt = 0; pt < 4; ++pt)
#pragma unroll
      for (int n2 = 0; n2 < 2; ++n2) acc[d][pt][n2] = (f32x4){0.f, 0.f, 0.f, 0.f};
#pragma unroll
  for (int ks = 0; ks < 4; ++ks) {
    bf16x8 bb[2];
#pragma unroll
    for (int n2 = 0; n2 < 2; ++n2) bb[n2] = *(const bf16x8*)(BT + ((2 * w + n2) * 16 + l15) * 136 + ks * 32 + quad * 8);
#pragma unroll
    for (int pt = 0; pt < 4; ++pt) {
      const bf16x8 af = *(const bf16x8*)(XfT + (pt * 16 + l15) * 136 + ks * 32 + quad * 8);
      const bf16x8 ab = *(const bf16x8*)(XbT + (pt * 16 + l15) * 136 + ks * 32 + quad * 8);
#pragma unroll
      for (int n2 = 0; n2 < 2; ++n2) {
        acc[0][pt][n2] = MFMA16(af, bb[n2], acc[0][pt][n2]);
        acc[1][pt][n2] = MFMA16(ab, bb[n2], acc[1][pt][n2]);
      }
    }
  }
#pragma unroll
  for (int d = 0; d < 2; ++d) {
    bf16_t* sp = (bf16_t*)p.ST + ((size_t)(((lb * 2 + d) * 16 + h) * 18 + cid)) * 8192;
#pragma unroll
    for (int pt = 0; pt < 4; ++pt)
#pragma unroll
      for (int n2 = 0; n2 < 2; ++n2)
#pragma unroll
        for (int reg = 0; reg < 4; ++reg)
          sp[(pt * 16 + quad * 4 + reg) * 128 + (2 * w + n2) * 16 + l15] = f2bf(acc[d][pt][n2][reg]);
  }
  if (tid == 0) {
    p.DEC[((lb * 2 + 0) * 16 + h) * 18 + cid] = expf(cf_end);
    p.DEC[((lb * 2 + 1) * 16 + h) * 18 + cid] = expf(rb_0);
  }
  HSYNC();
}

DI void attn_item(const Params& p, int layer, int lb, int h, int qb, bool is_ctx, unsigned char* lds, int tid) {
  bf16_t* Ks = (bf16_t*)lds;
  bf16_t* Vs = (bf16_t*)(lds + 34816);
  float* XB = (float*)lds;
  const int lane = tid & 63, w = tid >> 6, l15 = lane & 15, quad = lane >> 4;
  const int comp = w >> 1, qh = w & 1;
  const int nl = p.nbg * SEQ;
  const int ntiles = is_ctx ? 4 : 36;
  const int qrow0 = (is_ctx ? nl + lb * CTXL : lb * SEQ) + qb * 64;
  const bf16_t* KKp = p.KK + (size_t)(lb * 8 + h) * 2304 * 128;
  const bf16_t* VTp = p.VT + (size_t)(lb * 8 + h) * 128 * 2304;
  bf16x8 Qf[2][2];
#pragma unroll
  for (int qt = 0; qt < 2; ++qt)
#pragma unroll
    for (int ks = 0; ks < 2; ++ks)
      Qf[qt][ks] = *(const bf16x8*)(p.U + (size_t)(qrow0 + qh * 32 + qt * 16 + l15) * USTR + 3072 + h * 128 + comp * 64 + ks * 32 + quad * 8);
  f32x4 O[8][2];
#pragma unroll
  for (int et = 0; et < 8; ++et) { O[et][0] = (f32x4){0.f, 0.f, 0.f, 0.f}; O[et][1] = (f32x4){0.f, 0.f, 0.f, 0.f}; }
  float mrun[2] = {-1e30f, -1e30f}, lsum[2] = {0.f, 0.f};
  const float CS = 0.125f * 1.44269504088896f;
  u32x4 rk[4], rv[4];
#pragma unroll
  for (int r = 0; r < 4; ++r) {
    const int q = tid + 256 * r;
    rk[r] = *(const u32x4*)(KKp + (size_t)(q >> 4) * 128 + (q & 15) * 8);
    rv[r] = *(const u32x4*)(VTp + (size_t)(q >> 3) * 2304 + (q & 7) * 8);
  }
#pragma unroll
  for (int r = 0; r < 4; ++r) {
    const int q = tid + 256 * r;
    *(u32x4*)(Ks + (q >> 4) * 136 + (q & 15) * 8) = rk[r];
    *(u32x4*)(Vs + (q >> 3) * 72 + (q & 7) * 8) = rv[r];
  }
  HSYNC();
  for (int kt = 0; kt < ntiles; ++kt) {
    const int cur = kt & 1;
    if (kt + 1 < ntiles) {
#pragma unroll
      for (int r = 0; r < 4; ++r) {
        const int q = tid + 256 * r;
        rk[r] = *(const u32x4*)(KKp + (size_t)((kt + 1) * 64 + (q >> 4)) * 128 + (q & 15) * 8);
        rv[r] = *(const u32x4*)(VTp + (size_t)(q >> 3) * 2304 + (kt + 1) * 64 + (q & 7) * 8);
      }
    }
    const bf16_t* cK = Ks + cur * 8704;
    const bf16_t* cV = Vs + cur * 9216;
    f32x4 S[4][2];
#pragma unroll
    for (int t = 0; t < 4; ++t) { S[t][0] = (f32x4){0.f, 0.f, 0.f, 0.f}; S[t][1] = (f32x4){0.f, 0.f, 0.f, 0.f}; }
#pragma unroll
    for (int ks = 0; ks < 2; ++ks)
#pragma unroll
      for (int t = 0; t < 4; ++t) {
        const bf16x8 a = *(const bf16x8*)(cK + (t * 16 + l15) * 136 + comp * 64 + ks * 32 + quad * 8);
        S[t][0] = MFMA16(a, Qf[0][ks], S[t][0]);
        S[t][1] = MFMA16(a, Qf[1][ks], S[t][1]);
      }
    bf16x8 Pf[2][2];
#pragma unroll
    for (int qt = 0; qt < 2; ++qt) {
      float mx = S[0][qt][0];
#pragma unroll
      for (int t = 0; t < 4; ++t)
#pragma unroll
        for (int reg = 0; reg < 4; ++reg) mx = fmaxf(mx, S[t][qt][reg]);
      mx = fmaxf(mx, shfl_idx(mx, lane ^ 16));
      mx = fmaxf(mx, shfl_idx(mx, lane ^ 32));
      const float mxc = mx * CS;
      const bool need = mxc - mrun[qt] > 8.f;
      if (__builtin_amdgcn_ballot_w64(need) != 0ull) {
        const float mnew = fmaxf(mrun[qt], mxc);
        const float alpha = __builtin_amdgcn_exp2f(mrun[qt] - mnew);
        mrun[qt] = mnew;
        lsum[qt] *= alpha;
#pragma unroll
        for (int et = 0; et < 8; ++et) { O[et][qt][0] *= alpha; O[et][qt][1] *= alpha; O[et][qt][2] *= alpha; O[et][qt][3] *= alpha; }
      }
      const float mc = mrun[qt];
      float ps = 0.f;
      float pv[4][4];
#pragma unroll
      for (int t = 0; t < 4; ++t)
#pragma unroll
        for (int reg = 0; reg < 4; ++reg) { pv[t][reg] = __builtin_amdgcn_exp2f(S[t][qt][reg] * CS - mc); ps += pv[t][reg]; }
      lsum[qt] += ps;
#pragma unroll
      for (int k2 = 0; k2 < 2; ++k2) {
        u32x4 pk = {pack2(pv[2 * k2][0], pv[2 * k2][1]), pack2(pv[2 * k2][2], pv[2 * k2][3]),
                    pack2(pv[2 * k2 + 1][0], pv[2 * k2 + 1][1]), pack2(pv[2 * k2 + 1][2], pv[2 * k2 + 1][3])};
        Pf[qt][k2] = __builtin_bit_cast(bf16x8, pk);
      }
    }
#pragma unroll
    for (int k2 = 0; k2 < 2; ++k2)
#pragma unroll
      for (int et = 0; et < 8; ++et) {
        const u32x2 a0 = *(const u32x2*)(cV + (et * 16 + l15) * 72 + (2 * k2) * 16 + quad * 4);
        const u32x2 a1 = *(const u32x2*)(cV + (et * 16 + l15) * 72 + (2 * k2 + 1) * 16 + quad * 4);
        const u32x4 a4 = {a0.x, a0.y, a1.x, a1.y};
        const bf16x8 a = __builtin_bit_cast(bf16x8, a4);
        O[et][0] = MFMA16(a, Pf[0][k2], O[et][0]);
        O[et][1] = MFMA16(a, Pf[1][k2], O[et][1]);
      }
    if (kt + 1 < ntiles) {
      bf16_t* nK = Ks + (cur ^ 1) * 8704;
      bf16_t* nV = Vs + (cur ^ 1) * 9216;
#pragma unroll
      for (int r = 0; r < 4; ++r) {
        const int q = tid + 256 * r;
        *(u32x4*)(nK + (q >> 4) * 136 + (q & 15) * 8) = rk[r];
        *(u32x4*)(nV + (q >> 3) * 72 + (q & 7) * 8) = rv[r];
      }
    }
    HSYNC();
  }
  const float lam = p.LAM[layer * 2], oml = p.LAM[layer * 2 + 1];
#pragma unroll
  for (int qt = 0; qt < 2; ++qt) {
    float l = lsum[qt];
    l += shfl_idx(l, lane ^ 16);
    l += shfl_idx(l, lane ^ 32);
    const float inv = (comp == 1 ? lam : 1.f) / l;
#pragma unroll
    for (int et = 0; et < 8; ++et) { O[et][qt][0] *= inv; O[et][qt][1] *= inv; O[et][qt][2] *= inv; O[et][qt][3] *= inv; }
  }
  if (comp == 1) {
#pragma unroll
    for (int qt = 0; qt < 2; ++qt)
#pragma unroll
      for (int et = 0; et < 8; ++et) *(f32x4*)(XB + (qh * 32 + qt * 16 + l15) * 132 + et * 16 + quad * 4) = O[et][qt];
  }
  HSYNC();
  if (comp == 0) {
    const float* sw = p.subln_w + layer * 128;
#pragma unroll
    for (int qt = 0; qt < 2; ++qt) {
      float ss = 0.f;
#pragma unroll
      for (int et = 0; et < 8; ++et) {
        const f32x4 o1 = *(const f32x4*)(XB + (qh * 32 + qt * 16 + l15) * 132 + et * 16 + quad * 4);
        O[et][qt][0] -= o1[0]; O[et][qt][1] -= o1[1]; O[et][qt][2] -= o1[2]; O[et][qt][3] -= o1[3];
        ss += O[et][qt][0] * O[et][qt][0] + O[et][qt][1] * O[et][qt][1] + O[et][qt][2] * O[et][qt][2] + O[et][qt][3] * O[et][qt][3];
      }
      ss += shfl_idx(ss, lane ^ 16);
      ss += shfl_idx(ss, lane ^ 32);
      const float rstd = rsqrtf(ss * (1.f / 128.f) + EPSN) * oml;
      const int row = qrow0 + qh * 32 + qt * 16 + l15;
#pragma unroll
      for (int et = 0; et < 8; ++et) {
        const f32x4 wv = *(const f32x4*)(sw + et * 16 + quad * 4);
        u32x2 pk = {pack2(O[et][qt][0] * rstd * wv[0], O[et][qt][1] * rstd * wv[1]),
                    pack2(O[et][qt][2] * rstd * wv[2], O[et][qt][3] * rstd * wv[3])};
        *(u32x2*)(p.YA + (size_t)row * D + h * 128 + et * 16 + quad * 4) = pk;
      }
    }
  }
  HSYNC();
}

DI void attn_item8(const Params& p, int layer, int lb, int h, int qb, bool is_ctx, unsigned char* lds, int tid) {
  bf16_t* Ks = (bf16_t*)lds;
  bf16_t* Vs = (bf16_t*)(lds + 34816);
  float* XB = (float*)lds;
  const int lane = tid & 63, w = tid >> 6, l15 = lane & 15, quad = lane >> 4;
  const int comp = w >> 2, qh = w & 3;
  const int nl = p.nbg * SEQ;
  const int ntiles = is_ctx ? 4 : 36;
  const int qrow0 = (is_ctx ? nl + lb * CTXL : lb * SEQ) + qb * 128;
  const bf16_t* KKp = p.KK + (size_t)(lb * 8 + h) * 2304 * 128;
  const bf16_t* VTp = p.VT + (size_t)(lb * 8 + h) * 128 * 2304;
  bf16x8 Qf[2][2];
#pragma unroll
  for (int qt = 0; qt < 2; ++qt)
#pragma unroll
    for (int ks = 0; ks < 2; ++ks)
      Qf[qt][ks] = *(const bf16x8*)(p.U + (size_t)(qrow0 + qh * 32 + qt * 16 + l15) * USTR + 3072 + h * 128 + comp * 64 + ks * 32 + quad * 8);
  f32x4 O[8][2];
#pragma unroll
  for (int et = 0; et < 8; ++et) { O[et][0] = (f32x4){0.f, 0.f, 0.f, 0.f}; O[et][1] = (f32x4){0.f, 0.f, 0.f, 0.f}; }
  float mrun[2] = {-1e30f, -1e30f}, lsum[2] = {0.f, 0.f};
  const float CS = 0.125f * 1.44269504088896f;
  u32x4 rk[2], rv[2];
#pragma unroll
  for (int r = 0; r < 2; ++r) {
    const int q = tid + 512 * r;
    rk[r] = *(const u32x4*)(KKp + (size_t)(q >> 4) * 128 + (q & 15) * 8);
    rv[r] = *(const u32x4*)(VTp + (size_t)(q >> 3) * 2304 + (q & 7) * 8);
  }
#pragma unroll
  for (int r = 0; r < 2; ++r) {
    const int q = tid + 512 * r;
    *(u32x4*)(Ks + (q >> 4) * 136 + (q & 15) * 8) = rk[r];
    *(u32x4*)(Vs + (q >> 3) * 72 + (q & 7) * 8) = rv[r];
  }
  __syncthreads();
  for (int kt = 0; kt < ntiles; ++kt) {
    const int cur = kt & 1;
    if (kt + 1 < ntiles) {
#pragma unroll
      for (int r = 0; r < 2; ++r) {
        const int q = tid + 512 * r;
        rk[r] = *(const u32x4*)(KKp + (size_t)((kt + 1) * 64 + (q >> 4)) * 128 + (q & 15) * 8);
        rv[r] = *(const u32x4*)(VTp + (size_t)(q >> 3) * 2304 + (kt + 1) * 64 + (q & 7) * 8);
      }
    }
    const bf16_t* cK = Ks + cur * 8704;
    const bf16_t* cV = Vs + cur * 9216;
    f32x4 S[4][2];
#pragma unroll
    for (int t = 0; t < 4; ++t) { S[t][0] = (f32x4){0.f, 0.f, 0.f, 0.f}; S[t][1] = (f32x4){0.f, 0.f, 0.f, 0.f}; }
#pragma unroll
    for (int ks = 0; ks < 2; ++ks)
#pragma unroll
      for (int t = 0; t < 4; ++t) {
        const bf16x8 a = *(const bf16x8*)(cK + (t * 16 + l15) * 136 + comp * 64 + ks * 32 + quad * 8);
        S[t][0] = MFMA16(a, Qf[0][ks], S[t][0]);
        S[t][1] = MFMA16(a, Qf[1][ks], S[t][1]);
      }
    bf16x8 Pf[2][2];
#pragma unroll
    for (int qt = 0; qt < 2; ++qt) {
      float mx = S[0][qt][0];
#pragma unroll
      for (int t = 0; t < 4; ++t)
#pragma unroll
        for (int reg = 0; reg < 4; ++reg) mx = fmaxf(mx, S[t][qt][reg]);
      mx = fmaxf(mx, shfl_idx(mx, lane ^ 16));
      mx = fmaxf(mx, shfl_idx(mx, lane ^ 32));
      const float mxc = mx * CS;
      const bool need = mxc - mrun[qt] > 8.f;
      if (__builtin_amdgcn_ballot_w64(need) != 0ull) {
        const float mnew = fmaxf(mrun[qt], mxc);
        const float alpha = __builtin_amdgcn_exp2f(mrun[qt] - mnew);
        mrun[qt] = mnew;
        lsum[qt] *= alpha;
#pragma unroll
        for (int et = 0; et < 8; ++et) { O[et][qt][0] *= alpha; O[et][qt][1] *= alpha; O[et][qt][2] *= alpha; O[et][qt][3] *= alpha; }
      }
      const float mc = mrun[qt];
      float ps = 0.f;
      float pv[4][4];
#pragma unroll
      for (int t = 0; t < 4; ++t)
#pragma unroll
        for (int reg = 0; reg < 4; ++reg) { pv[t][reg] = __builtin_amdgcn_exp2f(S[t][qt][reg] * CS - mc); ps += pv[t][reg]; }
      lsum[qt] += ps;
#pragma unroll
      for (int k2 = 0; k2 < 2; ++k2) {
        u32x4 pk = {pack2(pv[2 * k2][0], pv[2 * k2][1]), pack2(pv[2 * k2][2], pv[2 * k2][3]),
                    pack2(pv[2 * k2 + 1][0], pv[2 * k2 + 1][1]), pack2(pv[2 * k2 + 1][2], pv[2 * k2 + 1][3])};
        Pf[qt][k2] = __builtin_bit_cast(bf16x8, pk);
      }
    }
#pragma unroll
    for (int k2 = 0; k2 < 2; ++k2)
#pragma unroll
      for (int et = 0; et < 8; ++et) {
        const u32x2 a0 = *(const u32x2*)(cV + (et * 16 + l15) * 72 + (2 * k2) * 16 + quad * 4);
        const u32x2 a1 = *(const u32x2*)(cV + (et * 16 + l15) * 72 + (2 * k2 + 1) * 16 + quad * 4);
        const u32x4 a4 = {a0.x, a0.y, a1.x, a1.y};
        const bf16x8 a = __builtin_bit_cast(bf16x8, a4);
        O[et][0] = MFMA16(a, Pf[0][k2], O[et][0]);
        O[et][1] = MFMA16(a, Pf[1][k2], O[et][1]);
      }
    if (kt + 1 < ntiles) {
      bf16_t* nK = Ks + (cur ^ 1) * 8704;
      bf16_t* nV = Vs + (cur ^ 1) * 9216;
#pragma unroll
      for (int r = 0; r < 2; ++r) {
        const int q = tid + 512 * r;
        *(u32x4*)(nK + (q >> 4) * 136 + (q & 15) * 8) = rk[r];
        *(u32x4*)(nV + (q >> 3) * 72 + (q & 7) * 8) = rv[r];
      }
    }
    __syncthreads();
  }
  const float lam = p.LAM[layer * 2], oml = p.LAM[layer * 2 + 1];
#pragma unroll
  for (int qt = 0; qt < 2; ++qt) {
    float l = lsum[qt];
    l += shfl_idx(l, lane ^ 16);
    l += shfl_idx(l, lane ^ 32);
    const float inv = (comp == 1 ? lam : 1.f) / l;
#pragma unroll
    for (int et = 0; et < 8; ++et) { O[et][qt][0] *= inv; O[et][qt][1] *= inv; O[et][qt][2] *= inv; O[et][qt][3] *= inv; }
  }
  if (comp == 1) {
#pragma unroll
    for (int qt = 0; qt < 2; ++qt)
#pragma unroll
      for (int et = 0; et < 8; ++et) *(f32x4*)(XB + (qh * 32 + qt * 16 + l15) * 132 + et * 16 + quad * 4) = O[et][qt];
  }
  __syncthreads();
  if (comp == 0) {
    const float* sw = p.subln_w + layer * 128;
#pragma unroll
    for (int qt = 0; qt < 2; ++qt) {
      float ss = 0.f;
#pragma unroll
      for (int et = 0; et < 8; ++et) {
        const f32x4 o1 = *(const f32x4*)(XB + (qh * 32 + qt * 16 + l15) * 132 + et * 16 + quad * 4);
        O[et][qt][0] -= o1[0]; O[et][qt][1] -= o1[1]; O[et][qt][2] -= o1[2]; O[et][qt][3] -= o1[3];
        ss += O[et][qt][0] * O[et][qt][0] + O[et][qt][1] * O[et][qt][1] + O[et][qt][2] * O[et][qt][2] + O[et][qt][3] * O[et][qt][3];
      }
      ss += shfl_idx(ss, lane ^ 16);
      ss += shfl_idx(ss, lane ^ 32);
      const float rstd = rsqrtf(ss * (1.f / 128.f) + EPSN) * oml;
      const int row = qrow0 + qh * 32 + qt * 16 + l15;
#pragma unroll
      for (int et = 0; et < 8; ++et) {
        const f32x4 wv = *(const f32x4*)(sw + et * 16 + quad * 4);
        u32x2 pk = {pack2(O[et][qt][0] * rstd * wv[0], O[et][qt][1] * rstd * wv[1]),
                    pack2(O[et][qt][2] * rstd * wv[2], O[et][qt][3] * rstd * wv[3])};
        *(u32x2*)(p.YA + (size_t)row * D + h * 128 + et * 16 + quad * 4) = pk;
      }
    }
  }
  __syncthreads();
}

DI int inproj_main_tiles(int MT, int NT);
DI void inproj_tile(const Params& p, int layer, int g, int item, unsigned char* lds, int tid_);
DI void mix_phase(const Params& p, int layer, int g, unsigned char* lds, int tid_) {
  const int n_al = p.nbg * 8 * 16;
  const int n_ac = layer == 0 ? p.nbg * 8 * 2 : 0;
  const int n_st = p.nbg * 18 * 16;
  for (int item = blockIdx.x; item < n_al; item += gridDim.x) {
    int tid = tid_;
    asm volatile("" : "+v"(tid));
    attn_item8(p, layer, item >> 7, (item >> 4) & 7, item & 15, false, lds, tid);
  }
  {
    const int cshift = (int)gridDim.x >= 128 ? 64 : 0;
    for (int it = ((int)blockIdx.x - cshift + (int)gridDim.x) % (int)gridDim.x; it < n_ac; it += gridDim.x) {
      int tid = tid_;
      asm volatile("" : "+v"(tid));
      attn_item8(p, layer, it >> 4, (it >> 1) & 7, it & 1, true, lds, tid);
    }
  }
  {
    const int MT = (p.nbg * (SEQ + CTXL)) >> 8, NT = NINP >> 8;
    const int n_main = inproj_main_tiles(MT, NT), ntail = MT * NT - n_main;
    const int back = (int)gridDim.x - 1 - (int)blockIdx.x;
    if (back < ntail) {
      inproj_tile(p, layer, g, n_main + back, lds, tid_);
      __syncthreads();
    }
  }
  unsigned char* vlds = lds + VHALF * LDS_HALF;
  for (int item = VB; item < n_st; item += VG) {
    int tid = tid_ & 255;
    asm volatile("" : "+v"(tid));
    const int hh = item & 15, rest = item >> 4, cid = rest % 18, lb = rest / 18;
    ssd_state_item(p, layer, lb, cid, hh, vlds, tid);
  }
}

DI void recur_phase(const Params& p, int tid) {
  const int total = p.nbg * 2 * 16 * 1024;
  for (int idx = VB * 256 + tid; idx < total; idx += VG * 256) {
    const int lbdh = idx >> 10, e8 = idx & 1023;
    const int dir = (lbdh >> 4) & 1;
    bf16_t* base = (bf16_t*)p.ST + (size_t)lbdh * 18 * 8192 + e8 * 8;
    const float* dec = p.DEC + lbdh * 18;
    u32x4 sv[18];
    float dc[18];
#pragma unroll
    for (int k = 0; k < 18; ++k) {
      const int cid = dir == 0 ? k : (k < 2 ? 1 - k : 19 - k);
      sv[k] = *(const u32x4*)(base + (size_t)cid * 8192);
      dc[k] = dec[cid];
    }
    float zf = 0.f;
    asm volatile("" : "+v"(zf));
    float hst[8] = {zf, zf, zf, zf, zf, zf, zf, zf};
#pragma unroll
    for (int k = 0; k < 18; ++k) {
      const int cid = dir == 0 ? k : (k < 2 ? 1 - k : 19 - k);
      u32x4 pk = {pack2(hst[0], hst[1]), pack2(hst[2], hst[3]), pack2(hst[4], hst[5]), pack2(hst[6], hst[7])};
      *(u32x4*)(base + (size_t)cid * 8192) = pk;
      float sf[8];
      unpack8(sv[k], sf);
#pragma unroll
      for (int e = 0; e < 8; ++e) hst[e] = hst[e] * dc[k] + sf[e];
    }
  }
}

DI void ssd_out_item(const Params& p, int layer, int lb, int cid, int h, unsigned char* lds, int tid) {
  bf16_t* Bs = (bf16_t*)lds;
  bf16_t* XT = (bf16_t*)(lds + 34816);
  float* fl = (float*)(lds + 52224);
  const int lane = tid & 63, w = tid >> 6, l15_ = lane & 15, quad_ = lane >> 4;
  const int row0 = chunk_row0(p, lb, cid);
  const int seqlen = cid < 2 ? CTXL : SEQ;
  const int t0 = cid < 2 ? cid * 128 : (cid - 2) * 128;
  const int grp = h >> 2;
  const float* cw = p.ssd_conv_w + layer * 3 * 2048;
  const float* cb = p.ssd_conv_b + layer * 2048;
  if (tid < 128) *(f32x4*)(fl + tid * 4) = *(const f32x4*)(p.CSB + (size_t)((lb * 18 + cid) * 16 + h) * 512 + tid * 4);
  const float* dtf = fl; const float* dtb = fl + 128; const float* csf = fl + 256; const float* rsb = fl + 384;
#pragma unroll 4
  for (int r = 0; r < 8; ++r) {
    const int unit = tid + 256 * r, cgp = unit & 15, l = unit >> 4;
    const int ci = 1024 + grp * 128 + cgp * 8;
    float o[8];
    conv_silu8(p.U + (size_t)(row0 + l) * USTR + 1024 + ci, (t0 + l) > 0, (t0 + l) < seqlen - 1, cw, cb, ci, o);
    u32x4 pk = {pack2(o[0], o[1]), pack2(o[2], o[3]), pack2(o[4], o[5]), pack2(o[6], o[7])};
    *(u32x4*)(Bs + l * 136 + cgp * 8) = pk;
  }
#pragma unroll 4
  for (int r = 0; r < 4; ++r) {
    const int unit = tid + 256 * r, cgp = unit & 7, l = unit >> 3;
    const int ci = h * 64 + cgp * 8;
    float o[8];
    conv_silu8(p.U + (size_t)(row0 + l) * USTR + 1024 + ci, (t0 + l) > 0, (t0 + l) < seqlen - 1, cw, cb, ci, o);
#pragma unroll
    for (int e = 0; e < 8; ++e) XT[(cgp * 8 + e) * 136 + l] = f2bf(o[e]);
  }
  HSYNC();
  bf16_t* Pw = (bf16_t*)(lds + 54272) + w * (16 * 136);
  const float dsk = p.ssd_d[layer * 16 + h];
#pragma unroll 1
  for (int lt = 0; lt < 2; ++lt) {
    int l15 = l15_, quad = quad_;
    asm volatile("" : "+v"(l15), "+v"(quad));
    const int l = w * 32 + lt * 16 + l15;
    bf16x8 Cf[4];
#pragma unroll
    for (int ks = 0; ks < 4; ++ks) {
      const int ci = 1536 + grp * 128 + ks * 32 + quad * 8;
      float o[8];
      conv_silu8(p.U + (size_t)(row0 + l) * USTR + 1024 + ci, (t0 + l) > 0, (t0 + l) < seqlen - 1, cw, cb, ci, o);
      u32x4 pk = {pack2(o[0], o[1]), pack2(o[2], o[3]), pack2(o[4], o[5]), pack2(o[6], o[7])};
      Cf[ks] = __builtin_bit_cast(bf16x8, pk);
    }
    f32x4 cbT[8];
#pragma unroll
    for (int st = 0; st < 8; ++st) cbT[st] = (f32x4){0.f, 0.f, 0.f, 0.f};
#pragma unroll
    for (int ks = 0; ks < 4; ++ks)
#pragma unroll
      for (int st = 0; st < 8; ++st) {
        const bf16x8 a = *(const bf16x8*)(Bs + (st * 16 + l15) * 136 + ks * 32 + quad * 8);
        cbT[st] = MFMA16(a, Cf[ks], cbT[st]);
      }
    f32x4 Y[4];
#pragma unroll
    for (int pt = 0; pt < 4; ++pt) Y[pt] = (f32x4){0.f, 0.f, 0.f, 0.f};
#pragma unroll
    for (int dir = 0; dir < 2; ++dir) {
      const float cl = dir == 0 ? csf[l] : rsb[l];
#pragma unroll
      for (int st = 0; st < 8; ++st) {
        float pv[4];
#pragma unroll
        for (int reg = 0; reg < 4; ++reg) {
          const int s = st * 16 + quad * 4 + reg;
          const bool ok = dir == 0 ? (s <= l) : (s >= l);
          const float cs_s = dir == 0 ? csf[s] : rsb[s];
          const float dts = dir == 0 ? dtf[s] : dtb[s];
          pv[reg] = ok ? cbT[st][reg] * __expf(fminf(cl - cs_s, 0.f)) * dts : 0.f;
        }
        u32x2 pk = {pack2(pv[0], pv[1]), pack2(pv[2], pv[3])};
        *(u32x2*)(Pw + l15 * 136 + st * 16 + quad * 4) = pk;
      }
      asm volatile("s_waitcnt lgkmcnt(0)" ::: "memory");
#pragma unroll
      for (int ks = 0; ks < 4; ++ks) {
        const bf16x8 b0 = *(const bf16x8*)(Pw + l15 * 136 + ks * 32 + quad * 8);
#pragma unroll
        for (int pt = 0; pt < 4; ++pt) {
          const bf16x8 a = *(const bf16x8*)(XT + (pt * 16 + l15) * 136 + ks * 32 + quad * 8);
          Y[pt] = MFMA16(a, b0, Y[pt]);
        }
      }
      asm volatile("s_waitcnt lgkmcnt(0)" ::: "memory");
    }
#pragma unroll
    for (int dir = 0; dir < 2; ++dir) {
      const bf16_t* hp = (const bf16_t*)p.ST + ((size_t)(((lb * 2 + dir) * 16 + h) * 18 + cid)) * 8192;
      f32x4 T[4];
#pragma unroll
      for (int pt = 0; pt < 4; ++pt) T[pt] = (f32x4){0.f, 0.f, 0.f, 0.f};
#pragma unroll
      for (int ks = 0; ks < 4; ++ks)
#pragma unroll
        for (int pt = 0; pt < 4; ++pt) {
          const bf16x8 a = *(const bf16x8*)(hp + (pt * 16 + l15) * 128 + ks * 32 + quad * 8);
          T[pt] = MFMA16(a, Cf[ks], T[pt]);
        }
      const float e = __expf(dir == 0 ? csf[l] : rsb[l]);
#pragma unroll
      for (int pt = 0; pt < 4; ++pt) { Y[pt][0] += e * T[pt][0]; Y[pt][1] += e * T[pt][1]; Y[pt][2] += e * T[pt][2]; Y[pt][3] += e * T[pt][3]; }
    }
    const int row = row0 + l;
    float ss = 0.f;
#pragma unroll
    for (int pt = 0; pt < 4; ++pt) {
      const int pp = pt * 16 + quad * 4;
      const u32x2 zz = *(const u32x2*)(p.U + (size_t)row * USTR + h * 64 + pp);
      const float z0 = lo_f(zz.x), z1 = hi_f(zz.x), z2 = lo_f(zz.y), z3 = hi_f(zz.y);
      float y0 = Y[pt][0] + dsk * bf2f(XT[(pp + 0) * 136 + l]);
      float y1 = Y[pt][1] + dsk * bf2f(XT[(pp + 1) * 136 + l]);
      float y2 = Y[pt][2] + dsk * bf2f(XT[(pp + 2) * 136 + l]);
      float y3 = Y[pt][3] + dsk * bf2f(XT[(pp + 3) * 136 + l]);
      y0 *= silu_f(z0); y1 *= silu_f(z1); y2 *= silu_f(z2); y3 *= silu_f(z3);
      ss += y0 * y0 + y1 * y1 + y2 * y2 + y3 * y3;
      u32x2 pk = {pack2(y0, y1), pack2(y2, y3)};
      *(u32x2*)(p.YS + (size_t)row * D + h * 64 + pp) = pk;
    }
    ss += shfl_idx(ss, lane ^ 16);
    ss += shfl_idx(ss, lane ^ 32);
    if (quad == 0) p.SSQ[(size_t)row * 16 + h] = ss;
  }
  HSYNC();
}

DI void ssdout_phase(const Params& p, int layer, int g, unsigned char* lds, int tid_) {
  const int cid0 = layer == 0 ? 0 : 2;
  const int ncid = 18 - cid0;
  const int n = p.nbg * ncid * 16;
  for (int item = VB; item < n; item += VG) {
    int tid = tid_;
    asm volatile("" : "+v"(tid));
    const int hh = item & 15, rest = item >> 4, cid = cid0 + rest % ncid, lb = rest / ncid;
    ssd_out_item(p, layer, lb, cid, hh, lds, tid);
  }
}

DI void merge_phase(const Params& p, int layer, int g, int mrows, unsigned char* lds, int tid_) {
  const int MT = mrows >> 7, NT = D >> 6;
  const bf16_t* Bs_ = p.wt_brs + (size_t)layer * D * D;
  const bf16_t* Ba_ = p.wt_bra + (size_t)layer * D * D;
  for (int round = 0; (int)blockIdx.x + round * VG < MT * NT; ++round) {
    const int item = VB + round * VG;
    if (item >= MT * NT) {
      for (int i = 0; i < 2 * (1 + (D >> 6)); ++i) __syncthreads();
      continue;
    }
    int tid = tid_;
    asm volatile("" : "+v"(tid));
    const int lane = tid & 63, w = tid >> 6, wm = w & 1, wn = w >> 1, l15 = lane & 15, quad = lane >> 4;
    const int mt = item % MT, nt = item / MT;
    f32x4 as[2][4], aa[2][4];
    zero_acc<2>(as); zero_acc<2>(aa);
    gemm_mainloop<2>(p.YS + (size_t)mt * 128 * D, D, Bs_ + (size_t)nt * 64 * D, D, D, as, lds, tid);
    gemm_mainloop<2>(p.YA + (size_t)mt * 128 * D, D, Ba_ + (size_t)nt * 64 * D, D, D, aa, lds, tid);
    const int mb = mt * 128 + wm * 64, nb = nt * 64 + wn * 32;
#pragma unroll
    for (int j = 0; j < 4; ++j) {
      const int r = mb + j * 16 + l15;
      float ssq = 0.f;
      const f32x4* sq = (const f32x4*)(p.SSQ + (size_t)r * 16);
#pragma unroll
      for (int q = 0; q < 4; ++q) { const f32x4 t = sq[q]; ssq += t[0] + t[1] + t[2] + t[3]; }
      const float rstd = rsqrtf(ssq * (1.f / D) + EPSN);
#pragma unroll
      for (int i = 0; i < 2; ++i) {
        const int n = nb + i * 16 + quad * 4;
        const u32x2 gs = *(const u32x2*)(p.U + (size_t)r * USTR + 4096 + n);
        const u32x2 ga = *(const u32x2*)(p.U + (size_t)r * USTR + 5120 + n);
        const float m0 = sigm_f(lo_f(gs.x)) * rstd * as[i][j][0] + sigm_f(lo_f(ga.x)) * aa[i][j][0];
        const float m1 = sigm_f(hi_f(gs.x)) * rstd * as[i][j][1] + sigm_f(hi_f(ga.x)) * aa[i][j][1];
        const float m2 = sigm_f(lo_f(gs.y)) * rstd * as[i][j][2] + sigm_f(lo_f(ga.y)) * aa[i][j][2];
        const float m3 = sigm_f(hi_f(gs.y)) * rstd * as[i][j][3] + sigm_f(hi_f(ga.y)) * aa[i][j][3];
        u32x2 pk = {pack2(m0, m1), pack2(m2, m3)};
        *(u32x2*)(p.MG + (size_t)r * D + n) = pk;
      }
    }
  }
}

DI void resid_gemm_phase(const Params& p, int layer, int g, int mrows, const bf16_t* A, int K, const bf16_t* Bt, int gate_off,
                         bool src_is_in, unsigned char* lds, int tid_) {
  const int MT = mrows >> 7, NT = D >> 7;
  for (int round = 0; (int)blockIdx.x + round * VG < MT * NT; ++round) {
    const int item = VB + round * VG;
    if (item >= MT * NT) {
      for (int i = 0; i < 1 + (K >> 6); ++i) __syncthreads();
      continue;
    }
    int tid = tid_;
    asm volatile("" : "+v"(tid));
    const int lane = tid & 63, w = tid >> 6, wm = w & 1, wn = w >> 1, l15 = lane & 15, quad = lane >> 4;
    const int mt = item % MT, nt = item / MT;
    f32x4 acc[4][4];
    zero_acc<4>(acc);
    gemm_mainloop<4>(A + (size_t)mt * 128 * K, K, Bt + (size_t)nt * 128 * K, K, K, acc, lds, tid);
    const int mb = mt * 128 + wm * 64, nb = nt * 128 + wn * 64;
#pragma unroll
    for (int j = 0; j < 4; ++j) {
      const int r = mb + j * 16 + l15;
      const float* src = src_is_in ? xin_row(p, layer, g, r) : xout_row(p, g, r);
      float* dst = xout_row(p, g, r);
      const float* gate = p.MOD + (size_t)(layer * 9 + mod_row(p, g, r)) * 6144 + gate_off;
#pragma unroll
      for (int i = 0; i < 4; ++i) {
        const int n = nb + i * 16 + quad * 4;
        const f32x4 xv = *(const f32x4*)(src + n), gv = *(const f32x4*)(gate + n);
        f32x4 o;
        o[0] = xv[0] + gv[0] * acc[i][j][0]; o[1] = xv[1] + gv[1] * acc[i][j][1];
        o[2] = xv[2] + gv[2] * acc[i][j][2]; o[3] = xv[3] + gv[3] * acc[i][j][3];
        *(f32x4*)(dst + n) = o;
      }
    }
  }
}


DI int g8_lds_byte(int r, int c) {
  const int st = (r >> 4) * 2 + (c >> 5), rr = r & 15, cc = c & 31, ob = rr * 64 + cc * 2;
  return st * 1024 + (ob ^ (((ob >> 9) & 1) << 5));
}
DI void g8_stage_rc(int b, int& R, int& C) {
  const int st = b / 1024, sb = b % 1024, swz = sb ^ (((sb >> 9) & 1) << 5);
  R = (st >> 1) * 16 + swz / 64; C = (st & 1) * 32 + (swz % 64) / 2;
}
DI void gemm8p(const bf16_t* __restrict__ Wp, const bf16_t* __restrict__ Xp, f32x4 (&acc)[2][2][4][2], unsigned char* lds, int tid) {
  constexpr int GK = 1024, GBK = 64, GHALF = 128, GHT = GHALF * GBK;
  bf16_t* shm = (bf16_t*)lds;
#define SA(b, h) (shm + ((b) * 2 + (h)) * GHT)
#define SB(b, h) (shm + (4 + (b) * 2 + (h)) * GHT)
  const int wid = tid >> 6, lane = tid & 63, wr = wid >> 2, wc = wid & 3, fr = lane & 15, fq = lane >> 4;
  int goff0, goff1;
  { int r_, c_; g8_stage_rc(tid * 16, r_, c_); goff0 = r_ * GK + c_; g8_stage_rc(tid * 16 + 8192, r_, c_); goff1 = r_ * GK + c_; }
#define STAGE(P, BASE, br, kt) do { \
    __builtin_amdgcn_global_load_lds((const unsigned*)((BASE) + (br) * GK + (kt) * GBK + goff0), (unsigned*)((char*)(P) + tid * 16), 16, 0, 0); \
    __builtin_amdgcn_global_load_lds((const unsigned*)((BASE) + (br) * GK + (kt) * GBK + goff1), (unsigned*)((char*)(P) + tid * 16 + 8192), 16, 0, 0); } while (0)
#define LDA(dst, b, h) _Pragma("unroll") for (int m = 0; m < 4; ++m) _Pragma("unroll") for (int k = 0; k < 2; ++k) \
    dst[m][k] = *reinterpret_cast<const bf16x8*>((char*)SA(b, h) + g8_lds_byte(wr * 64 + m * 16 + fr, k * 32 + fq * 8))
#define LDB(dst, b, h) _Pragma("unroll") for (int n = 0; n < 2; ++n) _Pragma("unroll") for (int k = 0; k < 2; ++k) \
    dst[n][k] = *reinterpret_cast<const bf16x8*>((char*)SB(b, h) + g8_lds_byte(wc * 32 + n * 16 + fr, k * 32 + fq * 8))
#define MMA(ai, bj, At_, Bt_) do { __builtin_amdgcn_s_setprio(1); \
    _Pragma("unroll") for (int m = 0; m < 4; ++m) _Pragma("unroll") for (int n = 0; n < 2; ++n) _Pragma("unroll") for (int k = 0; k < 2; ++k) \
      acc[ai][bj][m][n] = __builtin_amdgcn_mfma_f32_16x16x32_bf16(At_[m][k], Bt_[n][k], acc[ai][bj][m][n], 0, 0, 0); \
    __builtin_amdgcn_s_setprio(0); } while (0)
#define WAIT_V(n) asm volatile("s_waitcnt vmcnt(" #n ")" ::: "memory")
#define WAIT_L(n) asm volatile("s_waitcnt lgkmcnt(" #n ")" ::: "memory")
#define BAR __builtin_amdgcn_s_barrier()
#define SCHED __builtin_amdgcn_sched_barrier(0)
  bf16x8 At[4][2], B0[2][2], B1[2][2];
  constexpr int nt = GK / GBK;
  STAGE(SB(0, 0), Xp, 0, 0); STAGE(SA(0, 0), Wp, 0, 0);
  STAGE(SB(0, 1), Xp, GHALF, 0); STAGE(SA(0, 1), Wp, GHALF, 0);
  if (wr == 1) BAR;
  WAIT_V(4); BAR;
  STAGE(SB(1, 0), Xp, 0, 1); STAGE(SA(1, 0), Wp, 0, 1); STAGE(SB(1, 1), Xp, GHALF, 1);
  WAIT_V(6); BAR;
  for (int t = 0; t < nt - 2; t += 2) {
    LDB(B0, 0, 0); SCHED; LDA(At, 0, 0); STAGE(SA(1, 1), Wp, GHALF, t + 1);
    WAIT_L(8); BAR; WAIT_L(0); MMA(0, 0, At, B0); BAR; SCHED;
    LDB(B1, 0, 1); STAGE(SB(0, 0), Xp, 0, t + 2);
    BAR; WAIT_L(0); MMA(0, 1, At, B1); BAR;
    LDA(At, 0, 1); STAGE(SA(0, 0), Wp, 0, t + 2);
    BAR; WAIT_L(0); MMA(1, 0, At, B0); BAR; SCHED;
    STAGE(SB(0, 1), Xp, GHALF, t + 2);
    WAIT_V(6); BAR; MMA(1, 1, At, B1); BAR;
    LDB(B0, 1, 0); SCHED; LDA(At, 1, 0); STAGE(SA(0, 1), Wp, GHALF, t + 2);
    WAIT_L(8); BAR; WAIT_L(0); MMA(0, 0, At, B0); BAR; SCHED;
    LDB(B1, 1, 1); STAGE(SB(1, 0), Xp, 0, t + 3);
    BAR; WAIT_L(0); MMA(0, 1, At, B1); BAR;
    LDA(At, 1, 1); STAGE(SA(1, 0), Wp, 0, t + 3);
    BAR; WAIT_L(0); MMA(1, 0, At, B0); BAR; SCHED;
    STAGE(SB(1, 1), Xp, GHALF, t + 3);
    WAIT_V(6); BAR; MMA(1, 1, At, B1); BAR;
  }
  { LDB(B0, 0, 0); LDA(At, 0, 0); STAGE(SA(1, 1), Wp, GHALF, nt - 1);
    BAR; WAIT_L(0); MMA(0, 0, At, B0); BAR;
    LDB(B1, 0, 1); BAR; WAIT_L(0); MMA(0, 1, At, B1); BAR;
    LDA(At, 0, 1); WAIT_V(4); BAR; WAIT_L(0); MMA(1, 0, At, B0); MMA(1, 1, At, B1); BAR; }
  { LDB(B0, 1, 0); LDA(At, 1, 0); WAIT_V(2); BAR; WAIT_L(0); MMA(0, 0, At, B0); BAR;
    LDB(B1, 1, 1); WAIT_V(0); BAR; WAIT_L(0); MMA(0, 1, At, B1); BAR;
    LDA(At, 1, 1); BAR; WAIT_L(0); MMA(1, 0, At, B0); MMA(1, 1, At, B1); BAR; }
  if (wr == 0) BAR;
#undef SA
#undef SB
#undef STAGE
#undef LDA
#undef LDB
#undef MMA
#undef WAIT_V
#undef WAIT_L
#undef BAR
#undef SCHED
}
DI void zero_acc8p(f32x4 (&acc)[2][2][4][2]) {
#pragma unroll
  for (int a = 0; a < 2; ++a)
#pragma unroll
    for (int b = 0; b < 2; ++b)
#pragma unroll
      for (int m = 0; m < 4; ++m) { acc[a][b][m][0] = (f32x4){0.f, 0.f, 0.f, 0.f}; acc[a][b][m][1] = (f32x4){0.f, 0.f, 0.f, 0.f}; }
}

DI int inproj_main_tiles(int MT, int NT) {
  const int total = MT * NT, whole = (total / (int)gridDim.x) * (int)gridDim.x;
  return (whole > 0 && whole / MT >= 25 && total - whole <= (int)gridDim.x) ? whole : total;
}
DI void inproj_tile(const Params& p, int layer, int g, int item, unsigned char* lds, int tid_) {
  const int nl = p.nbg * SEQ, mg = p.nbg * (SEQ + CTXL);
  const int MT = mg >> 8;
  const bf16_t* Wt = p.wt_in + (size_t)layer * NINP * D;
  {
    int tid = tid_;
    asm volatile("" : "+v"(tid));
    const int wid = tid >> 6, lane = tid & 63, wr = wid >> 2, wc = wid & 3, fr = lane & 15, fq = lane >> 4;
    const int mt = item % MT, kpos = item / MT;
    const int nt = kpos == 0 ? 32 : (kpos <= 28 ? kpos + 3 : kpos - 29);
    const int m0 = mt * 256, n0 = nt * 256;
    asm volatile("s_waitcnt vmcnt(0)" ::: "memory");
    __syncthreads();
    f32x4 acc[2][2][4][2];
    zero_acc8p(acc);
    gemm8p(Wt + (size_t)n0 * D, p.H + (size_t)m0 * D, acc, lds, tid);
    const bool lat = m0 < nl;
#pragma unroll
    for (int ai = 0; ai < 2; ++ai) {
      const int c0 = n0 + ai * 128 + wr * 64;
      if (c0 >= 3072 && c0 < 5120 && lat) {
#pragma unroll
        for (int bj = 0; bj < 2; ++bj)
#pragma unroll
          for (int ni = 0; ni < 2; ++ni) {
            const int r = m0 + bj * 128 + wc * 32 + ni * 16 + fr, t = r & (SEQ - 1), pr = t >> 6, pc = t & 63;
#pragma unroll
            for (int j = 0; j < 4; ++j) {
              const int f = fq * 4 + j;
              const float cr = p.ROPE[(pr * 16 + f) * 2], sr = p.ROPE[(pr * 16 + f) * 2 + 1];
              const float cc = p.ROPE[(pc * 16 + f) * 2], sc = p.ROPE[(pc * 16 + f) * 2 + 1];
              float x1 = acc[ai][bj][0][ni][j], x2 = acc[ai][bj][1][ni][j];
              acc[ai][bj][0][ni][j] = x1 * cr - x2 * sr; acc[ai][bj][1][ni][j] = x2 * cr + x1 * sr;
              x1 = acc[ai][bj][2][ni][j]; x2 = acc[ai][bj][3][ni][j];
              acc[ai][bj][2][ni][j] = x1 * cc - x2 * sc; acc[ai][bj][3][ni][j] = x2 * cc + x1 * sc;
            }
            asm volatile("" ::: "memory");
          }
      }
    }
    if (n0 < 5120 || (n0 >= 6144 && n0 < 8192)) {
      bf16_t* stg = (bf16_t*)lds + wid * (64 * 136);
#pragma unroll
      for (int ai = 0; ai < 2; ++ai)
#pragma unroll
        for (int bj = 0; bj < 2; ++bj)
#pragma unroll
          for (int ni = 0; ni < 2; ++ni)
#pragma unroll
            for (int mi = 0; mi < 4; ++mi) {
              const f32x4 v = acc[ai][bj][mi][ni];
              u32x2 pk = {pack2(v[0], v[1]), pack2(v[2], v[3])};
              *(u32x2*)(stg + (bj * 32 + ni * 16 + fr) * 136 + ai * 64 + mi * 16 + fq * 4) = pk;
            }
      __syncthreads();
#pragma unroll
      for (int ai = 0; ai < 2; ++ai) {
        const int c0 = n0 + ai * 128 + wr * 64;
#pragma unroll
        for (int k = 0; k < 8; ++k) {
          const int c = lane + 64 * k, rl = c >> 3, cc = c & 7;
          const u32x4 v = *(const u32x4*)(stg + rl * 136 + ai * 64 + cc * 8);
          const int r = m0 + (rl >> 5) * 128 + wc * 32 + (rl & 31);
          bf16_t* dst;
          if (n0 >= 4096 && n0 < 5120) {
            int lb, kj;
            if (lat) { lb = r >> 11; kj = CTXL + (r & (SEQ - 1)); } else { const int rc = r - nl; lb = rc >> 8; kj = rc & 255; }
            const int hh = (c0 - 4096) >> 7, cd0 = (c0 - 4096) & 127;
            dst = p.KK + ((size_t)(lb * 8 + hh) * 2304 + kj) * 128 + cd0;
          } else {
            dst = p.U + (size_t)r * USTR + (n0 < 4096 ? c0 : c0 - 2048);
          }
          *(u32x4*)(dst + cc * 8) = v;
        }
      }
    } else if (n0 < 6144) {
      bf16_t* stg = (bf16_t*)lds + wid * (128 * 72);
#pragma unroll
      for (int ai = 0; ai < 2; ++ai)
#pragma unroll
        for (int bj = 0; bj < 2; ++bj)
#pragma unroll
          for (int ni = 0; ni < 2; ++ni)
#pragma unroll
            for (int mi = 0; mi < 4; ++mi)
#pragma unroll
              for (int j = 0; j < 4; ++j)
                stg[(ai * 64 + mi * 16 + fq * 4 + j) * 72 + bj * 32 + ni * 16 + fr] = f2bf(acc[ai][bj][mi][ni][j]);
      __syncthreads();
#pragma unroll
      for (int k = 0; k < 16; ++k) {
        const int c = lane + 64 * k, el = c >> 3, cc = c & 7;
        const u32x4 v = *(const u32x4*)(stg + el * 72 + cc * 8);
        const int r = m0 + (cc >> 2) * 128 + wc * 32 + (cc & 3) * 8;
        int lb, kj;
        if (lat) { lb = r >> 11; kj = CTXL + (r & (SEQ - 1)); } else { const int rc = r - nl; lb = rc >> 8; kj = rc & 255; }
        const int n = n0 + (el >> 6) * 128 + wr * 64 + (el & 63);
        const int hh = (n - 5120) >> 7, e = (n - 5120) & 127;
        *(u32x4*)(p.VT + ((size_t)(lb * 8 + hh) * 128 + e) * 2304 + kj) = v;
      }
    } else if (n0 == 8192 && wr == 0) {
#pragma unroll
      for (int bj = 0; bj < 2; ++bj)
#pragma unroll
        for (int ni = 0; ni < 2; ++ni) {
          const int r = m0 + bj * 128 + wc * 32 + ni * 16 + fr;
#pragma unroll
          for (int mi = 0; mi < 2; ++mi) *(f32x4*)(p.DT + (size_t)r * 32 + mi * 16 + fq * 4) = acc[0][bj][mi][ni];
        }
    }
  }
}
DI void inproj_phase(const Params& p, int layer, int g, unsigned char* lds, int tid_) {
  const int MT = (p.nbg * (SEQ + CTXL)) >> 8, NT = NINP >> 8;
  const int n_main = inproj_main_tiles(MT, NT);
  for (int item = blockIdx.x; item < n_main; item += gridDim.x) inproj_tile(p, layer, g, item, lds, tid_);
}

DI void up_phase(const Params& p, int layer, int mrows, unsigned char* lds, int tid_) {
  const int MT = mrows >> 8, NT = DFF2 >> 8;
  const bf16_t* Wt = p.wt_up + (size_t)layer * DFF2 * D;
  bf16_t* UF = p.U;
  for (int item = blockIdx.x; item < MT * NT; item += gridDim.x) {
    int tid = tid_;
    asm volatile("" : "+v"(tid));
    const int wid = tid >> 6, lane = tid & 63, wr = wid >> 2, wc = wid & 3, fr = lane & 15, fq = lane >> 4;
    const int mt = item % MT, nt = item / MT;
    const int m0 = mt * 256, n0 = nt * 256;
    asm volatile("s_waitcnt vmcnt(0)" ::: "memory");
    __syncthreads();
    f32x4 acc[2][2][4][2];
    zero_acc8p(acc);
    gemm8p(Wt + (size_t)n0 * D, p.H + (size_t)m0 * D, acc, lds, tid);
    bf16_t* stg = (bf16_t*)lds + wid * (64 * 136);
#pragma unroll
    for (int ai = 0; ai < 2; ++ai)
#pragma unroll
      for (int bj = 0; bj < 2; ++bj)
#pragma unroll
        for (int ni = 0; ni < 2; ++ni)
#pragma unroll
          for (int mi = 0; mi < 4; ++mi) {
            const f32x4 v = acc[ai][bj][mi][ni];
            u32x2 pk = {pack2(v[0], v[1]), pack2(v[2], v[3])};
            *(u32x2*)(stg + (bj * 32 + ni * 16 + fr) * 136 + ai * 64 + mi * 16 + fq * 4) = pk;
          }
    __syncthreads();
#pragma unroll
    for (int ai = 0; ai < 2; ++ai) {
      const int c0 = n0 + ai * 128 + wr * 64;
#pragma unroll
      for (int k = 0; k < 8; ++k) {
        const int c = lane + 64 * k, rl = c >> 3, cc = c & 7;
        const u32x4 v = *(const u32x4*)(stg + rl * 136 + ai * 64 + cc * 8);
        const int r = m0 + (rl >> 5) * 128 + wc * 32 + (rl & 31);
        *(u32x4*)(UF + (size_t)r * DFF2 + c0 + cc * 8) = v;
      }
    }
  }
}

DI void act_phase(const Params& p, int layer, int mrows, int tid) {
  const bf16_t* __restrict__ UF = p.U;
  bf16_t* __restrict__ HID = (bf16_t*)p.ST;
  const int nl = p.nbg * SEQ;
  const float* __restrict__ cw = p.ffn_conv_w + (size_t)layer * 3 * DFF2;
  const float* __restrict__ cb = p.ffn_conv_b + (size_t)layer * DFF2;
  const u32x4 z4 = {0u, 0u, 0u, 0u};
  constexpr int NCH = DFF / 8;
  const int gid = VB * 256 + tid;
  const int slots = (VG * 256) / NCH;
  const int jc = gid % NCH, rslot = gid / NCH;
  if (rslot >= slots) return;
  const int j0 = jc * 8;
  float w0[2][8], w1[2][8], w2[2][8], bb[2][8];
#pragma unroll
  for (int half = 0; half < 2; ++half) {
    const int ci = half * DFF + j0;
#pragma unroll
    for (int e = 0; e < 8; ++e) { w0[half][e] = cw[ci + e]; w1[half][e] = cw[DFF2 + ci + e]; w2[half][e] = cw[2 * DFF2 + ci + e]; bb[half][e] = cb[ci + e]; }
  }
#pragma unroll 2
  for (int r = rslot; r < mrows; r += slots) {
    int t, sl;
    if (r < nl) { t = r & (SEQ - 1); sl = SEQ; } else { t = (r - nl) & (CTXL - 1); sl = CTXL; }
    const bool hp = t > 0, hn = t < sl - 1;
    const bf16_t* up = UF + (size_t)r * DFF2 + j0;
    float av[8], vv[8], res[8];
#pragma unroll
    for (int half = 0; half < 2; ++half) {
      const bf16_t* q = up + half * DFF;
      float c[8], pv[8], nx[8];
      unpack8(*(const u32x4*)q, c);
      unpack8(hp ? *(const u32x4*)(q - DFF2) : z4, pv);
      unpack8(hn ? *(const u32x4*)(q + DFF2) : z4, nx);
#pragma unroll
      for (int e = 0; e < 8; ++e) {
        const float xx = w0[half][e] * pv[e] + w1[half][e] * c[e] + w2[half][e] * nx[e] + bb[half][e];
        if (half == 0) av[e] = xx; else vv[e] = xx;
      }
    }
#pragma unroll
    for (int e = 0; e < 8; ++e) res[e] = silu_f(av[e]) * vv[e];
    u32x4 pk = {pack2(res[0], res[1]), pack2(res[2], res[3]), pack2(res[4], res[5]), pack2(res[6], res[7])};
    *(u32x4*)(HID + (size_t)r * DFF + j0) = pk;
  }
}

DI void final_phase(const Params& p, int tid) {
  const int lane = tid & 63, w = __builtin_amdgcn_readfirstlane(tid >> 6);
  f32x4 wv[4];
#pragma unroll
  for (int i = 0; i < 4; ++i) wv[i] = *(const f32x4*)(p.final_norm_w + lane * 4 + 256 * i);
  int r = VB * 4 + w;
  f32x4 v[4];
  if (r < 8 * SEQ) {
#pragma unroll
    for (int i = 0; i < 4; ++i) v[i] = *(const f32x4*)(p.out + (size_t)r * D + lane * 4 + 256 * i);
  }
  while (r < 8 * SEQ) {
    const int rn = r + VG * 4;
    f32x4 vn[4];
    if (rn < 8 * SEQ) {
#pragma unroll
      for (int i = 0; i < 4; ++i) vn[i] = *(const f32x4*)(p.out + (size_t)rn * D + lane * 4 + 256 * i);
    }
    float ss = 0.f;
#pragma unroll
    for (int i = 0; i < 4; ++i) ss += v[i][0] * v[i][0] + v[i][1] * v[i][1] + v[i][2] * v[i][2] + v[i][3] * v[i][3];
#pragma unroll
    for (int o = 32; o > 0; o >>= 1) ss += shfl_idx(ss, lane ^ o);
    const float rstd = rsqrtf(ss * (1.f / D) + EPSN);
    float* dst = p.out + (size_t)r * D;
#pragma unroll
    for (int i = 0; i < 4; ++i) {
      f32x4 o;
      o[0] = v[i][0] * rstd * wv[i][0]; o[1] = v[i][1] * rstd * wv[i][1]; o[2] = v[i][2] * rstd * wv[i][2]; o[3] = v[i][3] * rstd * wv[i][3];
      *(f32x4*)(dst + lane * 4 + 256 * i) = o;
    }
#pragma unroll
    for (int i = 0; i < 4; ++i) v[i] = vn[i];
    r = rn;
  }
}


#define XB_TMO      128
#define XB_XCNT(j)  (256  + 64 * (j))
#define XB_XSUB(j)  (1280 + 64 * (j))
#define XB_XGEN(j)  (2304 + 64 * (j))
#define XB_TOP      3328
#define XB_TOPGEN   3392
#define XCD_BAR_WORDS 3456
#define XB_SPIN_CAP (1u << 22)
#define LAS __attribute__((address_space(3)))
DI unsigned xb_ld(unsigned* p) { return __hip_atomic_load(p, __ATOMIC_RELAXED, __HIP_MEMORY_SCOPE_AGENT); }
DI unsigned xb_add(unsigned* p, unsigned v) { return __hip_atomic_fetch_add(p, v, __ATOMIC_RELAXED, __HIP_MEMORY_SCOPE_AGENT); }
DI unsigned xb_xcc_id() { return (unsigned)__builtin_amdgcn_s_getreg((3 << 11) | 20) & 0xFu; }
#define XB_SPIN(cond, bar) do { unsigned _sp = 0; while (cond) { __builtin_amdgcn_s_sleep(1); \
    if ((++_sp & 255u) == 0u) { if (xb_ld(&(bar)[XB_TMO])) break; if (_sp > XB_SPIN_CAP) { atomicAdd(&(bar)[XB_TMO], 1u); break; } } } } while (0)
struct XcdBarrier { unsigned* bar; unsigned x; volatile LAS unsigned* st; };
DI XcdBarrier xcd_barrier_post(unsigned* bar, volatile LAS unsigned* st) {
  XcdBarrier b; b.bar = bar; b.x = xb_xcc_id(); b.st = st;
  if (threadIdx.x == 0) (void)xb_add(&bar[XB_XCNT(b.x)], 1u);
  return b;
}
DI void xcd_barrier_complete(unsigned* bar, unsigned x, unsigned& nloc, unsigned& nx) {
  const unsigned G = gridDim.x * gridDim.y * gridDim.z;
  unsigned sum, cnt, sp = 0u;
  for (;;) {
    sum = 0u; cnt = 0u;
#pragma unroll 1
    for (unsigned j = 0; j < 16; ++j) { const unsigned c = xb_ld(&bar[XB_XCNT(j)]); sum += c; cnt += (c > 0u) ? 1u : 0u; }
    if (sum == G) break;
    __builtin_amdgcn_s_sleep(1);
    if ((++sp & 255u) == 0u) { if (xb_ld(&bar[XB_TMO])) break; if (sp > XB_SPIN_CAP) { atomicAdd(&bar[XB_TMO], 1u); break; } }
  }
  const unsigned mine = xb_ld(&bar[XB_XCNT(x)]);
  nloc = mine > 0u ? mine : 1u; nx = cnt > 0u ? cnt : 1u;
}
template <bool FIRST>
DI void xcd_barrier_t(const XcdBarrier& b) {
  asm volatile("s_waitcnt vmcnt(0)" ::: "memory");
  __syncthreads();
  if (threadIdx.x == 0) {
    unsigned* bar = b.bar;
    __builtin_amdgcn_s_waitcnt(0);
    unsigned nloc = b.st[0], nx = b.st[1];
    if (FIRST) { xcd_barrier_complete(bar, b.x, nloc, nx); b.st[0] = nloc; b.st[1] = nx; }
    const unsigned old = xb_add(&bar[XB_XSUB(b.x)], 1u);
    const unsigned gen = old / nloc;
    if (old + 1u == (gen + 1u) * nloc) {
      __builtin_amdgcn_fence(__ATOMIC_RELEASE, "agent");
      asm volatile("s_waitcnt vmcnt(0)" ::: "memory");
      const unsigned og = xb_add(&bar[XB_TOP], 1u);
      const unsigned tg = og / nx;
      if (og + 1u == (tg + 1u) * nx) xb_add(&bar[XB_TOPGEN], 1u);
      else XB_SPIN(xb_ld(&bar[XB_TOPGEN]) == tg, bar);
      __builtin_amdgcn_fence(__ATOMIC_ACQUIRE, "agent");
      xb_add(&bar[XB_XGEN(b.x)], 1u);
      asm volatile("s_waitcnt vmcnt(0)" ::: "memory");
    } else {
      XB_SPIN(xb_ld(&bar[XB_XGEN(b.x)]) == gen, bar);
      __builtin_amdgcn_fence(__ATOMIC_ACQUIRE, "agent");
      asm volatile("s_waitcnt vmcnt(0)" ::: "memory");
    }
  }
  __syncthreads();
}
DI void xcd_barrier(const XcdBarrier& b) { xcd_barrier_t<false>(b); }

__global__ void __launch_bounds__(512) mega_fwd(Params p) {
  extern __shared__ __attribute__((aligned(16))) unsigned char lds[];
  cg::grid_group grid = cg::this_grid();
  const int tid0 = threadIdx.x;
#define OPQ() ({ int t_ = tid0; asm volatile("" : "+v"(t_)); t_; })
#define OPQV() (OPQ() & 255)
  unsigned char* vlds = lds + VHALF * LDS_HALF;
  volatile LAS unsigned* xst = (volatile LAS unsigned*)(lds + 2 * LDS_HALF);
  if (tid0 == 0) { xst[0] = 0u; xst[1] = 0u; xst[2] = 0u; xst[3] = 0u; xst[4] = 0u; xst[5] = 0u; xst[6] = 0u; xst[7] = 0u; }
  __syncthreads();
  const XcdBarrier xb = xcd_barrier_post(p.BAR, xst);
  phase0(p, vlds, OPQV());
  if (p.pad == 0x7fffffff) grid.sync();
  xcd_barrier_t<true>(xb);
  phase0b(p, OPQV());
  xcd_barrier(xb);
  const int ngroups = 8 / p.nbg;
  const int nl = p.nbg * SEQ, mg = p.nbg * (SEQ + CTXL);
  for (int g = 0; g < ngroups; ++g) {
    for (int layer = 0; layer < 2; ++layer) {
      const int mrows = layer == 0 ? mg : nl;
      norm_phase(p, layer, g, 0, mg, OPQV());
      xcd_barrier(xb);
      inproj_phase(p, layer, g, lds, OPQ());
      xcd_barrier(xb);
      mix_phase(p, layer, g, lds, OPQ());
      xcd_barrier(xb);
      recur_phase(p, OPQV());
      xcd_barrier(xb);
      ssdout_phase(p, layer, g, vlds, OPQV());
      xcd_barrier(xb);
      merge_phase(p, layer, g, mrows, vlds, OPQV());
      xcd_barrier(xb);
      resid_gemm_phase(p, layer, g, mrows, p.MG, D, p.wt_o + (size_t)layer * D * D, 2048, true, vlds, OPQV());
      xcd_barrier(xb);
      norm_phase(p, layer, g, 1, mrows, OPQV());
      xcd_barrier(xb);
      up_phase(p, layer, mrows, lds, OPQ());
      xcd_barrier(xb);
      act_phase(p, layer, mrows, OPQV());
      xcd_barrier(xb);
      resid_gemm_phase(p, layer, g, mrows, (const bf16_t*)p.ST, DFF, p.wt_down + (size_t)layer * D * DFF, 5120, false, vlds, OPQV());
      xcd_barrier(xb);
    }
  }
  final_phase(p, OPQV());
}

static size_t ws_need(int nbg, size_t* offs) {
  size_t o = 0;
  auto take = [&](size_t bytes) { size_t r = o; o += (bytes + 255) & ~(size_t)255; return r; };
  offs[0] = take((size_t)2 * NINP * D * 2);
  offs[1] = take((size_t)2 * D * D * 2);
  offs[2] = take((size_t)2 * D * D * 2);
  offs[3] = take((size_t)2 * D * D * 2);
  offs[4] = take((size_t)2 * DFF2 * D * 2);
  offs[5] = take((size_t)2 * D * DFF * 2);
  const size_t mg = (size_t)nbg * 2304;
  offs[6] = take(mg * USTR * 2);
  offs[7] = take((size_t)nbg * 8 * 2304 * 128 * 2);
  offs[8] = take((size_t)nbg * 8 * 128 * 2304 * 2);
  offs[9] = take(mg * D * 2);
  offs[10] = take(mg * D * 2);
  offs[11] = take(mg * D * 2);
  offs[12] = take(mg * D * 2);
  offs[13] = take(mg * 32 * 4);
  offs[14] = take((size_t)nbg * 2 * 16 * 18 * 8192 * 4);
  offs[15] = take((size_t)nbg * 2 * 16 * 18 * 4);
  offs[16] = take(mg * 16 * 4);
  offs[17] = take((size_t)8 * CTXL * D * 4);
  offs[18] = take((size_t)8 * 2 * 9 * 6144 * 4);
  offs[19] = take((size_t)2 * 9 * 6144 * 4);
  offs[20] = take((size_t)1024 * 2 * 4);
  offs[21] = take(256);
  offs[22] = take(XCD_BAR_WORDS * 4);
  offs[23] = take((size_t)nbg * 18 * 16 * 512 * 4);
  return o;
}

extern "C" void kernel_launch(void* const* d_in, const int* in_sizes, int n_in, void* d_out, int out_size, void* d_ws,
                              size_t ws_size, hipStream_t stream) {
  static int grid_blocks = 0;
  if (grid_blocks == 0) {
    int dev = 0, cus = 0, per_cu = 0;
    hipGetDevice(&dev);
    hipDeviceGetAttribute(&cus, hipDeviceAttributeMultiprocessorCount, dev);
    hipFuncSetAttribute((const void*)mega_fwd, hipFuncAttributeMaxDynamicSharedMemorySize, LDS_BYTES);
    hipOccupancyMaxActiveBlocksPerMultiprocessor(&per_cu, (const void*)mega_fwd, 512, LDS_BYTES);
    if (per_cu < 1) { fprintf(stderr, "occupancy query returned %d\n", per_cu); per_cu = 1; }
    if (per_cu > 1) per_cu = 1;
    grid_blocks = cus * per_cu;
  }
  size_t offs[24];
  int nbg = 8;
  while (nbg > 1 && ws_need(nbg, offs) > ws_size) nbg >>= 1;
  const size_t need = ws_need(nbg, offs);
  if (need > ws_size) { fprintf(stderr, "workspace too small: need %zu have %zu\n", need, ws_size); return; }
  Params p{};
  const float** ins = (const float**)&p.x;
  for (int i = 0; i < 25; ++i) ins[i] = (const float*)d_in[i];
  p.out = (float*)d_out;
  unsigned char* ws = (unsigned char*)d_ws;
  p.wt_in = (bf16_t*)(ws + offs[0]); p.wt_brs = (bf16_t*)(ws + offs[1]); p.wt_bra = (bf16_t*)(ws + offs[2]);
  p.wt_o = (bf16_t*)(ws + offs[3]); p.wt_up = (bf16_t*)(ws + offs[4]); p.wt_down = (bf16_t*)(ws + offs[5]);
  p.U = (bf16_t*)(ws + offs[6]); p.KK = (bf16_t*)(ws + offs[7]); p.VT = (bf16_t*)(ws + offs[8]);
  p.H = (bf16_t*)(ws + offs[9]); p.YS = (bf16_t*)(ws + offs[10]); p.YA = (bf16_t*)(ws + offs[11]); p.MG = (bf16_t*)(ws + offs[12]);
  p.DT = (float*)(ws + offs[13]); p.ST = (float*)(ws + offs[14]); p.DEC = (float*)(ws + offs[15]); p.SSQ = (float*)(ws + offs[16]);
  p.XC = (float*)(ws + offs[17]); p.MODP = (float*)(ws + offs[18]); p.MOD = (float*)(ws + offs[19]);
  p.ROPE = (float*)(ws + offs[20]); p.LAM = (float*)(ws + offs[21]);
  p.BAR = (unsigned*)(ws + offs[22]);
  p.CSB = (float*)(ws + offs[23]);
  p.nbg = nbg; p.pad = 0;
  hipMemsetAsync(p.BAR, 0, XCD_BAR_WORDS * 4, stream);
  void* args[] = {&p};
  hipError_t e = hipLaunchCooperativeKernel((const void*)mega_fwd, dim3(grid_blocks), dim3(512), args, LDS_BYTES, stream);
  if (e != hipSuccess) fprintf(stderr, "cooperative launch failed: %s (grid %d)\n", hipGetErrorString(e), grid_blocks);
}
```

```cpp
#include <hip/hip_runtime.h>
#include <hip/hip_cooperative_groups.h>
#include <cstdio>
#include <cstdint>
namespace cg = cooperative_groups;

#define DI __device__ __forceinline__
typedef unsigned short bf16_t;
typedef short bf16x8 __attribute__((ext_vector_type(8)));
typedef float f32x4 __attribute__((ext_vector_type(4)));
typedef unsigned u32x4 __attribute__((ext_vector_type(4)));
typedef unsigned u32x2 __attribute__((ext_vector_type(2)));

constexpr int D = 1024, SEQ = 2048, CTXL = 256, DFF = 2816, DFF2 = 5632;
constexpr int NIN = 8224, NINP = 8448, USTR = 6144;
constexpr int LDS_HALF = 73728;
constexpr int LDS_BYTES = 2 * LDS_HALF + 32;
#define VHALF __builtin_amdgcn_readfirstlane((int)(threadIdx.x >> 8))
#define VB (VHALF * (int)gridDim.x + (int)blockIdx.x)
#define VG ((int)gridDim.x * 2)
constexpr float EPSN = 1e-6f;
constexpr int CONV_TILES = 9872;

struct Params {
  const float *x, *c, *ctx, *c_ctx, *w_mod, *b_mod, *norm1_w, *w_in, *ssd_conv_w, *ssd_conv_b, *a_log, *dt_bias,
      *ssd_d, *ssd_norm_w, *diff_lambda, *subln_w, *w_br_ssd, *w_br_att, *w_out, *norm2_w, *w_up, *ffn_conv_w,
      *ffn_conv_b, *w_down, *final_norm_w;
  float* out;
  bf16_t *wt_in, *wt_brs, *wt_bra, *wt_o, *wt_up, *wt_down;
  bf16_t *U, *KK, *VT, *H, *YS, *YA, *MG;
  float *DT, *ST, *DEC, *SSQ, *XC, *MODP, *MOD, *ROPE, *LAM, *CSB;
  unsigned* BAR;
  int nbg, pad;
};

typedef __bf16 bf16v2_t __attribute__((ext_vector_type(2)));
typedef float f32v2_t __attribute__((ext_vector_type(2)));
DI unsigned pack2(float a, float b) { f32v2_t v = {a, b}; bf16v2_t r = __builtin_convertvector(v, bf16v2_t); return __builtin_bit_cast(unsigned, r); }
DI bf16_t f2bf(float x) { return (bf16_t)(pack2(x, 0.f) & 0xffffu); }
DI float bf2f(bf16_t h) { return __uint_as_float(((unsigned)h) << 16); }
DI float lo_f(unsigned u) { return __uint_as_float(u << 16); }
DI float hi_f(unsigned u) { return __uint_as_float(u & 0xffff0000u); }
DI void unpack8(u32x4 v, float (&f)[8]) {
  f[0] = lo_f(v.x); f[1] = hi_f(v.x); f[2] = lo_f(v.y); f[3] = hi_f(v.y);
  f[4] = lo_f(v.z); f[5] = hi_f(v.z); f[6] = lo_f(v.w); f[7] = hi_f(v.w);
}
DI float silu_f(float x) { return x * __builtin_amdgcn_rcpf(1.f + __expf(-x)); }
DI float sigm_f(float x) { return __builtin_amdgcn_rcpf(1.f + __expf(-x)); }
DI float softplus_f(float x) { return x > 20.f ? x : log1pf(expf(x)); }
DI float shfl_idx(float v, int src_lane) { return __builtin_bit_cast(float, __builtin_amdgcn_ds_bpermute(src_lane << 2, __builtin_bit_cast(int, v))); }
#define LAS3 __attribute__((address_space(3)))
DI void half_sync(unsigned char* vlds, int tid) {
  __builtin_amdgcn_fence(__ATOMIC_RELEASE, "workgroup");
  if ((tid & 63) == 0) {
    LAS3 unsigned* cnt = (LAS3 unsigned*)((LAS3 unsigned char*)vlds + (VHALF ? (LDS_HALF + 20) : (2 * LDS_HALF + 16)));
    const unsigned old = __hip_atomic_fetch_add(cnt, 1u, __ATOMIC_RELAXED, __HIP_MEMORY_SCOPE_WORKGROUP);
    const unsigned target = (old & ~3u) + 4u;
    while ((int)(__hip_atomic_load(cnt, __ATOMIC_RELAXED, __HIP_MEMORY_SCOPE_WORKGROUP) - target) < 0) __builtin_amdgcn_s_sleep(0);
  }
  __builtin_amdgcn_fence(__ATOMIC_ACQUIRE, "workgroup");
}
#define HSYNC() half_sync(lds, tid)
#define MFMA16(a, b, c) __builtin_amdgcn_mfma_f32_16x16x32_bf16((a), (b), (c), 0, 0, 0)

DI const float* xin_row(const Params& p, int layer, int g, int r) {
  const int nl = p.nbg * SEQ;
  if (r < nl) return (layer == 0 ? p.x : p.out) + ((size_t)g * nl + r) * D;
  return (layer == 0 ? p.ctx : p.XC) + ((size_t)g * p.nbg * CTXL + (r - nl)) * D;
}
DI float* xout_row(const Params& p, int g, int r) {
  const int nl = p.nbg * SEQ;
  if (r < nl) return p.out + ((size_t)g * nl + r) * D;
  return p.XC + ((size_t)g * p.nbg * CTXL + (r - nl)) * D;
}
DI int mod_row(const Params& p, int g, int r) {
  const int nl = p.nbg * SEQ;
  return r < nl ? g * p.nbg + r / SEQ : 8;
}

DI int xcd_lin(int round) {
  const int chunk = gridDim.x >> 3;
  return (round * 8 + (blockIdx.x & 7)) * chunk + (blockIdx.x >> 3);
}
DI void tile_map(int t, int MT, int NT, int& mt, int& nt) {
  const int fb = NT >> 3, rem = NT & 7, full = fb * 8 * MT;
  if (t < full) { const int band = t / (8 * MT), r = t - band * 8 * MT; mt = r >> 3; nt = band * 8 + (r & 7); }
  else { const int r = t - full; mt = r / rem; nt = fb * 8 + r % rem; }
}

template <int NI>
DI void gemm_mainloop(const bf16_t* __restrict__ A, int lda, const bf16_t* __restrict__ B, int ldb, int K,
                      f32x4 (&acc)[NI][4], unsigned char* lds, int tid) {
  bf16_t* sA = (bf16_t*)lds;
  bf16_t* sB = (bf16_t*)(lds + 32768);
  const int lane = tid & 63, w = tid >> 6, wm = w & 1, wn = w >> 1, l15 = lane & 15, quad = lane >> 4;
  u32x4 ra0[4], rb0[NI], ra1[4], rb1[NI];
  const int nk = K >> 6;
  const int srow = tid >> 3, skc = (tid & 7) * 8;
  const bf16_t* Ap = A + (size_t)srow * lda + skc;
  const bf16_t* Bp = B + (size_t)srow * ldb + skc;
  const int soff = srow * 64 + (((tid & 7) ^ (srow & 7)) * 8);
  const int sw7 = l15 & 7;
#define G_LOAD(RA, RB, KT)                                                              \
  _Pragma("unroll") for (int r = 0; r < 4; ++r) {                                       \
    RA[r] = *(const u32x4*)(Ap + (size_t)(32 * r) * lda + (KT) * 64);                   \
    if (r < NI) RB[r] = *(const u32x4*)(Bp + (size_t)(32 * r) * ldb + (KT) * 64);       \
  }
#define G_STORE(RA, RB, BUF)                                                            \
  _Pragma("unroll") for (int r = 0; r < 4; ++r) {                                       \
    *(u32x4*)(sA + (BUF) * 8192 + soff + 32 * r * 64) = RA[r];                          \
    if (r < NI) *(u32x4*)(sB + (BUF) * 8192 + soff + 32 * r * 64) = RB[r];              \
  }
#define G_COMPUTE(BUF)                                                                  \
  {                                                                                     \
    const bf16_t* cA = sA + (BUF) * 8192;                                               \
    const bf16_t* cB = sB + (BUF) * 8192;                                               \
    _Pragma("unroll") for (int ks = 0; ks < 2; ++ks) {                                  \
      bf16x8 af[NI], bfr[4];                                                            \
      _Pragma("unroll") for (int i = 0; i < NI; ++i)                                    \
        af[i] = *(const bf16x8*)(cB + (wn * (NI * 16) + i * 16 + l15) * 64 + (((ks * 4 + quad) ^ sw7) * 8)); \
      _Pragma("unroll") for (int j = 0; j < 4; ++j)                                     \
        bfr[j] = *(const bf16x8*)(cA + (wm * 64 + j * 16 + l15) * 64 + (((ks * 4 + quad) ^ sw7) * 8)); \
      _Pragma("unroll") for (int i = 0; i < NI; ++i)                                    \
        _Pragma("unroll") for (int j = 0; j < 4; ++j) acc[i][j] = MFMA16(af[i], bfr[j], acc[i][j]); \
    }                                                                                   \
  }
  G_LOAD(ra0, rb0, 0);
  if (nk > 1) { G_LOAD(ra1, rb1, 1); }
  G_STORE(ra0, rb0, 0);
  __syncthreads();
  for (int kt = 0; kt < nk; kt += 2) {
    if (kt + 2 < nk) { G_LOAD(ra0, rb0, kt + 2); }
    G_COMPUTE(0);
    if (kt + 1 < nk) { G_STORE(ra1, rb1, 1); }
    __syncthreads();
    if (kt + 1 < nk) {
      if (kt + 3 < nk) { G_LOAD(ra1, rb1, kt + 3); }
      G_COMPUTE(1);
      if (kt + 2 < nk) { G_STORE(ra0, rb0, 0); }
      __syncthreads();
    }
  }
#undef G_LOAD
#undef G_STORE
#undef G_COMPUTE
}

template <int NI>
DI void zero_acc(f32x4 (&acc)[NI][4]) {
#pragma unroll
  for (int i = 0; i < NI; ++i)
#pragma unroll
    for (int j = 0; j < 4; ++j) acc[i][j] = (f32x4){0.f, 0.f, 0.f, 0.f};
}

DI void phase0(const Params& p, unsigned char* lds, int tid) {
  if (VB == 0) {
    for (int idx = tid; idx < 1024; idx += 256) {
      const int pos = idx >> 4, f = idx & 15;
      const float inv = powf(10000.f, -(float)f / 16.f);
      const float ang = (float)pos * inv;
      p.ROPE[idx * 2] = cosf(ang);
      p.ROPE[idx * 2 + 1] = sinf(ang);
    }
    if (tid < 2) {
      const float* lf = p.diff_lambda + tid * 256;
      float s1 = 0.f, s2 = 0.f;
      for (int i = 0; i < 64; ++i) { s1 += lf[i] * lf[64 + i]; s2 += lf[128 + i] * lf[192 + i]; }
      const float lam_init = 0.8f - 0.6f * expf(-0.3f * (float)tid);
      p.LAM[tid * 2] = expf(s1) - expf(s2) + lam_init;
      p.LAM[tid * 2 + 1] = 1.f - lam_init;
    }
  }
  {
    const u32x4 z = {0u, 0u, 0u, 0u};
    for (int i = VB * 256 + tid; i < 2 * 28672; i += VG * 256) {
      const int layer = i / 28672, e = i % 28672;
      *(u32x4*)(p.wt_in + (size_t)layer * NINP * D + (size_t)NIN * D + (size_t)e * 8) = z;
    }
  }
  float* sc = (float*)lds;
  for (int item = VB; item < 384; item += VG) {
    const int l = item / 192, rem = item % 192, nc = rem >> 3, kc = rem & 7;
    for (int idx = tid; idx < 1152; idx += 256) {
      const int r = idx >> 7, k = idx & 127;
      const float cv = r < 8 ? p.c[r * D + kc * 128 + k] : p.c_ctx[kc * 128 + k];
      sc[idx] = cv / (1.f + expf(-cv));
    }
    HSYNC();
    float a0 = 0, a1 = 0, a2 = 0, a3 = 0, a4 = 0, a5 = 0, a6 = 0, a7 = 0, a8 = 0;
    const int n = nc * 256 + tid;
    const float* wp = p.w_mod + ((size_t)l * D + kc * 128) * 6144 + n;
#pragma unroll 8
    for (int k = 0; k < 128; ++k) {
      const float wv = wp[(size_t)k * 6144];
      a0 += sc[k] * wv; a1 += sc[128 + k] * wv; a2 += sc[256 + k] * wv; a3 += sc[384 + k] * wv; a4 += sc[512 + k] * wv;
      a5 += sc[640 + k] * wv; a6 += sc[768 + k] * wv; a7 += sc[896 + k] * wv; a8 += sc[1024 + k] * wv;
    }
    float* op = p.MODP + ((size_t)(kc * 2 + l) * 9) * 6144 + n;
    op[0] = a0; op[6144] = a1; op[2 * 6144] = a2; op[3 * 6144] = a3; op[4 * 6144] = a4;
    op[5 * 6144] = a5; op[6 * 6144] = a6; op[7 * 6144] = a7; op[8 * 6144] = a8;
    HSYNC();
  }
  float* tile = (float*)lds;
  for (int item = VB; item < 2 * CONV_TILES; item += VG) {
    const int layer = item / CONV_TILES;
    int t = item % CONV_TILES;
    const float* src; bf16_t* dst; const float* scale = nullptr; int ld, sc0, dr0, ncols, K;
    if (t < 4112) {
      src = p.w_in + (size_t)layer * D * NIN; dst = p.wt_in + (size_t)layer * NINP * D; ld = NIN; K = D;
      if (t < 1536) { sc0 = 0; dr0 = 0; ncols = 3072; }
      else if (t < 3072) { t -= 1536; sc0 = 3104; dr0 = 3072; ncols = 3072; }
      else if (t < 4096) { t -= 3072; sc0 = 6176; dr0 = 6144; ncols = 2048; }
      else { t -= 4096; sc0 = 3072; dr0 = 8192; ncols = 32; }
    } else if (t < 4112 + 1536) {
      t -= 4112; const int which = t >> 9; t &= 511;
      ld = D; K = D; sc0 = 0; dr0 = 0; ncols = D;
      if (which == 0) { src = p.w_br_ssd + (size_t)layer * D * D; dst = p.wt_brs + (size_t)layer * D * D; scale = p.ssd_norm_w + layer * D; }
      else if (which == 1) { src = p.w_br_att + (size_t)layer * D * D; dst = p.wt_bra + (size_t)layer * D * D; }
      else { src = p.w_out + (size_t)layer * D * D; dst = p.wt_o + (size_t)layer * D * D; }
    } else if (t < 4112 + 1536 + 2816) {
      t -= 4112 + 1536;
      src = p.w_up + (size_t)layer * D * DFF2; dst = p.wt_up + (size_t)layer * DFF2 * D; ld = DFF2; K = D; sc0 = 0; dr0 = 0; ncols = DFF2;
    } else {
      t -= 4112 + 1536 + 2816;
      src = p.w_down + (size_t)layer * DFF * D; dst = p.wt_down + (size_t)layer * D * DFF; ld = D; K = DFF; sc0 = 0; dr0 = 0; ncols = D;
    }
    const int nct = ncols >> 5;
    const int tn = t % nct, tk = t / nct;
    const int k0 = tk * 64, n0 = tn * 32;
#pragma unroll
    for (int i = 0; i < 2; ++i) {
      const int kk = (tid >> 3) + 32 * i, n4 = (tid & 7) * 4;
      f32x4 v = *(const f32x4*)(src + (size_t)(k0 + kk) * ld + sc0 + n0 + n4);
      if (scale) { const float sv = scale[k0 + kk]; v[0] *= sv; v[1] *= sv; v[2] *= sv; v[3] *= sv; }
      tile[kk * 33 + n4] = v[0]; tile[kk * 33 + n4 + 1] = v[1]; tile[kk * 33 + n4 + 2] = v[2]; tile[kk * 33 + n4 + 3] = v[3];
    }
    HSYNC();
    {
      const int nn = tid >> 3, k8 = (tid & 7) * 8;
      const float* tp = tile + k8 * 33 + nn;
      u32x4 pk = {pack2(tp[0], tp[33]), pack2(tp[66], tp[99]), pack2(tp[132], tp[165]), pack2(tp[198], tp[231])};
      *(u32x4*)(dst + (size_t)(dr0 + n0 + nn) * K + k0 + k8) = pk;
    }
    HSYNC();
  }
}

DI void phase0b(const Params& p, int tid) {
  for (int i = VB * 256 + tid; i < 2 * 9 * 6144; i += VG * 256) {
    const int n = i % 6144, lr = i / 6144, l = lr / 9, r = lr % 9;
    float s = p.b_mod[l * 6144 + n];
#pragma unroll
    for (int kc = 0; kc < 8; ++kc) s += p.MODP[((size_t)(kc * 2 + l) * 9 + r) * 6144 + n];
    p.MOD[i] = s;
  }
}

DI void norm_phase(const Params& p, int layer, int g, int which, int nrows, int tid) {
  const int lane = tid & 63, w = __builtin_amdgcn_readfirstlane(tid >> 6);
  const float* nw = (which == 0 ? p.norm1_w : p.norm2_w) + layer * D;
  bf16_t* __restrict__ Hout = p.H;
  const int nwaves = VG * 4, rpw = (nrows + nwaves - 1) / nwaves;
  int r = (VB * 4 + w) * rpw;
  const int rend = r + rpw < nrows ? r + rpw : nrows;
  f32x4 wv[4], sh[4], scv[4];
#pragma unroll
  for (int i = 0; i < 4; ++i) wv[i] = *(const f32x4*)(nw + lane * 4 + 256 * i);
  int cur_mod = -1;
  f32x4 v[4];
  if (r < rend) {
    const float* src = which == 0 ? xin_row(p, layer, g, r) : xout_row(p, g, r);
#pragma unroll
    for (int i = 0; i < 4; ++i) v[i] = *(const f32x4*)(src + lane * 4 + 256 * i);
  }
  while (r < rend) {
    const int rn = r + 1;
    f32x4 vn[4];
    if (rn < rend) {
      const float* srcn = which == 0 ? xin_row(p, layer, g, rn) : xout_row(p, g, rn);
#pragma unroll
      for (int i = 0; i < 4; ++i) vn[i] = *(const f32x4*)(srcn + lane * 4 + 256 * i);
    }
    const int mr = mod_row(p, g, r);
    if (mr != cur_mod) {
      cur_mod = mr;
      const float* mod = p.MOD + (size_t)(layer * 9 + mr) * 6144 + (which ? 3072 : 0);
#pragma unroll
      for (int i = 0; i < 4; ++i) { const int col = lane * 4 + 256 * i; sh[i] = *(const f32x4*)(mod + col); scv[i] = *(const f32x4*)(mod + 1024 + col); }
    }
    float ss = 0.f;
#pragma unroll
    for (int i = 0; i < 4; ++i) ss += v[i][0] * v[i][0] + v[i][1] * v[i][1] + v[i][2] * v[i][2] + v[i][3] * v[i][3];
#pragma unroll
    for (int o = 32; o > 0; o >>= 1) ss += shfl_idx(ss, lane ^ o);
    const float rstd = rsqrtf(ss * (1.f / D) + EPSN);
#pragma unroll
    for (int i = 0; i < 4; ++i) {
      const int col = lane * 4 + 256 * i;
      float o0 = v[i][0] * rstd * wv[i][0] * (1.f + scv[i][0]) + sh[i][0];
      float o1 = v[i][1] * rstd * wv[i][1] * (1.f + scv[i][1]) + sh[i][1];
      float o2 = v[i][2] * rstd * wv[i][2] * (1.f + scv[i][2]) + sh[i][2];
      float o3 = v[i][3] * rstd * wv[i][3] * (1.f + scv[i][3]) + sh[i][3];
      u32x2 pk = {pack2(o0, o1), pack2(o2, o3)};
      *(u32x2*)(Hout + (size_t)r * D + col) = pk;
    }
#pragma unroll
    for (int i = 0; i < 4; ++i) v[i] = vn[i];
    r = rn;
  }
}


DI void conv_silu8(const bf16_t* __restrict__ Up, bool hp, bool hn, const float* __restrict__ cw, const float* __restrict__ cb,
                   int ci, float (&o)[8]) {
  const u32x4 z4 = {0u, 0u, 0u, 0u};
  const u32x4 cur = *(const u32x4*)Up;
  const u32x4 prv = hp ? *(const u32x4*)(Up - USTR) : z4;
  const u32x4 nxt = hn ? *(const u32x4*)(Up + USTR) : z4;
  float c[8], pv[8], nx[8];
  unpack8(cur, c); unpack8(prv, pv); unpack8(nxt, nx);
  const f32x4 w0a = *(const f32x4*)(cw + ci), w0b = *(const f32x4*)(cw + ci + 4);
  const f32x4 w1a = *(const f32x4*)(cw + 2048 + ci), w1b = *(const f32x4*)(cw + 2048 + ci + 4);
  const f32x4 w2a = *(const f32x4*)(cw + 4096 + ci), w2b = *(const f32x4*)(cw + 4096 + ci + 4);
  const f32x4 ba = *(const f32x4*)(cb + ci), bb = *(const f32x4*)(cb + ci + 4);
#pragma unroll
  for (int e = 0; e < 4; ++e) {
    const float xa = w0a[e] * pv[e] + w1a[e] * c[e] + w2a[e] * nx[e] + ba[e];
    const float xb = w0b[e] * pv[4 + e] + w1b[e] * c[4 + e] + w2b[e] * nx[4 + e] + bb[e];
    o[e] = silu_f(xa); o[4 + e] = silu_f(xb);
  }
}

DI int chunk_row0(const Params& p, int lb, int cid) {
  return cid < 2 ? p.nbg * SEQ + lb * CTXL + cid * 128 : lb * SEQ + (cid - 2) * 128;
}

DI void ssd_scan_prep(const Params& p, int layer, int row0, int h, float* fl, unsigned char* lds, int tid) {
  float* dtf = fl; float* dtb = fl + 128; float* csf = fl + 256; float* rsb = fl + 384;
  if (tid < 128) {
    const float rf = p.DT[(size_t)(row0 + tid) * 32 + h] + p.dt_bias[layer * 32 + h];
    const float rb = p.DT[(size_t)(row0 + tid) * 32 + 16 + h] + p.dt_bias[layer * 32 + 16 + h];
    dtf[tid] = softplus_f(rf); dtb[tid] = softplus_f(rb);
  }
  HSYNC();
  if (tid < 64) {
    const float Af = -expf(p.a_log[layer * 32 + h]), Ab = -expf(p.a_log[layer * 32 + 16 + h]);
    const float v0 = dtf[2 * tid] * Af, v1 = dtf[2 * tid + 1] * Af;
    const float s = v0 + v1;
    float inc = s;
#pragma unroll
    for (int o = 1; o < 64; o <<= 1) { const float t = shfl_idx(inc, tid >= o ? tid - o : tid); if (tid >= o) inc += t; }
    const float ex = inc - s;
    csf[2 * tid] = ex + v0; csf[2 * tid + 1] = ex + v0 + v1;
    const float w0 = dtb[2 * tid] * Ab, w1 = dtb[2 * tid + 1] * Ab;
    const float s2 = w0 + w1;
    float inc2 = s2;
#pragma unroll
    for (int o = 1; o < 64; o <<= 1) { const float t = shfl_idx(inc2, tid + o < 64 ? tid + o : tid); if (tid + o < 64) inc2 += t; }
    const float ex2 = inc2 - s2;
    rsb[2 * tid + 1] = ex2 + w1; rsb[2 * tid] = ex2 + w1 + w0;
  }
  HSYNC();
}

DI void ssd_state_item(const Params& p, int layer, int lb, int cid, int h, unsigned char* lds, int tid) {
  bf16_t* XfT = (bf16_t*)lds;
  bf16_t* XbT = (bf16_t*)(lds + 17408);
  bf16_t* BT = (bf16_t*)(lds + 34816);
  float* fl = (float*)(lds + 69632);
  const int lane = tid & 63, w = tid >> 6, l15 = lane & 15, quad = lane >> 4;
  const int row0 = chunk_row0(p, lb, cid);
  const int seqlen = cid < 2 ? CTXL : SEQ;
  const int t0 = cid < 2 ? cid * 128 : (cid - 2) * 128;
  const int grp = h >> 2;
  const float* cw = p.ssd_conv_w + layer * 3 * 2048;
  const float* cb = p.ssd_conv_b + layer * 2048;
  ssd_scan_prep(p, layer, row0, h, fl, lds, tid);
  if (tid < 128) *(f32x4*)(p.CSB + (size_t)((lb * 18 + cid) * 16 + h) * 512 + tid * 4) = *(const f32x4*)(fl + tid * 4);
  const float* dtf = fl; const float* dtb = fl + 128; const float* csf = fl + 256; const float* rsb = fl + 384;
  const float cf_end = csf[127], rb_0 = rsb[0];
#pragma unroll 4
  for (int r = 0; r < 4; ++r) {
    const int unit = tid + 256 * r, cgp = unit & 7, l = unit >> 3;
    const int ci = h * 64 + cgp * 8;
    float o[8];
    conv_silu8(p.U + (size_t)(row0 + l) * USTR + 1024 + ci, (t0 + l) > 0, (t0 + l) < seqlen - 1, cw, cb, ci, o);
    const float wf = __expf(cf_end - csf[l]) * dtf[l], wb = __expf(rb_0 - rsb[l]) * dtb[l];
#pragma unroll
    for (int e = 0; e < 8; ++e) {
      XfT[(cgp * 8 + e) * 136 + l] = f2bf(o[e] * wf);
      XbT[(cgp * 8 + e) * 136 + l] = f2bf(o[e] * wb);
    }
  }
#pragma unroll 4
  for (int r = 0; r < 8; ++r) {
    const int unit = tid + 256 * r, cgp = unit & 15, l = unit >> 4;
    const int ci = 1024 + grp * 128 + cgp * 8;
    float o[8];
    conv_silu8(p.U + (size_t)(row0 + l) * USTR + 1024 + ci, (t0 + l) > 0, (t0 + l) < seqlen - 1, cw, cb, ci, o);
#pragma unroll
    for (int e = 0; e < 8; ++e) BT[(cgp * 8 + e) * 136 + l] = f2bf(o[e]);
  }
  HSYNC();
  f32x4 acc[2][4][2];
#pragma unroll
  for (int d = 0; d < 2; ++d)
#pragma unroll
    for (int pt = 0; pt < 4; ++pt)
#pragma unroll
      for (int n2 = 0; n2 < 2; ++n2) acc[d][pt][n2] = (f32x4){0.f, 0.f, 0.f, 0.f};
#pragma unroll
  for (int ks = 0; ks < 4; ++ks) {
    bf16x8 bb[2];
#pragma unroll
    for (int n2 = 0; n2 < 2; ++n2) bb[n2] = *(const bf16x8*)(BT + ((2 * w + n2) * 16 + l15) * 136 + ks * 32 + quad * 8);
#pragma unroll
    for (int pt = 0; pt < 4; ++pt) {
      const bf16x8 af = *(const bf16x8*)(XfT + (pt * 16 + l15) * 136 + ks * 32 + quad * 8);
      const bf16x8 ab = *(const bf16x8*)(XbT + (pt * 16 + l15) * 136 + ks * 32 + quad * 8);
#pragma unroll
      for (int n2 = 0; n2 < 2; ++n2) {
        acc[0][pt][n2] = MFMA16(af, bb[n2], acc[0][pt][n2]);
        acc[1][pt][n2] = MFMA16(ab, bb[n2], acc[1][pt][n2]);
      }
    }
  }
#pragma unroll
  for (int d = 0; d < 2; ++d) {
    bf16_t* sp = (bf16_t*)p.ST + ((size_t)(((lb * 2 + d) * 16 + h) * 18 + cid)) * 8192;
#pragma unroll
    for (int pt = 0; pt < 4; ++pt)
#pragma unroll
      for (int n2 = 0; n2 < 2; ++n2)
#pragma unroll
        for (int reg = 0; reg < 4; ++reg)
          sp[(pt * 16 + quad * 4 + reg) * 128 + (2 * w + n2) * 16 + l15] = f2bf(acc[d][pt][n2][reg]);
  }
  if (tid == 0) {
    p.DEC[((lb * 2 + 0) * 16 + h) * 18 + cid] = expf(cf_end);
    p.DEC[((lb * 2 + 1) * 16 + h) * 18 + cid] = expf(rb_0);
  }
  HSYNC();
}

DI void attn_item(const Params& p, int layer, int lb, int h, int qb, bool is_ctx, unsigned char* lds, int tid) {
  bf16_t* Ks = (bf16_t*)lds;
  bf16_t* Vs = (bf16_t*)(lds + 34816);
  float* XB = (float*)lds;
  const int lane = tid & 63, w = tid >> 6, l15 = lane & 15, quad = lane >> 4;
  const int comp = w >> 1, qh = w & 1;
  const int nl = p.nbg * SEQ;
  const int ntiles = is_ctx ? 4 : 36;
  const int qrow0 = (is_ctx ? nl + lb * CTXL : lb * SEQ) + qb * 64;
  const bf16_t* KKp = p.KK + (size_t)(lb * 8 + h) * 2304 * 128;
  const bf16_t* VTp = p.VT + (size_t)(lb * 8 + h) * 128 * 2304;
  bf16x8 Qf[2][2];
#pragma unroll
  for (int qt = 0; qt < 2; ++qt)
#pragma unroll
    for (int ks = 0; ks < 2; ++ks)
      Qf[qt][ks] = *(const bf16x8*)(p.U + (size_t)(qrow0 + qh * 32 + qt * 16 + l15) * USTR + 3072 + h * 128 + comp * 64 + ks * 32 + quad * 8);
  f32x4 O[8][2];
#pragma unroll
  for (int et = 0; et < 8; ++et) { O[et][0] = (f32x4){0.f, 0.f, 0.f, 0.f}; O[et][1] = (f32x4){0.f, 0.f, 0.f, 0.f}; }
  float mrun[2] = {-1e30f, -1e30f}, lsum[2] = {0.f, 0.f};
  const float CS = 0.125f * 1.44269504088896f;
  u32x4 rk[4], rv[4];
#pragma unroll
  for (int r = 0; r < 4; ++r) {
    const int q = tid + 256 * r;
    rk[r] = *(const u32x4*)(KKp + (size_t)(q >> 4) * 128 + (q & 15) * 8);
    rv[r] = *(const u32x4*)(VTp + (size_t)(q >> 3) * 2304 + (q & 7) * 8);
  }
#pragma unroll
  for (int r = 0; r < 4; ++r) {
    const int q = tid + 256 * r;
    *(u32x4*)(Ks + (q >> 4) * 136 + (q & 15) * 8) = rk[r];
    *(u32x4*)(Vs + (q >> 3) * 72 + (q & 7) * 8) = rv[r];
  }
  HSYNC();
  for (int kt = 0; kt < ntiles; ++kt) {
    const int cur = kt & 1;
    if (kt + 1 < ntiles) {
#pragma unroll
      for (int r = 0; r < 4; ++r) {
        const int q = tid + 256 * r;
        rk[r] = *(const u32x4*)(KKp + (size_t)((kt + 1) * 64 + (q >> 4)) * 128 + (q & 15) * 8);
        rv[r] = *(const u32x4*)(VTp + (size_t)(q >> 3) * 2304 + (kt + 1) * 64 + (q & 7) * 8);
      }
    }
    const bf16_t* cK = Ks + cur * 8704;
    const bf16_t* cV = Vs + cur * 9216;
    f32x4 S[4][2];
#pragma unroll
    for (int t = 0; t < 4; ++t) { S[t][0] = (f32x4){0.f, 0.f, 0.f, 0.f}; S[t][1] = (f32x4){0.f, 0.f, 0.f, 0.f}; }
#pragma unroll
    for (int ks = 0; ks < 2; ++ks)
#pragma unroll
      for (int t = 0; t < 4; ++t) {
        const bf16x8 a = *(const bf16x8*)(cK + (t * 16 + l15) * 136 + comp * 64 + ks * 32 + quad * 8);
        S[t][0] = MFMA16(a, Qf[0][ks], S[t][0]);
        S[t][1] = MFMA16(a, Qf[1][ks], S[t][1]);
      }
    bf16x8 Pf[2][2];
#pragma unroll
    for (int qt = 0; qt < 2; ++qt) {
      float mx = S[0][qt][0];
#pragma unroll
      for (int t = 0; t < 4; ++t)
#pragma unroll
        for (int reg = 0; reg < 4; ++reg) mx = fmaxf(mx, S[t][qt][reg]);
      mx = fmaxf(mx, shfl_idx(mx, lane ^ 16));
      mx = fmaxf(mx, shfl_idx(mx, lane ^ 32));
      const float mxc = mx * CS;
      const bool need = mxc - mrun[qt] > 8.f;
      if (__builtin_amdgcn_ballot_w64(need) != 0ull) {
        const float mnew = fmaxf(mrun[qt], mxc);
        const float alpha = __builtin_amdgcn_exp2f(mrun[qt] - mnew);
        mrun[qt] = mnew;
        lsum[qt] *= alpha;
#pragma unroll
        for (int et = 0; et < 8; ++et) { O[et][qt][0] *= alpha; O[et][qt][1] *= alpha; O[et][qt][2] *= alpha; O[et][qt][3] *= alpha; }
      }
      const float mc = mrun[qt];
      float ps = 0.f;
      float pv[4][4];
#pragma unroll
      for (int t = 0; t < 4; ++t)
#pragma unroll
        for (int reg = 0; reg < 4; ++reg) { pv[t][reg] = __builtin_amdgcn_exp2f(S[t][qt][reg] * CS - mc); ps += pv[t][reg]; }
      lsum[qt] += ps;
#pragma unroll
      for (int k2 = 0; k2 < 2; ++k2) {
        u32x4 pk = {pack2(pv[2 * k2][0], pv[2 * k2][1]), pack2(pv[2 * k2][2], pv[2 * k2][3]),
                    pack2(pv[2 * k2 + 1][0], pv[2 * k2 + 1][1]), pack2(pv[2 * k2 + 1][2], pv[2 * k2 + 1][3])};
        Pf[qt][k2] = __builtin_bit_cast(bf16x8, pk);
      }
    }
#pragma unroll
    for (int k2 = 0; k2 < 2; ++k2)
#pragma unroll
      for (int et = 0; et < 8; ++et) {
        const u32x2 a0 = *(const u32x2*)(cV + (et * 16 + l15) * 72 + (2 * k2) * 16 + quad * 4);
        const u32x2 a1 = *(const u32x2*)(cV + (et * 16 + l15) * 72 + (2 * k2 + 1) * 16 + quad * 4);
        const u32x4 a4 = {a0.x, a0.y, a1.x, a1.y};
        const bf16x8 a = __builtin_bit_cast(bf16x8, a4);
        O[et][0] = MFMA16(a, Pf[0][k2], O[et][0]);
        O[et][1] = MFMA16(a, Pf[1][k2], O[et][1]);
      }
    if (kt + 1 < ntiles) {
      bf16_t* nK = Ks + (cur ^ 1) * 8704;
      bf16_t* nV = Vs + (cur ^ 1) * 9216;
#pragma unroll
      for (int r = 0; r < 4; ++r) {
        const int q = tid + 256 * r;
        *(u32x4*)(nK + (q >> 4) * 136 + (q & 15) * 8) = rk[r];
        *(u32x4*)(nV + (q >> 3) * 72 + (q & 7) * 8) = rv[r];
      }
    }
    HSYNC();
  }
  const float lam = p.LAM[layer * 2], oml = p.LAM[layer * 2 + 1];
#pragma unroll
  for (int qt = 0; qt < 2; ++qt) {
    float l = lsum[qt];
    l += shfl_idx(l, lane ^ 16);
    l += shfl_idx(l, lane ^ 32);
    const float inv = (comp == 1 ? lam : 1.f) / l;
#pragma unroll
    for (int et = 0; et < 8; ++et) { O[et][qt][0] *= inv; O[et][qt][1] *= inv; O[et][qt][2] *= inv; O[et][qt][3] *= inv; }
  }
  if (comp == 1) {
#pragma unroll
    for (int qt = 0; qt < 2; ++qt)
#pragma unroll
      for (int et = 0; et < 8; ++et) *(f32x4*)(XB + (qh * 32 + qt * 16 + l15) * 132 + et * 16 + quad * 4) = O[et][qt];
  }
  HSYNC();
  if (comp == 0) {
    const float* sw = p.subln_w + layer * 128;
#pragma unroll
    for (int qt = 0; qt < 2; ++qt) {
      float ss = 0.f;
#pragma unroll
      for (int et = 0; et < 8; ++et) {
        const f32x4 o1 = *(const f32x4*)(XB + (qh * 32 + qt * 16 + l15) * 132 + et * 16 + quad * 4);
        O[et][qt][0] -= o1[0]; O[et][qt][1] -= o1[1]; O[et][qt][2] -= o1[2]; O[et][qt][3] -= o1[3];
        ss += O[et][qt][0] * O[et][qt][0] + O[et][qt][1] * O[et][qt][1] + O[et][qt][2] * O[et][qt][2] + O[et][qt][3] * O[et][qt][3];
      }
      ss += shfl_idx(ss, lane ^ 16);
      ss += shfl_idx(ss, lane ^ 32);
      const float rstd = rsqrtf(ss * (1.f / 128.f) + EPSN) * oml;
      const int row = qrow0 + qh * 32 + qt * 16 + l15;
#pragma unroll
      for (int et = 0; et < 8; ++et) {
        const f32x4 wv = *(const f32x4*)(sw + et * 16 + quad * 4);
        u32x2 pk = {pack2(O[et][qt][0] * rstd * wv[0], O[et][qt][1] * rstd * wv[1]),
                    pack2(O[et][qt][2] * rstd * wv[2], O[et][qt][3] * rstd * wv[3])};
        *(u32x2*)(p.YA + (size_t)row * D + h * 128 + et * 16 + quad * 4) = pk;
      }
    }
  }
  HSYNC();
}

DI void attn_item8(const Params& p, int layer, int lb, int h, int qb, bool is_ctx, unsigned char* lds, int tid) {
  bf16_t* Ks = (bf16_t*)lds;
  bf16_t* Vs = (bf16_t*)(lds + 34816);
  float* XB = (float*)lds;
  const int lane = tid & 63, w = tid >> 6, l15 = lane & 15, quad = lane >> 4;
  const int comp = w >> 2, qh = w & 3;
  const int nl = p.nbg * SEQ;
  const int ntiles = is_ctx ? 4 : 36;
  const int qrow0 = (is_ctx ? nl + lb * CTXL : lb * SEQ) + qb * 128;
  const bf16_t* KKp = p.KK + (size_t)(lb * 8 + h) * 2304 * 128;
  const bf16_t* VTp = p.VT + (size_t)(lb * 8 + h) * 128 * 2304;
  bf16x8 Qf[2][2];
#pragma unroll
  for (int qt = 0; qt < 2; ++qt)
#pragma unroll
    for (int ks = 0; ks < 2; ++ks)
      Qf[qt][ks] = *(const bf16x8*)(p.U + (size_t)(qrow0 + qh * 32 + qt * 16 + l15) * USTR + 3072 + h * 128 + comp * 64 + ks * 32 + quad * 8);
  f32x4 O[8][2];
#pragma unroll
  for (int et = 0; et < 8; ++et) { O[et][0] = (f32x4){0.f, 0.f, 0.f, 0.f}; O[et][1] = (f32x4){0.f, 0.f, 0.f, 0.f}; }
  float mrun[2] = {-1e30f, -1e30f}, lsum[2] = {0.f, 0.f};
  const float CS = 0.125f * 1.44269504088896f;
  u32x4 rk[2], rv[2];
#pragma unroll
  for (int r = 0; r < 2; ++r) {
    const int q = tid + 512 * r;
    rk[r] = *(const u32x4*)(KKp + (size_t)(q >> 4) * 128 + (q & 15) * 8);
    rv[r] = *(const u32x4*)(VTp + (size_t)(q >> 3) * 2304 + (q & 7) * 8);
  }
#pragma unroll
  for (int r = 0; r < 2; ++r) {
    const int q = tid + 512 * r;
    *(u32x4*)(Ks + (q >> 4) * 136 + (q & 15) * 8) = rk[r];
    *(u32x4*)(Vs + (q >> 3) * 72 + (q & 7) * 8) = rv[r];
  }
  __syncthreads();
  for (int kt = 0; kt < ntiles; ++kt) {
    const int cur = kt & 1;
    if (kt + 1 < ntiles) {
#pragma unroll
      for (int r = 0; r < 2; ++r) {
        const int q = tid + 512 * r;
        rk[r] = *(const u32x4*)(KKp + (size_t)((kt + 1) * 64 + (q >> 4)) * 128 + (q & 15) * 8);
        rv[r] = *(const u32x4*)(VTp + (size_t)(q >> 3) * 2304 + (kt + 1) * 64 + (q & 7) * 8);
      }
    }
    const bf16_t* cK = Ks + cur * 8704;
    const bf16_t* cV = Vs + cur * 9216;
    f32x4 S[4][2];
#pragma unroll
    for (int t = 0; t < 4; ++t) { S[t][0] = (f32x4){0.f, 0.f, 0.f, 0.f}; S[t][1] = (f32x4){0.f, 0.f, 0.f, 0.f}; }
#pragma unroll
    for (int ks = 0; ks < 2; ++ks)
#pragma unroll
      for (int t = 0; t < 4; ++t) {
        const bf16x8 a = *(const bf16x8*)(cK + (t * 16 + l15) * 136 + comp * 64 + ks * 32 + quad * 8);
        S[t][0] = MFMA16(a, Qf[0][ks], S[t][0]);
        S[t][1] = MFMA16(a, Qf[1][ks], S[t][1]);
      }
    bf16x8 Pf[2][2];
#pragma unroll
    for (int qt = 0; qt < 2; ++qt) {
      float mx = S[0][qt][0];
#pragma unroll
      for (int t = 0; t < 4; ++t)
#pragma unroll
        for (int reg = 0; reg < 4; ++reg) mx = fmaxf(mx, S[t][qt][reg]);
      mx = fmaxf(mx, shfl_idx(mx, lane ^ 16));
      mx = fmaxf(mx, shfl_idx(mx, lane ^ 32));
      const float mxc = mx * CS;
      const bool need = mxc - mrun[qt] > 8.f;
      if (__builtin_amdgcn_ballot_w64(need) != 0ull) {
        const float mnew = fmaxf(mrun[qt], mxc);
        const float alpha = __builtin_amdgcn_exp2f(mrun[qt] - mnew);
        mrun[qt] = mnew;
        lsum[qt] *= alpha;
#pragma unroll
        for (int et = 0; et < 8; ++et) { O[et][qt][0] *= alpha; O[et][qt][1] *= alpha; O[et][qt][2] *= alpha; O[et][qt][3] *= alpha; }
      }
      const float mc = mrun[qt];
      float ps = 0.f;
      float pv[4][4];
#pragma unroll
      for (int t = 0; t < 4; ++t)
#pragma unroll
        for (int reg = 0; reg < 4; ++reg) { pv[t][reg] = __builtin_amdgcn_exp2f(S[t][qt][reg] * CS - mc); ps += pv[t][reg]; }
      lsum[qt] += ps;
#pragma unroll
      for (int k2 = 0; k2 < 2; ++k2) {
        u32x4 pk = {pack2(pv[2 * k2][0], pv[2 * k2][1]), pack2(pv[2 * k2][2], pv[2 * k2][3]),
                    pack2(pv[2 * k2 + 1][0], pv[2 * k2 + 1][1]), pack2(pv[2 * k2 + 1][2], pv[2 * k2 + 1][3])};
        Pf[qt][k2] = __builtin_bit_cast(bf16x8, pk);
      }
    }
#pragma unroll
    for (int k2 = 0; k2 < 2; ++k2)
#pragma unroll
      for (int et = 0; et < 8; ++et) {
        const u32x2 a0 = *(const u32x2*)(cV + (et * 16 + l15) * 72 + (2 * k2) * 16 + quad * 4);
        const u32x2 a1 = *(const u32x2*)(cV + (et * 16 + l15) * 72 + (2 * k2 + 1) * 16 + quad * 4);
        const u32x4 a4 = {a0.x, a0.y, a1.x, a1.y};
        const bf16x8 a = __builtin_bit_cast(bf16x8, a4);
        O[et][0] = MFMA16(a, Pf[0][k2], O[et][0]);
        O[et][1] = MFMA16(a, Pf[1][k2], O[et][1]);
      }
    if (kt + 1 < ntiles) {
      bf16_t* nK = Ks + (cur ^ 1) * 8704;
      bf16_t* nV = Vs + (cur ^ 1) * 9216;
#pragma unroll
      for (int r = 0; r < 2; ++r) {
        const int q = tid + 512 * r;
        *(u32x4*)(nK + (q >> 4) * 136 + (q & 15) * 8) = rk[r];
        *(u32x4*)(nV + (q >> 3) * 72 + (q & 7) * 8) = rv[r];
      }
    }
    __syncthreads();
  }
  const float lam = p.LAM[layer * 2], oml = p.LAM[layer * 2 + 1];
#pragma unroll
  for (int qt = 0; qt < 2; ++qt) {
    float l = lsum[qt];
    l += shfl_idx(l, lane ^ 16);
    l += shfl_idx(l, lane ^ 32);
    const float inv = (comp == 1 ? lam : 1.f) / l;
#pragma unroll
    for (int et = 0; et < 8; ++et) { O[et][qt][0] *= inv; O[et][qt][1] *= inv; O[et][qt][2] *= inv; O[et][qt][3] *= inv; }
  }
  if (comp == 1) {
#pragma unroll
    for (int qt = 0; qt < 2; ++qt)
#pragma unroll
      for (int et = 0; et < 8; ++et) *(f32x4*)(XB + (qh * 32 + qt * 16 + l15) * 132 + et * 16 + quad * 4) = O[et][qt];
  }
  __syncthreads();
  if (comp == 0) {
    const float* sw = p.subln_w + layer * 128;
#pragma unroll
    for (int qt = 0; qt < 2; ++qt) {
      float ss = 0.f;
#pragma unroll
      for (int et = 0; et < 8; ++et) {
        const f32x4 o1 = *(const f32x4*)(XB + (qh * 32 + qt * 16 + l15) * 132 + et * 16 + quad * 4);
        O[et][qt][0] -= o1[0]; O[et][qt][1] -= o1[1]; O[et][qt][2] -= o1[2]; O[et][qt][3] -= o1[3];
        ss += O[et][qt][0] * O[et][qt][0] + O[et][qt][1] * O[et][qt][1] + O[et][qt][2] * O[et][qt][2] + O[et][qt][3] * O[et][qt][3];
      }
      ss += shfl_idx(ss, lane ^ 16);
      ss += shfl_idx(ss, lane ^ 32);
      const float rstd = rsqrtf(ss * (1.f / 128.f) + EPSN) * oml;
      const int row = qrow0 + qh * 32 + qt * 16 + l15;
#pragma unroll
      for (int et = 0; et < 8; ++et) {
        const f32x4 wv = *(const f32x4*)(sw + et * 16 + quad * 4);
        u32x2 pk = {pack2(O[et][qt][0] * rstd * wv[0], O[et][qt][1] * rstd * wv[1]),
                    pack2(O[et][qt][2] * rstd * wv[2], O[et][qt][3] * rstd * wv[3])};
        *(u32x2*)(p.YA + (size_t)row * D + h * 128 + et * 16 + quad * 4) = pk;
      }
    }
  }
  __syncthreads();
}

DI int inproj_main_tiles(int MT, int NT);
DI void inproj_tile(const Params& p, int layer, int g, int item, unsigned char* lds, int tid_);
DI void mix_phase(const Params& p, int layer, int g, unsigned char* lds, int tid_) {
  const int n_al = p.nbg * 8 * 16;
  const int n_ac = layer == 0 ? p.nbg * 8 * 2 : 0;
  const int n_st = p.nbg * 18 * 16;
  for (int item = blockIdx.x; item < n_al; item += gridDim.x) {
    int tid = tid_;
    asm volatile("" : "+v"(tid));
    attn_item8(p, layer, item >> 7, (item >> 4) & 7, item & 15, false, lds, tid);
  }
  {
    const int cshift = (int)gridDim.x >= 128 ? 64 : 0;
    for (int it = ((int)blockIdx.x - cshift + (int)gridDim.x) % (int)gridDim.x; it < n_ac; it += gridDim.x) {
      int tid = tid_;
      asm volatile("" : "+v"(tid));
      attn_item8(p, layer, it >> 4, (it >> 1) & 7, it & 1, true, lds, tid);
    }
  }
  {
    const int MT = (p.nbg * (SEQ + CTXL)) >> 8, NT = NINP >> 8;
    const int n_main = inproj_main_tiles(MT, NT), ntail = MT * NT - n_main;
    const int back = (int)gridDim.x - 1 - (int)blockIdx.x;
    if (back < ntail) {
      inproj_tile(p, layer, g, n_main + back, lds, tid_);
      __syncthreads();
    }
  }
  unsigned char* vlds = lds + VHALF * LDS_HALF;
  for (int item = VB; item < n_st; item += VG) {
    int tid = tid_ & 255;
    asm volatile("" : "+v"(tid));
    const int hh = item & 15, rest = item >> 4, cid = rest % 18, lb = rest / 18;
    ssd_state_item(p, layer, lb, cid, hh, vlds, tid);
  }
}

DI void recur_phase(const Params& p, int tid) {
  const int total = p.nbg * 2 * 16 * 1024;
  for (int idx = VB * 256 + tid; idx < total; idx += VG * 256) {
    const int lbdh = idx >> 10, e8 = idx & 1023;
    const int dir = (lbdh >> 4) & 1;
    bf16_t* base = (bf16_t*)p.ST + (size_t)lbdh * 18 * 8192 + e8 * 8;
    const float* dec = p.DEC + lbdh * 18;
    u32x4 sv[18];
    float dc[18];
#pragma unroll
    for (int k = 0; k < 18; ++k) {
      const int cid = dir == 0 ? k : (k < 2 ? 1 - k : 19 - k);
      sv[k] = *(const u32x4*)(base + (size_t)cid * 8192);
      dc[k] = dec[cid];
    }
    float zf = 0.f;
    asm volatile("" : "+v"(zf));
    float hst[8] = {zf, zf, zf, zf, zf, zf, zf, zf};
#pragma unroll
    for (int k = 0; k < 18; ++k) {
      const int cid = dir == 0 ? k : (k < 2 ? 1 - k : 19 - k);
      u32x4 pk = {pack2(hst[0], hst[1]), pack2(hst[2], hst[3]), pack2(hst[4], hst[5]), pack2(hst[6], hst[7])};
      *(u32x4*)(base + (size_t)cid * 8192) = pk;
      float sf[8];
      unpack8(sv[k], sf);
#pragma unroll
      for (int e = 0; e < 8; ++e) hst[e] = hst[e] * dc[k] + sf[e];
    }
  }
}

DI void ssd_out_item(const Params& p, int layer, int lb, int cid, int h, unsigned char* lds, int tid) {
  bf16_t* Bs = (bf16_t*)lds;
  bf16_t* XT = (bf16_t*)(lds + 34816);
  float* fl = (float*)(lds + 52224);
  const int lane = tid & 63, w = tid >> 6, l15_ = lane & 15, quad_ = lane >> 4;
  const int row0 = chunk_row0(p, lb, cid);
  const int seqlen = cid < 2 ? CTXL : SEQ;
  const int t0 = cid < 2 ? cid * 128 : (cid - 2) * 128;
  const int grp = h >> 2;
  const float* cw = p.ssd_conv_w + layer * 3 * 2048;
  const float* cb = p.ssd_conv_b + layer * 2048;
  if (tid < 128) *(f32x4*)(fl + tid * 4) = *(const f32x4*)(p.CSB + (size_t)((lb * 18 + cid) * 16 + h) * 512 + tid * 4);
  const float* dtf = fl; const float* dtb = fl + 128; const float* csf = fl + 256; const float* rsb = fl + 384;
#pragma unroll 4
  for (int r = 0; r < 8; ++r) {
    const int unit = tid + 256 * r, cgp = unit & 15, l = unit >> 4;
    const int ci = 1024 + grp * 128 + cgp * 8;
    float o[8];
    conv_silu8(p.U + (size_t)(row0 + l) * USTR + 1024 + ci, (t0 + l) > 0, (t0 + l) < seqlen - 1, cw, cb, ci, o);
    u32x4 pk = {pack2(o[0], o[1]), pack2(o[2], o[3]), pack2(o[4], o[5]), pack2(o[6], o[7])};
    *(u32x4*)(Bs + l * 136 + cgp * 8) = pk;
  }
#pragma unroll 4
  for (int r = 0; r < 4; ++r) {
    const int unit = tid + 256 * r, cgp = unit & 7, l = unit >> 3;
    const int ci = h * 64 + cgp * 8;
    float o[8];
    conv_silu8(p.U + (size_t)(row0 + l) * USTR + 1024 + ci, (t0 + l) > 0, (t0 + l) < seqlen - 1, cw, cb, ci, o);
#pragma unroll
    for (int e = 0; e < 8; ++e) XT[(cgp * 8 + e) * 136 + l] = f2bf(o[e]);
  }
  HSYNC();
  bf16_t* Pw = (bf16_t*)(lds + 54272) + w * (16 * 136);
  const float dsk = p.ssd_d[layer * 16 + h];
#pragma unroll 1
  for (int lt = 0; lt < 2; ++lt) {
    int l15 = l15_, quad = quad_;
    asm volatile("" : "+v"(l15), "+v"(quad));
    const int l = w * 32 + lt * 16 + l15;
    bf16x8 Cf[4];
#pragma unroll
    for (int ks = 0; ks < 4; ++ks) {
      const int ci = 1536 + grp * 128 + ks * 32 + quad * 8;
      float o[8];
      conv_silu8(p.U + (size_t)(row0 + l) * USTR + 1024 + ci, (t0 + l) > 0, (t0 + l) < seqlen - 1, cw, cb, ci, o);
      u32x4 pk = {pack2(o[0], o[1]), pack2(o[2], o[3]), pack2(o[4], o[5]), pack2(o[6], o[7])};
      Cf[ks] = __builtin_bit_cast(bf16x8, pk);
    }
    f32x4 cbT[8];
#pragma unroll
    for (int st = 0; st < 8; ++st) cbT[st] = (f32x4){0.f, 0.f, 0.f, 0.f};
#pragma unroll
    for (int ks = 0; ks < 4; ++ks)
#pragma unroll
      for (int st = 0; st < 8; ++st) {
        const bf16x8 a = *(const bf16x8*)(Bs + (st * 16 + l15) * 136 + ks * 32 + quad * 8);
        cbT[st] = MFMA16(a, Cf[ks], cbT[st]);
      }
    f32x4 Y[4];
#pragma unroll
    for (int pt = 0; pt < 4; ++pt) Y[pt] = (f32x4){0.f, 0.f, 0.f, 0.f};
#pragma unroll
    for (int dir = 0; dir < 2; ++dir) {
      const float cl = dir == 0 ? csf[l] : rsb[l];
#pragma unroll
      for (int st = 0; st < 8; ++st) {
        float pv[4];
#pragma unroll
        for (int reg = 0; reg < 4; ++reg) {
          const int s = st * 16 + quad * 4 + reg;
          const bool ok = dir == 0 ? (s <= l) : (s >= l);
          const float cs_s = dir == 0 ? csf[s] : rsb[s];
          const float dts = dir == 0 ? dtf[s] : dtb[s];
          pv[reg] = ok ? cbT[st][reg] * __expf(fminf(cl - cs_s, 0.f)) * dts : 0.f;
        }
        u32x2 pk = {pack2(pv[0], pv[1]), pack2(pv[2], pv[3])};
        *(u32x2*)(Pw + l15 * 136 + st * 16 + quad * 4) = pk;
      }
      asm volatile("s_waitcnt lgkmcnt(0)" ::: "memory");
#pragma unroll
      for (int ks = 0; ks < 4; ++ks) {
        const bf16x8 b0 = *(const bf16x8*)(Pw + l15 * 136 + ks * 32 + quad * 8);
#pragma unroll
        for (int pt = 0; pt < 4; ++pt) {
          const bf16x8 a = *(const bf16x8*)(XT + (pt * 16 + l15) * 136 + ks * 32 + quad * 8);
          Y[pt] = MFMA16(a, b0, Y[pt]);
        }
      }
      asm volatile("s_waitcnt lgkmcnt(0)" ::: "memory");
    }
#pragma unroll
    for (int dir = 0; dir < 2; ++dir) {
      const bf16_t* hp = (const bf16_t*)p.ST + ((size_t)(((lb * 2 + dir) * 16 + h) * 18 + cid)) * 8192;
      f32x4 T[4];
#pragma unroll
      for (int pt = 0; pt < 4; ++pt) T[pt] = (f32x4){0.f, 0.f, 0.f, 0.f};
#pragma unroll
      for (int ks = 0; ks < 4; ++ks)
#pragma unroll
        for (int pt = 0; pt < 4; ++pt) {
          const bf16x8 a = *(const bf16x8*)(hp + (pt * 16 + l15) * 128 + ks * 32 + quad * 8);
          T[pt] = MFMA16(a, Cf[ks], T[pt]);
        }
      const float e = __expf(dir == 0 ? csf[l] : rsb[l]);
#pragma unroll
      for (int pt = 0; pt < 4; ++pt) { Y[pt][0] += e * T[pt][0]; Y[pt][1] += e * T[pt][1]; Y[pt][2] += e * T[pt][2]; Y[pt][3] += e * T[pt][3]; }
    }
    const int row = row0 + l;
    float ss = 0.f;
#pragma unroll
    for (int pt = 0; pt < 4; ++pt) {
      const int pp = pt * 16 + quad * 4;
      const u32x2 zz = *(const u32x2*)(p.U + (size_t)row * USTR + h * 64 + pp);
      const float z0 = lo_f(zz.x), z1 = hi_f(zz.x), z2 = lo_f(zz.y), z3 = hi_f(zz.y);
      float y0 = Y[pt][0] + dsk * bf2f(XT[(pp + 0) * 136 + l]);
      float y1 = Y[pt][1] + dsk * bf2f(XT[(pp + 1) * 136 + l]);
      float y2 = Y[pt][2] + dsk * bf2f(XT[(pp + 2) * 136 + l]);
      float y3 = Y[pt][3] + dsk * bf2f(XT[(pp + 3) * 136 + l]);
      y0 *= silu_f(z0); y1 *= silu_f(z1); y2 *= silu_f(z2); y3 *= silu_f(z3);
      ss += y0 * y0 + y1 * y1 + y2 * y2 + y3 * y3;
      u32x2 pk = {pack2(y0, y1), pack2(y2, y3)};
      *(u32x2*)(p.YS + (size_t)row * D + h * 64 + pp) = pk;
    }
    ss += shfl_idx(ss, lane ^ 16);
    ss += shfl_idx(ss, lane ^ 32);
    if (quad == 0) p.SSQ[(size_t)row * 16 + h] = ss;
  }
  HSYNC();
}

DI void ssdout_phase(const Params& p, int layer, int g, unsigned char* lds, int tid_) {
  const int cid0 = layer == 0 ? 0 : 2;
  const int ncid = 18 - cid0;
  const int n = p.nbg * ncid * 16;
  for (int item = VB; item < n; item += VG) {
    int tid = tid_;
    asm volatile("" : "+v"(tid));
    const int hh = item & 15, rest = item >> 4, cid = cid0 + rest % ncid, lb = rest / ncid;
    ssd_out_item(p, layer, lb, cid, hh, lds, tid);
  }
}

DI void merge_phase(const Params& p, int layer, int g, int mrows, unsigned char* lds, int tid_) {
  const int MT = mrows >> 7, NT = D >> 6;
  const bf16_t* Bs_ = p.wt_brs + (size_t)layer * D * D;
  const bf16_t* Ba_ = p.wt_bra + (size_t)layer * D * D;
  for (int round = 0; (int)blockIdx.x + round * VG < MT * NT; ++round) {
    const int item = VB + round * VG;
    if (item >= MT * NT) {
      for (int i = 0; i < 2 * (1 + (D >> 6)); ++i) __syncthreads();
      continue;
    }
    int tid = tid_;
    asm volatile("" : "+v"(tid));
    const int lane = tid & 63, w = tid >> 6, wm = w & 1, wn = w >> 1, l15 = lane & 15, quad = lane >> 4;
    const int mt = item % MT, nt = item / MT;
    f32x4 as[2][4], aa[2][4];
    zero_acc<2>(as); zero_acc<2>(aa);
    gemm_mainloop<2>(p.YS + (size_t)mt * 128 * D, D, Bs_ + (size_t)nt * 64 * D, D, D, as, lds, tid);
    gemm_mainloop<2>(p.YA + (size_t)mt * 128 * D, D, Ba_ + (size_t)nt * 64 * D, D, D, aa, lds, tid);
    const int mb = mt * 128 + wm * 64, nb = nt * 64 + wn * 32;
#pragma unroll
    for (int j = 0; j < 4; ++j) {
      const int r = mb + j * 16 + l15;
      float ssq = 0.f;
      const f32x4* sq = (const f32x4*)(p.SSQ + (size_t)r * 16);
#pragma unroll
      for (int q = 0; q < 4; ++q) { const f32x4 t = sq[q]; ssq += t[0] + t[1] + t[2] + t[3]; }
      const float rstd = rsqrtf(ssq * (1.f / D) + EPSN);
#pragma unroll
      for (int i = 0; i < 2; ++i) {
        const int n = nb + i * 16 + quad * 4;
        const u32x2 gs = *(const u32x2*)(p.U + (size_t)r * USTR + 4096 + n);
        const u32x2 ga = *(const u32x2*)(p.U + (size_t)r * USTR + 5120 + n);
        const float m0 = sigm_f(lo_f(gs.x)) * rstd * as[i][j][0] + sigm_f(lo_f(ga.x)) * aa[i][j][0];
        const float m1 = sigm_f(hi_f(gs.x)) * rstd * as[i][j][1] + sigm_f(hi_f(ga.x)) * aa[i][j][1];
        const float m2 = sigm_f(lo_f(gs.y)) * rstd * as[i][j][2] + sigm_f(lo_f(ga.y)) * aa[i][j][2];
        const float m3 = sigm_f(hi_f(gs.y)) * rstd * as[i][j][3] + sigm_f(hi_f(ga.y)) * aa[i][j][3];
        u32x2 pk = {pack2(m0, m1), pack2(m2, m3)};
        *(u32x2*)(p.MG + (size_t)r * D + n) = pk;
      }
    }
  }
}

DI void resid_gemm_phase(const Params& p, int layer, int g, int mrows, const bf16_t* A, int K, const bf16_t* Bt, int gate_off,
                         bool src_is_in, unsigned char* lds, int tid_) {
  const int MT = mrows >> 7, NT = D >> 7;
  for (int round = 0; (int)blockIdx.x + round * VG < MT * NT; ++round) {
    const int item = VB + round * VG;
    if (item >= MT * NT) {
      for (int i = 0; i < 1 + (K >> 6); ++i) __syncthreads();
      continue;
    }
    int tid = tid_;
    asm volatile("" : "+v"(tid));
    const int lane = tid & 63, w = tid >> 6, wm = w & 1, wn = w >> 1, l15 = lane & 15, quad = lane >> 4;
    const int mt = item % MT, nt = item / MT;
    f32x4 acc[4][4];
    zero_acc<4>(acc);
    gemm_mainloop<4>(A + (size_t)mt * 128 * K, K, Bt + (size_t)nt * 128 * K, K, K, acc, lds, tid);
    const int mb = mt * 128 + wm * 64, nb = nt * 128 + wn * 64;
#pragma unroll
    for (int j = 0; j < 4; ++j) {
      const int r = mb + j * 16 + l15;
      const float* src = src_is_in ? xin_row(p, layer, g, r) : xout_row(p, g, r);
      float* dst = xout_row(p, g, r);
      const float* gate = p.MOD + (size_t)(layer * 9 + mod_row(p, g, r)) * 6144 + gate_off;
#pragma unroll
      for (int i = 0; i < 4; ++i) {
        const int n = nb + i * 16 + quad * 4;
        const f32x4 xv = *(const f32x4*)(src + n), gv = *(const f32x4*)(gate + n);
        f32x4 o;
        o[0] = xv[0] + gv[0] * acc[i][j][0]; o[1] = xv[1] + gv[1] * acc[i][j][1];
        o[2] = xv[2] + gv[2] * acc[i][j][2]; o[3] = xv[3] + gv[3] * acc[i][j][3];
        *(f32x4*)(dst + n) = o;
      }
    }
  }
}


DI int g8_lds_byte(int r, int c) {
  const int st = (r >> 4) * 2 + (c >> 5), rr = r & 15, cc = c & 31, ob = rr * 64 + cc * 2;
  return st * 1024 + (ob ^ (((ob >> 9) & 1) << 5));
}
DI void g8_stage_rc(int b, int& R, int& C) {
  const int st = b / 1024, sb = b % 1024, swz = sb ^ (((sb >> 9) & 1) << 5);
  R = (st >> 1) * 16 + swz / 64; C = (st & 1) * 32 + (swz % 64) / 2;
}
DI void gemm8p(const bf16_t* __restrict__ Wp, const bf16_t* __restrict__ Xp, f32x4 (&acc)[2][2][4][2], unsigned char* lds, int tid) {
  constexpr int GK = 1024, GBK = 64, GHALF = 128, GHT = GHALF * GBK;
  bf16_t* shm = (bf16_t*)lds;
#define SA(b, h) (shm + ((b) * 2 + (h)) * GHT)
#define SB(b, h) (shm + (4 + (b) * 2 + (h)) * GHT)
  const int wid = tid >> 6, lane = tid & 63, wr = wid >> 2, wc = wid & 3, fr = lane & 15, fq = lane >> 4;
  int goff0, goff1;
  { int r_, c_; g8_stage_rc(tid * 16, r_, c_); goff0 = r_ * GK + c_; g8_stage_rc(tid * 16 + 8192, r_, c_); goff1 = r_ * GK + c_; }
#define STAGE(P, BASE, br, kt) do { \
    __builtin_amdgcn_global_load_lds((const unsigned*)((BASE) + (br) * GK + (kt) * GBK + goff0), (unsigned*)((char*)(P) + tid * 16), 16, 0, 0); \
    __builtin_amdgcn_global_load_lds((const unsigned*)((BASE) + (br) * GK + (kt) * GBK + goff1), (unsigned*)((char*)(P) + tid * 16 + 8192), 16, 0, 0); } while (0)
#define LDA(dst, b, h) _Pragma("unroll") for (int m = 0; m < 4; ++m) _Pragma("unroll") for (int k = 0; k < 2; ++k) \
    dst[m][k] = *reinterpret_cast<const bf16x8*>((char*)SA(b, h) + g8_lds_byte(wr * 64 + m * 16 + fr, k * 32 + fq * 8))
#define LDB(dst, b, h) _Pragma("unroll") for (int n = 0; n < 2; ++n) _Pragma("unroll") for (int k = 0; k < 2; ++k) \
    dst[n][k] = *reinterpret_cast<const bf16x8*>((char*)SB(b, h) + g8_lds_byte(wc * 32 + n * 16 + fr, k * 32 + fq * 8))
#define MMA(ai, bj, At_, Bt_) do { __builtin_amdgcn_s_setprio(1); \
    _Pragma("unroll") for (int m = 0; m < 4; ++m) _Pragma("unroll") for (int n = 0; n < 2; ++n) _Pragma("unroll") for (int k = 0; k < 2; ++k) \
      acc[ai][bj][m][n] = __builtin_amdgcn_mfma_f32_16x16x32_bf16(At_[m][k], Bt_[n][k], acc[ai][bj][m][n], 0, 0, 0); \
    __builtin_amdgcn_s_setprio(0); } while (0)
#define WAIT_V(n) asm volatile("s_waitcnt vmcnt(" #n ")" ::: "memory")
#define WAIT_L(n) asm volatile("s_waitcnt lgkmcnt(" #n ")" ::: "memory")
#define BAR __builtin_amdgcn_s_barrier()
#define SCHED __builtin_amdgcn_sched_barrier(0)
  bf16x8 At[4][2], B0[2][2], B1[2][2];
  constexpr int nt = GK / GBK;
  STAGE(SB(0, 0), Xp, 0, 0); STAGE(SA(0, 0), Wp, 0, 0);
  STAGE(SB(0, 1), Xp, GHALF, 0); STAGE(SA(0, 1), Wp, GHALF, 0);
  if (wr == 1) BAR;
  WAIT_V(4); BAR;
  STAGE(SB(1, 0), Xp, 0, 1); STAGE(SA(1, 0), Wp, 0, 1); STAGE(SB(1, 1), Xp, GHALF, 1);
  WAIT_V(6); BAR;
  for (int t = 0; t < nt - 2; t += 2) {
    LDB(B0, 0, 0); SCHED; LDA(At, 0, 0); STAGE(SA(1, 1), Wp, GHALF, t + 1);
    WAIT_L(8); BAR; WAIT_L(0); MMA(0, 0, At, B0); BAR; SCHED;
    LDB(B1, 0, 1); STAGE(SB(0, 0), Xp, 0, t + 2);
    BAR; WAIT_L(0); MMA(0, 1, At, B1); BAR;
    LDA(At, 0, 1); STAGE(SA(0, 0), Wp, 0, t + 2);
    BAR; WAIT_L(0); MMA(1, 0, At, B0); BAR; SCHED;
    STAGE(SB(0, 1), Xp, GHALF, t + 2);
    WAIT_V(6); BAR; MMA(1, 1, At, B1); BAR;
    LDB(B0, 1, 0); SCHED; LDA(At, 1, 0); STAGE(SA(0, 1), Wp, GHALF, t + 2);
    WAIT_L(8); BAR; WAIT_L(0); MMA(0, 0, At, B0); BAR; SCHED;
    LDB(B1, 1, 1); STAGE(SB(1, 0), Xp, 0, t + 3);
    BAR; WAIT_L(0); MMA(0, 1, At, B1); BAR;
    LDA(At, 1, 1); STAGE(SA(1, 0), Wp, 0, t + 3);
    BAR; WAIT_L(0); MMA(1, 0, At, B0); BAR; SCHED;
    STAGE(SB(1, 1), Xp, GHALF, t + 3);
    WAIT_V(6); BAR; MMA(1, 1, At, B1); BAR;
  }
  { LDB(B0, 0, 0); LDA(At, 0, 0); STAGE(SA(1, 1), Wp, GHALF, nt - 1);
    BAR; WAIT_L(0); MMA(0, 0, At, B0); BAR;
    LDB(B1, 0, 1); BAR; WAIT_L(0); MMA(0, 1, At, B1); BAR;
    LDA(At, 0, 1); WAIT_V(4); BAR; WAIT_L(0); MMA(1, 0, At, B0); MMA(1, 1, At, B1); BAR; }
  { LDB(B0, 1, 0); LDA(At, 1, 0); WAIT_V(2); BAR; WAIT_L(0); MMA(0, 0, At, B0); BAR;
    LDB(B1, 1, 1); WAIT_V(0); BAR; WAIT_L(0); MMA(0, 1, At, B1); BAR;
    LDA(At, 1, 1); BAR; WAIT_L(0); MMA(1, 0, At, B0); MMA(1, 1, At, B1); BAR; }
  if (wr == 0) BAR;
#undef SA
#undef SB
#undef STAGE
#undef LDA
#undef LDB
#undef MMA
#undef WAIT_V
#undef WAIT_L
#undef BAR
#undef SCHED
}
DI void zero_acc8p(f32x4 (&acc)[2][2][4][2]) {
#pragma unroll
  for (int a = 0; a < 2; ++a)
#pragma unroll
    for (int b = 0; b < 2; ++b)
#pragma unroll
      for (int m = 0; m < 4; ++m) { acc[a][b][m][0] = (f32x4){0.f, 0.f, 0.f, 0.f}; acc[a][b][m][1] = (f32x4){0.f, 0.f, 0.f, 0.f}; }
}

DI int inproj_main_tiles(int MT, int NT) {
  const int total = MT * NT, whole = (total / (int)gridDim.x) * (int)gridDim.x;
  return (whole > 0 && whole / MT >= 25 && total - whole <= (int)gridDim.x) ? whole : total;
}
DI void inproj_tile(const Params& p, int layer, int g, int item, unsigned char* lds, int tid_) {
  const int nl = p.nbg * SEQ, mg = p.nbg * (SEQ + CTXL);
  const int MT = mg >> 8;
  const bf16_t* Wt = p.wt_in + (size_t)layer * NINP * D;
  {
    int tid = tid_;
    asm volatile("" : "+v"(tid));
    const int wid = tid >> 6, lane = tid & 63, wr = wid >> 2, wc = wid & 3, fr = lane & 15, fq = lane >> 4;
    const int mt = item % MT, kpos = item / MT;
    const int nt = kpos == 0 ? 32 : (kpos <= 28 ? kpos + 3 : kpos - 29);
    const int m0 = mt * 256, n0 = nt * 256;
    asm volatile("s_waitcnt vmcnt(0)" ::: "memory");
    __syncthreads();
    f32x4 acc[2][2][4][2];
    zero_acc8p(acc);
    gemm8p(Wt + (size_t)n0 * D, p.H + (size_t)m0 * D, acc, lds, tid);
    const bool lat = m0 < nl;
#pragma unroll
    for (int ai = 0; ai < 2; ++ai) {
      const int c0 = n0 + ai * 128 + wr * 64;
      if (c0 >= 3072 && c0 < 5120 && lat) {
#pragma unroll
        for (int bj = 0; bj < 2; ++bj)
#pragma unroll
          for (int ni = 0; ni < 2; ++ni) {
            const int r = m0 + bj * 128 + wc * 32 + ni * 16 + fr, t = r & (SEQ - 1), pr = t >> 6, pc = t & 63;
#pragma unroll
            for (int j = 0; j < 4; ++j) {
              const int f = fq * 4 + j;
              const float cr = p.ROPE[(pr * 16 + f) * 2], sr = p.ROPE[(pr * 16 + f) * 2 + 1];
              const float cc = p.ROPE[(pc * 16 + f) * 2], sc = p.ROPE[(pc * 16 + f) * 2 + 1];
              float x1 = acc[ai][bj][0][ni][j], x2 = acc[ai][bj][1][ni][j];
              acc[ai][bj][0][ni][j] = x1 * cr - x2 * sr; acc[ai][bj][1][ni][j] = x2 * cr + x1 * sr;
              x1 = acc[ai][bj][2][ni][j]; x2 = acc[ai][bj][3][ni][j];
              acc[ai][bj][2][ni][j] = x1 * cc - x2 * sc; acc[ai][bj][3][ni][j] = x2 * cc + x1 * sc;
            }
            asm volatile("" ::: "memory");
          }
      }
    }
    if (n0 < 5120 || (n0 >= 6144 && n0 < 8192)) {
      bf16_t* stg = (bf16_t*)lds + wid * (64 * 136);
#pragma unroll
      for (int ai = 0; ai < 2; ++ai)
#pragma unroll
        for (int bj = 0; bj < 2; ++bj)
#pragma unroll
          for (int ni = 0; ni < 2; ++ni)
#pragma unroll
            for (int mi = 0; mi < 4; ++mi) {
              const f32x4 v = acc[ai][bj][mi][ni];
              u32x2 pk = {pack2(v[0], v[1]), pack2(v[2], v[3])};
              *(u32x2*)(stg + (bj * 32 + ni * 16 + fr) * 136 + ai * 64 + mi * 16 + fq * 4) = pk;
            }
      __syncthreads();
#pragma unroll
      for (int ai = 0; ai < 2; ++ai) {
        const int c0 = n0 + ai * 128 + wr * 64;
#pragma unroll
        for (int k = 0; k < 8; ++k) {
          const int c = lane + 64 * k, rl = c >> 3, cc = c & 7;
          const u32x4 v = *(const u32x4*)(stg + rl * 136 + ai * 64 + cc * 8);
          const int r = m0 + (rl >> 5) * 128 + wc * 32 + (rl & 31);
          bf16_t* dst;
          if (n0 >= 4096 && n0 < 5120) {
            int lb, kj;
            if (lat) { lb = r >> 11; kj = CTXL + (r & (SEQ - 1)); } else { const int rc = r - nl; lb = rc >> 8; kj = rc & 255; }
            const int hh = (c0 - 4096) >> 7, cd0 = (c0 - 4096) & 127;
            dst = p.KK + ((size_t)(lb * 8 + hh) * 2304 + kj) * 128 + cd0;
          } else {
            dst = p.U + (size_t)r * USTR + (n0 < 4096 ? c0 : c0 - 2048);
          }
          *(u32x4*)(dst + cc * 8) = v;
        }
      }
    } else if (n0 < 6144) {
      bf16_t* stg = (bf16_t*)lds + wid * (128 * 72);
#pragma unroll
      for (int ai = 0; ai < 2; ++ai)
#pragma unroll
        for (int bj = 0; bj < 2; ++bj)
#pragma unroll
          for (int ni = 0; ni < 2; ++ni)
#pragma unroll
            for (int mi = 0; mi < 4; ++mi)
#pragma unroll
              for (int j = 0; j < 4; ++j)
                stg[(ai * 64 + mi * 16 + fq * 4 + j) * 72 + bj * 32 + ni * 16 + fr] = f2bf(acc[ai][bj][mi][ni][j]);
      __syncthreads();
#pragma unroll
      for (int k = 0; k < 16; ++k) {
        const int c = lane + 64 * k, el = c >> 3, cc = c & 7;
        const u32x4 v = *(const u32x4*)(stg + el * 72 + cc * 8);
        const int r = m0 + (cc >> 2) * 128 + wc * 32 + (cc & 3) * 8;
        int lb, kj;
        if (lat) { lb = r >> 11; kj = CTXL + (r & (SEQ - 1)); } else { const int rc = r - nl; lb = rc >> 8; kj = rc & 255; }
        const int n = n0 + (el >> 6) * 128 + wr * 64 + (el & 63);
        const int hh = (n - 5120) >> 7, e = (n - 5120) & 127;
        *(u32x4*)(p.VT + ((size_t)(lb * 8 + hh) * 128 + e) * 2304 + kj) = v;
      }
    } else if (n0 == 8192 && wr == 0) {
#pragma unroll
      for (int bj = 0; bj < 2; ++bj)
#pragma unroll
        for (int ni = 0; ni < 2; ++ni) {
          const int r = m0 + bj * 128 + wc * 32 + ni * 16 + fr;
#pragma unroll
          for (int mi = 0; mi < 2; ++mi) *(f32x4*)(p.DT + (size_t)r * 32 + mi * 16 + fq * 4) = acc[0][bj][mi][ni];
        }
    }
  }
}
DI void inproj_phase(const Params& p, int layer, int g, unsigned char* lds, int tid_) {
  const int MT = (p.nbg * (SEQ + CTXL)) >> 8, NT = NINP >> 8;
  const int n_main = inproj_main_tiles(MT, NT);
  for (int item = blockIdx.x; item < n_main; item += gridDim.x) inproj_tile(p, layer, g, item, lds, tid_);
}

DI void up_phase(const Params& p, int layer, int mrows, unsigned char* lds, int tid_) {
  const int MT = mrows >> 8, NT = DFF2 >> 8;
  const bf16_t* Wt = p.wt_up + (size_t)layer * DFF2 * D;
  bf16_t* UF = p.U;
  for (int item = blockIdx.x; item < MT * NT; item += gridDim.x) {
    int tid = tid_;
    asm volatile("" : "+v"(tid));
    const int wid = tid >> 6, lane = tid & 63, wr = wid >> 2, wc = wid & 3, fr = lane & 15, fq = lane >> 4;
    const int mt = item % MT, nt = item / MT;
    const int m0 = mt * 256, n0 = nt * 256;
    asm volatile("s_waitcnt vmcnt(0)" ::: "memory");
    __syncthreads();
    f32x4 acc[2][2][4][2];
    zero_acc8p(acc);
    gemm8p(Wt + (size_t)n0 * D, p.H + (size_t)m0 * D, acc, lds, tid);
    bf16_t* stg = (bf16_t*)lds + wid * (64 * 136);
#pragma unroll
    for (int ai = 0; ai < 2; ++ai)
#pragma unroll
      for (int bj = 0; bj < 2; ++bj)
#pragma unroll
        for (int ni = 0; ni < 2; ++ni)
#pragma unroll
          for (int mi = 0; mi < 4; ++mi) {
            const f32x4 v = acc[ai][bj][mi][ni];
            u32x2 pk = {pack2(v[0], v[1]), pack2(v[2], v[3])};
            *(u32x2*)(stg + (bj * 32 + ni * 16 + fr) * 136 + ai * 64 + mi * 16 + fq * 4) = pk;
          }
    __syncthreads();
#pragma unroll
    for (int ai = 0; ai < 2; ++ai) {
      const int c0 = n0 + ai * 128 + wr * 64;
#pragma unroll
      for (int k = 0; k < 8; ++k) {
        const int c = lane + 64 * k, rl = c >> 3, cc = c & 7;
        const u32x4 v = *(const u32x4*)(stg + rl * 136 + ai * 64 + cc * 8);
        const int r = m0 + (rl >> 5) * 128 + wc * 32 + (rl & 31);
        *(u32x4*)(UF + (size_t)r * DFF2 + c0 + cc * 8) = v;
      }
    }
  }
}

DI void act_phase(const Params& p, int layer, int mrows, int tid) {
  const bf16_t* __restrict__ UF = p.U;
  bf16_t* __restrict__ HID = (bf16_t*)p.ST;
  const int nl = p.nbg * SEQ;
  const float* __restrict__ cw = p.ffn_conv_w + (size_t)layer * 3 * DFF2;
  const float* __restrict__ cb = p.ffn_conv_b + (size_t)layer * DFF2;
  const u32x4 z4 = {0u, 0u, 0u, 0u};
  constexpr int NCH = DFF / 8;
  const int gid = VB * 256 + tid;
  const int slots = (VG * 256) / NCH;
  const int jc = gid % NCH, rslot = gid / NCH;
  if (rslot >= slots) return;
  const int j0 = jc * 8;
  float w0[2][8], w1[2][8], w2[2][8], bb[2][8];
#pragma unroll
  for (int half = 0; half < 2; ++half) {
    const int ci = half * DFF + j0;
#pragma unroll
    for (int e = 0; e < 8; ++e) { w0[half][e] = cw[ci + e]; w1[half][e] = cw[DFF2 + ci + e]; w2[half][e] = cw[2 * DFF2 + ci + e]; bb[half][e] = cb[ci + e]; }
  }
#pragma unroll 2
  for (int r = rslot; r < mrows; r += slots) {
    int t, sl;
    if (r < nl) { t = r & (SEQ - 1); sl = SEQ; } else { t = (r - nl) & (CTXL - 1); sl = CTXL; }
    const bool hp = t > 0, hn = t < sl - 1;
    const bf16_t* up = UF + (size_t)r * DFF2 + j0;
    float av[8], vv[8], res[8];
#pragma unroll
    for (int half = 0; half < 2; ++half) {
      const bf16_t* q = up + half * DFF;
      float c[8], pv[8], nx[8];
      unpack8(*(const u32x4*)q, c);
      unpack8(hp ? *(const u32x4*)(q - DFF2) : z4, pv);
      unpack8(hn ? *(const u32x4*)(q + DFF2) : z4, nx);
#pragma unroll
      for (int e = 0; e < 8; ++e) {
        const float xx = w0[half][e] * pv[e] + w1[half][e] * c[e] + w2[half][e] * nx[e] + bb[half][e];
        if (half == 0) av[e] = xx; else vv[e] = xx;
      }
    }
#pragma unroll
    for (int e = 0; e < 8; ++e) res[e] = silu_f(av[e]) * vv[e];
    u32x4 pk = {pack2(res[0], res[1]), pack2(res[2], res[3]), pack2(res[4], res[5]), pack2(res[6], res[7])};
    *(u32x4*)(HID + (size_t)r * DFF + j0) = pk;
  }
}

DI void final_phase(const Params& p, int tid) {
  const int lane = tid & 63, w = __builtin_amdgcn_readfirstlane(tid >> 6);
  f32x4 wv[4];
#pragma unroll
  for (int i = 0; i < 4; ++i) wv[i] = *(const f32x4*)(p.final_norm_w + lane * 4 + 256 * i);
  int r = VB * 4 + w;
  f32x4 v[4];
  if (r < 8 * SEQ) {
#pragma unroll
    for (int i = 0; i < 4; ++i) v[i] = *(const f32x4*)(p.out + (size_t)r * D + lane * 4 + 256 * i);
  }
  while (r < 8 * SEQ) {
    const int rn = r + VG * 4;
    f32x4 vn[4];
    if (rn < 8 * SEQ) {
#pragma unroll
      for (int i = 0; i < 4; ++i) vn[i] = *(const f32x4*)(p.out + (size_t)rn * D + lane * 4 + 256 * i);
    }
    float ss = 0.f;
#pragma unroll
    for (int i = 0; i < 4; ++i) ss += v[i][0] * v[i][0] + v[i][1] * v[i][1] + v[i][2] * v[i][2] + v[i][3] * v[i][3];
#pragma unroll
    for (int o = 32; o > 0; o >>= 1) ss += shfl_idx(ss, lane ^ o);
    const float rstd = rsqrtf(ss * (1.f / D) + EPSN);
    float* dst = p.out + (size_t)r * D;
#pragma unroll
    for (int i = 0; i < 4; ++i) {
      f32x4 o;
      o[0] = v[i][0] * rstd * wv[i][0]; o[1] = v[i][1] * rstd * wv[i][1]; o[2] = v[i][2] * rstd * wv[i][2]; o[3] = v[i][3] * rstd * wv[i][3];
      *(f32x4*)(dst + lane * 4 + 256 * i) = o;
    }
#pragma unroll
    for (int i = 0; i < 4; ++i) v[i] = vn[i];
    r = rn;
  }
}


#define XB_TMO      128
#define XB_XCNT(j)  (256  + 64 * (j))
#define XB_XSUB(j)  (1280 + 64 * (j))
#define XB_XGEN(j)  (2304 + 64 * (j))
#define XB_TOP      3328
#define XB_TOPGEN   3392
#define XCD_BAR_WORDS 3456
#define XB_SPIN_CAP (1u << 22)
#define LAS __attribute__((address_space(3)))
DI unsigned xb_ld(unsigned* p) { return __hip_atomic_load(p, __ATOMIC_RELAXED, __HIP_MEMORY_SCOPE_AGENT); }
DI unsigned xb_add(unsigned* p, unsigned v) { return __hip_atomic_fetch_add(p, v, __ATOMIC_RELAXED, __HIP_MEMORY_SCOPE_AGENT); }
DI unsigned xb_xcc_id() { return (unsigned)__builtin_amdgcn_s_getreg((3 << 11) | 20) & 0xFu; }
#define XB_SPIN(cond, bar) do { unsigned _sp = 0; while (cond) { __builtin_amdgcn_s_sleep(1); \
    if ((++_sp & 255u) == 0u) { if (xb_ld(&(bar)[XB_TMO])) break; if (_sp > XB_SPIN_CAP) { atomicAdd(&(bar)[XB_TMO], 1u); break; } } } } while (0)
struct XcdBarrier { unsigned* bar; unsigned x; volatile LAS unsigned* st; };
DI XcdBarrier xcd_barrier_post(unsigned* bar, volatile LAS unsigned* st) {
  XcdBarrier b; b.bar = bar; b.x = xb_xcc_id(); b.st = st;
  if (threadIdx.x == 0) (void)xb_add(&bar[XB_XCNT(b.x)], 1u);
  return b;
}
DI void xcd_barrier_complete(unsigned* bar, unsigned x, unsigned& nloc, unsigned& nx) {
  const unsigned G = gridDim.x * gridDim.y * gridDim.z;
  unsigned sum, cnt, sp = 0u;
  for (;;) {
    sum = 0u; cnt = 0u;
#pragma unroll 1
    for (unsigned j = 0; j < 16; ++j) { const unsigned c = xb_ld(&bar[XB_XCNT(j)]); sum += c; cnt += (c > 0u) ? 1u : 0u; }
    if (sum == G) break;
    __builtin_amdgcn_s_sleep(1);
    if ((++sp & 255u) == 0u) { if (xb_ld(&bar[XB_TMO])) break; if (sp > XB_SPIN_CAP) { atomicAdd(&bar[XB_TMO], 1u); break; } }
  }
  const unsigned mine = xb_ld(&bar[XB_XCNT(x)]);
  nloc = mine > 0u ? mine : 1u; nx = cnt > 0u ? cnt : 1u;
}
template <bool FIRST>
DI void xcd_barrier_t(const XcdBarrier& b) {
  asm volatile("s_waitcnt vmcnt(0)" ::: "memory");
  __syncthreads();
  if (threadIdx.x == 0) {
    unsigned* bar = b.bar;
    __builtin_amdgcn_s_waitcnt(0);
    unsigned nloc = b.st[0], nx = b.st[1];
    if (FIRST) { xcd_barrier_complete(bar, b.x, nloc, nx); b.st[0] = nloc; b.st[1] = nx; }
    const unsigned old = xb_add(&bar[XB_XSUB(b.x)], 1u);
    const unsigned gen = old / nloc;
    if (old + 1u == (gen + 1u) * nloc) {
      __builtin_amdgcn_fence(__ATOMIC_RELEASE, "agent");
      asm volatile("s_waitcnt vmcnt(0)" ::: "memory");
      const unsigned og = xb_add(&bar[XB_TOP], 1u);
      const unsigned tg = og / nx;
      if (og + 1u == (tg + 1u) * nx) xb_add(&bar[XB_TOPGEN], 1u);
      else XB_SPIN(xb_ld(&bar[XB_TOPGEN]) == tg, bar);
      __builtin_amdgcn_fence(__ATOMIC_ACQUIRE, "agent");
      xb_add(&bar[XB_XGEN(b.x)], 1u);
      asm volatile("s_waitcnt vmcnt(0)" ::: "memory");
    } else {
      XB_SPIN(xb_ld(&bar[XB_XGEN(b.x)]) == gen, bar);
      __builtin_amdgcn_fence(__ATOMIC_ACQUIRE, "agent");
      asm volatile("s_waitcnt vmcnt(0)" ::: "memory");
    }
  }
  __syncthreads();
}
DI void xcd_barrier(const XcdBarrier& b) { xcd_barrier_t<false>(b); }

__global__ void __launch_bounds__(512) mega_fwd(Params p) {
  extern __shared__ __attribute__((aligned(16))) unsigned char lds[];
  cg::grid_group grid = cg::this_grid();
  const int tid0 = threadIdx.x;
#define OPQ() ({ int t_ = tid0; asm volatile("" : "+v"(t_)); t_; })
#define OPQV() (OPQ() & 255)
  unsigned char* vlds = lds + VHALF * LDS_HALF;
  volatile LAS unsigned* xst = (volatile LAS unsigned*)(lds + 2 * LDS_HALF);
  if (tid0 == 0) { xst[0] = 0u; xst[1] = 0u; xst[2] = 0u; xst[3] = 0u; xst[4] = 0u; xst[5] = 0u; xst[6] = 0u; xst[7] = 0u; }
  __syncthreads();
  const XcdBarrier xb = xcd_barrier_post(p.BAR, xst);
  phase0(p, vlds, OPQV());
  if (p.pad == 0x7fffffff) grid.sync();
  xcd_barrier_t<true>(xb);
  phase0b(p, OPQV());
  xcd_barrier(xb);
  const int ngroups = 8 / p.nbg;
  const int nl = p.nbg * SEQ, mg = p.nbg * (SEQ + CTXL);
  for (int g = 0; g < ngroups; ++g) {
    for (int layer = 0; layer < 2; ++layer) {
      const int mrows = layer == 0 ? mg : nl;
      norm_phase(p, layer, g, 0, mg, OPQV());
      xcd_barrier(xb);
      inproj_phase(p, layer, g, lds, OPQ());
      xcd_barrier(xb);
      mix_phase(p, layer, g, lds, OPQ());
      xcd_barrier(xb);
      recur_phase(p, OPQV());
      xcd_barrier(xb);
      ssdout_phase(p, layer, g, vlds, OPQV());
      xcd_barrier(xb);
      merge_phase(p, layer, g, mrows, vlds, OPQV());
      xcd_barrier(xb);
      resid_gemm_phase(p, layer, g, mrows, p.MG, D, p.wt_o + (size_t)layer * D * D, 2048, true, vlds, OPQV());
      xcd_barrier(xb);
      norm_phase(p, layer, g, 1, mrows, OPQV());
      xcd_barrier(xb);
      up_phase(p, layer, mrows, lds, OPQ());
      xcd_barrier(xb);
      act_phase(p, layer, mrows, OPQV());
      xcd_barrier(xb);
      resid_gemm_phase(p, layer, g, mrows, (const bf16_t*)p.ST, DFF, p.wt_down + (size_t)layer * D * DFF, 5120, false, vlds, OPQV());
      xcd_barrier(xb);
    }
  }
  final_phase(p, OPQV());
}

static size_t ws_need(int nbg, size_t* offs) {
  size_t o = 0;
  auto take = [&](size_t bytes) { size_t r = o; o += (bytes + 255) & ~(size_t)255; return r; };
  offs[0] = take((size_t)2 * NINP * D * 2);
  offs[1] = take((size_t)2 * D * D * 2);
  offs[2] = take((size_t)2 * D * D * 2);
  offs[3] = take((size_t)2 * D * D * 2);
  offs[4] = take((size_t)2 * DFF2 * D * 2);
  offs[5] = take((size_t)2 * D * DFF * 2);
  const size_t mg = (size_t)nbg * 2304;
  offs[6] = take(mg * USTR * 2);
  offs[7] = take((size_t)nbg * 8 * 2304 * 128 * 2);
  offs[8] = take((size_t)nbg * 8 * 128 * 2304 * 2);
  offs[9] = take(mg * D * 2);
  offs[10] = take(mg * D * 2);
  offs[11] = take(mg * D * 2);
  offs[12] = take(mg * D * 2);
  offs[13] = take(mg * 32 * 4);
  offs[14] = take((size_t)nbg * 2 * 16 * 18 * 8192 * 4);
  offs[15] = take((size_t)nbg * 2 * 16 * 18 * 4);
  offs[16] = take(mg * 16 * 4);
  offs[17] = take((size_t)8 * CTXL * D * 4);
  offs[18] = take((size_t)8 * 2 * 9 * 6144 * 4);
  offs[19] = take((size_t)2 * 9 * 6144 * 4);
  offs[20] = take((size_t)1024 * 2 * 4);
  offs[21] = take(256);
  offs[22] = take(XCD_BAR_WORDS * 4);
  offs[23] = take((size_t)nbg * 18 * 16 * 512 * 4);
  return o;
}

extern "C" void kernel_launch(void* const* d_in, const int* in_sizes, int n_in, void* d_out, int out_size, void* d_ws,
                              size_t ws_size, hipStream_t stream) {
  static int grid_blocks = 0;
  if (grid_blocks == 0) {
    int dev = 0, cus = 0, per_cu = 0;
    hipGetDevice(&dev);
    hipDeviceGetAttribute(&cus, hipDeviceAttributeMultiprocessorCount, dev);
    hipFuncSetAttribute((const void*)mega_fwd, hipFuncAttributeMaxDynamicSharedMemorySize, LDS_BYTES);
    hipOccupancyMaxActiveBlocksPerMultiprocessor(&per_cu, (const void*)mega_fwd, 512, LDS_BYTES);
    if (per_cu < 1) { fprintf(stderr, "occupancy query returned %d\n", per_cu); per_cu = 1; }
    if (per_cu > 1) per_cu = 1;
    grid_blocks = cus * per_cu;
  }
  size_t offs[24];
  int nbg = 8;
  while (nbg > 1 && ws_need(nbg, offs) > ws_size) nbg >>= 1;
  const size_t need = ws_need(nbg, offs);
  if (need > ws_size) { fprintf(stderr, "workspace too small: need %zu have %zu\n", need, ws_size); return; }
  Params p{};
  const float** ins = (const float**)&p.x;
  for (int i = 0; i < 25; ++i) ins[i] = (const float*)d_in[i];
  p.out = (float*)d_out;
  unsigned char* ws = (unsigned char*)d_ws;
  p.wt_in = (bf16_t*)(ws + offs[0]); p.wt_brs = (bf16_t*)(ws + offs[1]); p.wt_bra = (bf16_t*)(ws + offs[2]);
  p.wt_o = (bf16_t*)(ws + offs[3]); p.wt_up = (bf16_t*)(ws + offs[4]); p.wt_down = (bf16_t*)(ws + offs[5]);
  p.U = (bf16_t*)(ws + offs[6]); p.KK = (bf16_t*)(ws + offs[7]); p.VT = (bf16_t*)(ws + offs[8]);
  p.H = (bf16_t*)(ws + offs[9]); p.YS = (bf16_t*)(ws + offs[10]); p.YA = (bf16_t*)(ws + offs[11]); p.MG = (bf16_t*)(ws + offs[12]);
  p.DT = (float*)(ws + offs[13]); p.ST = (float*)(ws + offs[14]); p.DEC = (float*)(ws + offs[15]); p.SSQ = (float*)(ws + offs[16]);
  p.XC = (float*)(ws + offs[17]); p.MODP = (float*)(ws + offs[18]); p.MOD = (float*)(ws + offs[19]);
  p.ROPE = (float*)(ws + offs[20]); p.LAM = (float*)(ws + offs[21]);
  p.BAR = (unsigned*)(ws + offs[22]);
  p.CSB = (float*)(ws + offs[23]);
  p.nbg = nbg; p.pad = 0;
  hipMemsetAsync(p.BAR, 0, XCD_BAR_WORDS * 4, stream);
  void* args[] = {&p};
  hipError_t e = hipLaunchCooperativeKernel((const void*)mega_fwd, dim3(grid_blocks), dim3(512), args, LDS_BYTES, stream);
  if (e != hipSuccess) fprintf(stderr, "cooperative launch failed: %s (grid %d)\n", hipGetErrorString(e), grid_blocks);
}
```

```cpp
#include <hip/hip_runtime.h>
#include <hip/hip_cooperative_groups.h>
#include <cstdio>
#include <cstdint>
namespace cg = cooperative_groups;

#define DI __device__ __forceinline__
typedef unsigned short bf16_t;
typedef short bf16x8 __attribute__((ext_vector_type(8)));
typedef float f32x4 __attribute__((ext_vector_type(4)));
typedef unsigned u32x4 __attribute__((ext_vector_type(4)));
typedef unsigned u32x2 __attribute__((ext_vector_type(2)));

constexpr int D = 1024, SEQ = 2048, CTXL = 256, DFF = 2816, DFF2 = 5632;
constexpr int NIN = 8224, NINP = 8448, USTR = 6144;
constexpr int LDS_HALF = 73728;
constexpr int LDS_BYTES = 2 * LDS_HALF + 32;
#define VHALF __builtin_amdgcn_readfirstlane((int)(threadIdx.x >> 8))
#define VB (VHALF * (int)gridDim.x + (int)blockIdx.x)
#define VG ((int)gridDim.x * 2)
constexpr float EPSN = 1e-6f;
constexpr int CONV_TILES = 9872;

struct Params {
  const float *x, *c, *ctx, *c_ctx, *w_mod, *b_mod, *norm1_w, *w_in, *ssd_conv_w, *ssd_conv_b, *a_log, *dt_bias,
      *ssd_d, *ssd_norm_w, *diff_lambda, *subln_w, *w_br_ssd, *w_br_att, *w_out, *norm2_w, *w_up, *ffn_conv_w,
      *ffn_conv_b, *w_down, *final_norm_w;
  float* out;
  bf16_t *wt_in, *wt_brs, *wt_bra, *wt_o, *wt_up, *wt_down;
  bf16_t *U, *KK, *VT, *H, *YS, *YA, *MG;
  float *DT, *ST, *DEC, *SSQ, *XC, *MODP, *MOD, *ROPE, *LAM, *CSB;
  unsigned* BAR;
  int nbg, pad;
};

typedef __bf16 bf16v2_t __attribute__((ext_vector_type(2)));
typedef float f32v2_t __attribute__((ext_vector_type(2)));
DI unsigned pack2(float a, float b) { f32v2_t v = {a, b}; bf16v2_t r = __builtin_convertvector(v, bf16v2_t); return __builtin_bit_cast(unsigned, r); }
DI bf16_t f2bf(float x) { return (bf16_t)(pack2(x, 0.f) & 0xffffu); }
DI float bf2f(bf16_t h) { return __uint_as_float(((unsigned)h) << 16); }
DI float lo_f(unsigned u) { return __uint_as_float(u << 16); }
DI float hi_f(unsigned u) { return __uint_as_float(u & 0xffff0000u); }
DI void unpack8(u32x4 v, float (&f)[8]) {
  f[0] = lo_f(v.x); f[1] = hi_f(v.x); f[2] = lo_f(v.y); f[3] = hi_f(v.y);
  f[4] = lo_f(v.z); f[5] = hi_f(v.z); f[6] = lo_f(v.w); f[7] = hi_f(v.w);
}
DI float silu_f(float x) { return x * __builtin_amdgcn_rcpf(1.f + __expf(-x)); }
DI float sigm_f(float x) { return __builtin_amdgcn_rcpf(1.f + __expf(-x)); }
DI float softplus_f(float x) { return x > 20.f ? x : log1pf(expf(x)); }
DI float shfl_idx(float v, int src_lane) { return __builtin_bit_cast(float, __builtin_amdgcn_ds_bpermute(src_lane << 2, __builtin_bit_cast(int, v))); }
#define LAS3 __attribute__((address_space(3)))
DI void half_sync(unsigned char* vlds, int tid) {
  __builtin_amdgcn_fence(__ATOMIC_RELEASE, "workgroup");
  if ((tid & 63) == 0) {
    LAS3 unsigned* cnt = (LAS3 unsigned*)((LAS3 unsigned char*)vlds + (VHALF ? (LDS_HALF + 20) : (2 * LDS_HALF + 16)));
    const unsigned old = __hip_atomic_fetch_add(cnt, 1u, __ATOMIC_RELAXED, __HIP_MEMORY_SCOPE_WORKGROUP);
    const unsigned target = (old & ~3u) + 4u;
    while ((int)(__hip_atomic_load(cnt, __ATOMIC_RELAXED, __HIP_MEMORY_SCOPE_WORKGROUP) - target) < 0) __builtin_amdgcn_s_sleep(0);
  }
  __builtin_amdgcn_fence(__ATOMIC_ACQUIRE, "workgroup");
}
#define HSYNC() half_sync(lds, tid)
#define MFMA16(a, b, c) __builtin_amdgcn_mfma_f32_16x16x32_bf16((a), (b), (c), 0, 0, 0)

DI const float* xin_row(const Params& p, int layer, int g, int r) {
  const int nl = p.nbg * SEQ;
  if (r < nl) return (layer == 0 ? p.x : p.out) + ((size_t)g * nl + r) * D;
  return (layer == 0 ? p.ctx : p.XC) + ((size_t)g * p.nbg * CTXL + (r - nl)) * D;
}
DI float* xout_row(const Params& p, int g, int r) {
  const int nl = p.nbg * SEQ;
  if (r < nl) return p.out + ((size_t)g * nl + r) * D;
  return p.XC + ((size_t)g * p.nbg * CTXL + (r - nl)) * D;
}
DI int mod_row(const Params& p, int g, int r) {
  const int nl = p.nbg * SEQ;
  return r < nl ? g * p.nbg + r / SEQ : 8;
}

DI int xcd_lin(int round) {
  const int chunk = gridDim.x >> 3;
  return (round * 8 + (blockIdx.x & 7)) * chunk + (blockIdx.x >> 3);
}
DI void tile_map(int t, int MT, int NT, int& mt, int& nt) {
  const int fb = NT >> 3, rem = NT & 7, full = fb * 8 * MT;
  if (t < full) { const int band = t / (8 * MT), r = t - band * 8 * MT; mt = r >> 3; nt = band * 8 + (r & 7); }
  else { const int r = t - full; mt = r / rem; nt = fb * 8 + r % rem; }
}

template <int NI>
DI void gemm_mainloop(const bf16_t* __restrict__ A, int lda, const bf16_t* __restrict__ B, int ldb, int K,
                      f32x4 (&acc)[NI][4], unsigned char* lds, int tid) {
  bf16_t* sA = (bf16_t*)lds;
  bf16_t* sB = (bf16_t*)(lds + 32768);
  const int lane = tid & 63, w = tid >> 6, wm = w & 1, wn = w >> 1, l15 = lane & 15, quad = lane >> 4;
  u32x4 ra0[4], rb0[NI], ra1[4], rb1[NI];
  const int nk = K >> 6;
  const int srow = tid >> 3, skc = (tid & 7) * 8;
  const bf16_t* Ap = A + (size_t)srow * lda + skc;
  const bf16_t* Bp = B + (size_t)srow * ldb + skc;
  const int soff = srow * 64 + (((tid & 7) ^ (srow & 7)) * 8);
  const int sw7 = l15 & 7;
#define G_LOAD(RA, RB, KT)                                                              \
  _Pragma("unroll") for (int r = 0; r < 4; ++r) {                                       \
    RA[r] = *(const u32x4*)(Ap + (size_t)(32 * r) * lda + (KT) * 64);                   \
    if (r < NI) RB[r] = *(const u32x4*)(Bp + (size_t)(32 * r) * ldb + (KT) * 64);       \
  }
#define G_STORE(RA, RB, BUF)                                                            \
  _Pragma("unroll") for (int r = 0; r < 4; ++r) {                                       \
    *(u32x4*)(sA + (BUF) * 8192 + soff + 32 * r * 64) = RA[r];                          \
    if (r < NI) *(u32x4*)(sB + (BUF) * 8192 + soff + 32 * r * 64) = RB[r];              \
  }
#define G_COMPUTE(BUF)                                                                  \
  {                                                                                     \
    const bf16_t* cA = sA + (BUF) * 8192;                                               \
    const bf16_t* cB = sB + (BUF) * 8192;                                               \
    _Pragma("unroll") for (int ks = 0; ks < 2; ++ks) {                                  \
      bf16x8 af[NI], bfr[4];                                                            \
      _Pragma("unroll") for (int i = 0; i < NI; ++i)                                    \
        af[i] = *(const bf16x8*)(cB + (wn * (NI * 16) + i * 16 + l15) * 64 + (((ks * 4 + quad) ^ sw7) * 8)); \
      _Pragma("unroll") for (int j = 0; j < 4; ++j)                                     \
        bfr[j] = *(const bf16x8*)(cA + (wm * 64 + j * 16 + l15) * 64 + (((ks * 4 + quad) ^ sw7) * 8)); \
      _Pragma("unroll") for (int i = 0; i < NI; ++i)                                    \
        _Pragma("unroll") for (int j = 0; j < 4; ++j) acc[i][j] = MFMA16(af[i], bfr[j], acc[i][j]); \
    }                                                                                   \
  }
  G_LOAD(ra0, rb0, 0);
  if (nk > 1) { G_LOAD(ra1, rb1, 1); }
  G_STORE(ra0, rb0, 0);
  __syncthreads();
  for (int kt = 0; kt < nk; kt += 2) {
    if (kt + 2 < nk) { G_LOAD(ra0, rb0, kt + 2); }
    G_COMPUTE(0);
    if (kt + 1 < nk) { G_STORE(ra1, rb1, 1); }
    __syncthreads();
    if (kt + 1 < nk) {
      if (kt + 3 < nk) { G_LOAD(ra1, rb1, kt + 3); }
      G_COMPUTE(1);
      if (kt + 2 < nk) { G_STORE(ra0, rb0, 0); }
      __syncthreads();
    }
  }
#undef G_LOAD
#undef G_STORE
#undef G_COMPUTE
}

template <int NI>
DI void zero_acc(f32x4 (&acc)[NI][4]) {
#pragma unroll
  for (int i = 0; i < NI; ++i)
#pragma unroll
    for (int j = 0; j < 4; ++j) acc[i][j] = (f32x4){0.f, 0.f, 0.f, 0.f};
}

DI void phase0(const Params& p, unsigned char* lds, int tid) {
  if (VB == 0) {
    for (int idx = tid; idx < 1024; idx += 256) {
      const int pos = idx >> 4, f = idx & 15;
      const float inv = powf(10000.f, -(float)f / 16.f);
      const float ang = (float)pos * inv;
      p.ROPE[idx * 2] = cosf(ang);
      p.ROPE[idx * 2 + 1] = sinf(ang);
    }
    if (tid < 2) {
      const float* lf = p.diff_lambda + tid * 256;
      float s1 = 0.f, s2 = 0.f;
      for (int i = 0; i < 64; ++i) { s1 += lf[i] * lf[64 + i]; s2 += lf[128 + i] * lf[192 + i]; }
      const float lam_init = 0.8f - 0.6f * expf(-0.3f * (float)tid);
      p.LAM[tid * 2] = expf(s1) - expf(s2) + lam_init;
      p.LAM[tid * 2 + 1] = 1.f - lam_init;
    }
  }
  {
    const u32x4 z = {0u, 0u, 0u, 0u};
    for (int i = VB * 256 + tid; i < 2 * 28672; i += VG * 256) {
      const int layer = i / 28672, e = i % 28672;
      *(u32x4*)(p.wt_in + (size_t)layer * NINP * D + (size_t)NIN * D + (size_t)e * 8) = z;
    }
  }
  float* sc = (float*)lds;
  for (int item = VB; item < 384; item += VG) {
    const int l = item / 192, rem = item % 192, nc = rem >> 3, kc = rem & 7;
    for (int idx = tid; idx < 1152; idx += 256) {
      const int r = idx >> 7, k = idx & 127;
      const float cv = r < 8 ? p.c[r * D + kc * 128 + k] : p.c_ctx[kc * 128 + k];
      sc[idx] = cv / (1.f + expf(-cv));
    }
    HSYNC();
    float a0 = 0, a1 = 0, a2 = 0, a3 = 0, a4 = 0, a5 = 0, a6 = 0, a7 = 0, a8 = 0;
    const int n = nc * 256 + tid;
    const float* wp = p.w_mod + ((size_t)l * D + kc * 128) * 6144 + n;
#pragma unroll 8
    for (int k = 0; k < 128; ++k) {
      const float wv = wp[(size_t)k * 6144];
      a0 += sc[k] * wv; a1 += sc[128 + k] * wv; a2 += sc[256 + k] * wv; a3 += sc[384 + k] * wv; a4 += sc[512 + k] * wv;
      a5 += sc[640 + k] * wv; a6 += sc[768 + k] * wv; a7 += sc[896 + k] * wv; a8 += sc[1024 + k] * wv;
    }
    float* op = p.MODP + ((size_t)(kc * 2 + l) * 9) * 6144 + n;
    op[0] = a0; op[6144] = a1; op[2 * 6144] = a2; op[3 * 6144] = a3; op[4 * 6144] = a4;
    op[5 * 6144] = a5; op[6 * 6144] = a6; op[7 * 6144] = a7; op[8 * 6144] = a8;
    HSYNC();
  }
  float* tile = (float*)lds;
  for (int item = VB; item < 2 * CONV_TILES; item += VG) {
    const int layer = item / CONV_TILES;
    int t = item % CONV_TILES;
    const float* src; bf16_t* dst; const float* scale = nullptr; int ld, sc0, dr0, ncols, K;
    if (t < 4112) {
      src = p.w_in + (size_t)layer * D * NIN; dst = p.wt_in + (size_t)layer * NINP * D; ld = NIN; K = D;
      if (t < 1536) { sc0 = 0; dr0 = 0; ncols = 3072; }
      else if (t < 3072) { t -= 1536; sc0 = 3104; dr0 = 3072; ncols = 3072; }
      else if (t < 4096) { t -= 3072; sc0 = 6176; dr0 = 6144; ncols = 2048; }
      else { t -= 4096; sc0 = 3072; dr0 = 8192; ncols = 32; }
    } else if (t < 4112 + 1536) {
      t -= 4112; const int which = t >> 9; t &= 511;
      ld = D; K = D; sc0 = 0; dr0 = 0; ncols = D;
      if (which == 0) { src = p.w_br_ssd + (size_t)layer * D * D; dst = p.wt_brs + (size_t)layer * D * D; scale = p.ssd_norm_w + layer * D; }
      else if (which == 1) { src = p.w_br_att + (size_t)layer * D * D; dst = p.wt_bra + (size_t)layer * D * D; }
      else { src = p.w_out + (size_t)layer * D * D; dst = p.wt_o + (size_t)layer * D * D; }
    } else if (t < 4112 + 1536 + 2816) {
      t -= 4112 + 1536;
      src = p.w_up + (size_t)layer * D * DFF2; dst = p.wt_up + (size_t)layer * DFF2 * D; ld = DFF2; K = D; sc0 = 0; dr0 = 0; ncols = DFF2;
    } else {
      t -= 4112 + 1536 + 2816;
      src = p.w_down + (size_t)layer * DFF * D; dst = p.wt_down + (size_t)layer * D * DFF; ld = D; K = DFF; sc0 = 0; dr0 = 0; ncols = D;
    }
    const int nct = ncols >> 5;
    const int tn = t % nct, tk = t / nct;
    const int k0 = tk * 64, n0 = tn * 32;
#pragma unroll
    for (int i = 0; i < 2; ++i) {
      const int kk = (tid >> 3) + 32 * i, n4 = (tid & 7) * 4;
      f32x4 v = *(const f32x4*)(src + (size_t)(k0 + kk) * ld + sc0 + n0 + n4);
      if (scale) { const float sv = scale[k0 + kk]; v[0] *= sv; v[1] *= sv; v[2] *= sv; v[3] *= sv; }
      tile[kk * 33 + n4] = v[0]; tile[kk * 33 + n4 + 1] = v[1]; tile[kk * 33 + n4 + 2] = v[2]; tile[kk * 33 + n4 + 3] = v[3];
    }
    HSYNC();
    {
      const int nn = tid >> 3, k8 = (tid & 7) * 8;
      const float* tp = tile + k8 * 33 + nn;
      u32x4 pk = {pack2(tp[0], tp[33]), pack2(tp[66], tp[99]), pack2(tp[132], tp[165]), pack2(tp[198], tp[231])};
      *(u32x4*)(dst + (size_t)(dr0 + n0 + nn) * K + k0 + k8) = pk;
    }
    HSYNC();
  }
}

DI void phase0b(const Params& p, int tid) {
  for (int i = VB * 256 + tid; i < 2 * 9 * 6144; i += VG * 256) {
    const int n = i % 6144, lr = i / 6144, l = lr / 9, r = lr % 9;
    float s = p.b_mod[l * 6144 + n];
#pragma unroll
    for (int kc = 0; kc < 8; ++kc) s += p.MODP[((size_t)(kc * 2 + l) * 9 + r) * 6144 + n];
    p.MOD[i] = s;
  }
}

DI void norm_phase(const Params& p, int layer, int g, int which, int nrows, int tid) {
  const int lane = tid & 63, w = __builtin_amdgcn_readfirstlane(tid >> 6);
  const float* nw = (which == 0 ? p.norm1_w : p.norm2_w) + layer * D;
  bf16_t* __restrict__ Hout = p.H;
  const int nwaves = VG * 4, rpw = (nrows + nwaves - 1) / nwaves;
  int r = (VB * 4 + w) * rpw;
  const int rend = r + rpw < nrows ? r + rpw : nrows;
  f32x4 wv[4], sh[4], scv[4];
#pragma unroll
  for (int i = 0; i < 4; ++i) wv[i] = *(const f32x4*)(nw + lane * 4 + 256 * i);
  int cur_mod = -1;
  f32x4 v[4];
  if (r < rend) {
    const float* src = which == 0 ? xin_row(p, layer, g, r) : xout_row(p, g, r);
#pragma unroll
    for (int i = 0; i < 4; ++i) v[i] = *(const f32x4*)(src + lane * 4 + 256 * i);
  }
  while (r < rend) {
    const int rn = r + 1;
    f32x4 vn[4];
    if (rn < rend) {
      const float* srcn = which == 0 ? xin_row(p, layer, g, rn) : xout_row(p, g, rn);
#pragma unroll
      for (int i = 0; i < 4; ++i) vn[i] = *(const f32x4*)(srcn + lane * 4 + 256 * i);
    }
    const int mr = mod_row(p, g, r);
    if (mr != cur_mod) {
      cur_mod = mr;
      const float* mod = p.MOD + (size_t)(layer * 9 + mr) * 6144 + (which ? 3072 : 0);
#pragma unroll
      for (int i = 0; i < 4; ++i) { const int col = lane * 4 + 256 * i; sh[i] = *(const f32x4*)(mod + col); scv[i] = *(const f32x4*)(mod + 1024 + col); }
    }
    float ss = 0.f;
#pragma unroll
    for (int i = 0; i < 4; ++i) ss += v[i][0] * v[i][0] + v[i][1] * v[i][1] + v[i][2] * v[i][2] + v[i][3] * v[i][3];
#pragma unroll
    for (int o = 32; o > 0; o >>= 1) ss += shfl_idx(ss, lane ^ o);
    const float rstd = rsqrtf(ss * (1.f / D) + EPSN);
#pragma unroll
    for (int i = 0; i < 4; ++i) {
      const int col = lane * 4 + 256 * i;
      float o0 = v[i][0] * rstd * wv[i][0] * (1.f + scv[i][0]) + sh[i][0];
      float o1 = v[i][1] * rstd * wv[i][1] * (1.f + scv[i][1]) + sh[i][1];
      float o2 = v[i][2] * rstd * wv[i][2] * (1.f + scv[i][2]) + sh[i][2];
      float o3 = v[i][3] * rstd * wv[i][3] * (1.f + scv[i][3]) + sh[i][3];
      u32x2 pk = {pack2(o0, o1), pack2(o2, o3)};
      *(u32x2*)(Hout + (size_t)r * D + col) = pk;
    }
#pragma unroll
    for (int i = 0; i < 4; ++i) v[i] = vn[i];
    r = rn;
  }
}


DI void conv_silu8(const bf16_t* __restrict__ Up, bool hp, bool hn, const float* __restrict__ cw, const float* __restrict__ cb,
                   int ci, float (&o)[8]) {
  const u32x4 z4 = {0u, 0u, 0u, 0u};
  const u32x4 cur = *(const u32x4*)Up;
  const u32x4 prv = hp ? *(const u32x4*)(Up - USTR) : z4;
  const u32x4 nxt = hn ? *(const u32x4*)(Up + USTR) : z4;
  float c[8], pv[8], nx[8];
  unpack8(cur, c); unpack8(prv, pv); unpack8(nxt, nx);
  const f32x4 w0a = *(const f32x4*)(cw + ci), w0b = *(const f32x4*)(cw + ci + 4);
  const f32x4 w1a = *(const f32x4*)(cw + 2048 + ci), w1b = *(const f32x4*)(cw + 2048 + ci + 4);
  const f32x4 w2a = *(const f32x4*)(cw + 4096 + ci), w2b = *(const f32x4*)(cw + 4096 + ci + 4);
  const f32x4 ba = *(const f32x4*)(cb + ci), bb = *(const f32x4*)(cb + ci + 4);
#pragma unroll
  for (int e = 0; e < 4; ++e) {
    const float xa = w0a[e] * pv[e] + w1a[e] * c[e] + w2a[e] * nx[e] + ba[e];
    const float xb = w0b[e] * pv[4 + e] + w1b[e] * c[4 + e] + w2b[e] * nx[4 + e] + bb[e];
    o[e] = silu_f(xa); o[4 + e] = silu_f(xb);
  }
}

DI int chunk_row0(const Params& p, int lb, int cid) {
  return cid < 2 ? p.nbg * SEQ + lb * CTXL + cid * 128 : lb * SEQ + (cid - 2) * 128;
}

DI void ssd_scan_prep(const Params& p, int layer, int row0, int h, float* fl, unsigned char* lds, int tid) {
  float* dtf = fl; float* dtb = fl + 128; float* csf = fl + 256; float* rsb = fl + 384;
  if (tid < 128) {
    const float rf = p.DT[(size_t)(row0 + tid) * 32 + h] + p.dt_bias[layer * 32 + h];
    const float rb = p.DT[(size_t)(row0 + tid) * 32 + 16 + h] + p.dt_bias[layer * 32 + 16 + h];
    dtf[tid] = softplus_f(rf); dtb[tid] = softplus_f(rb);
  }
  HSYNC();
  if (tid < 64) {
    const float Af = -expf(p.a_log[layer * 32 + h]), Ab = -expf(p.a_log[layer * 32 + 16 + h]);
    const float v0 = dtf[2 * tid] * Af, v1 = dtf[2 * tid + 1] * Af;
    const float s = v0 + v1;
    float inc = s;
#pragma unroll
    for (int o = 1; o < 64; o <<= 1) { const float t = shfl_idx(inc, tid >= o ? tid - o : tid); if (tid >= o) inc += t; }
    const float ex = inc - s;
    csf[2 * tid] = ex + v0; csf[2 * tid + 1] = ex + v0 + v1;
    const float w0 = dtb[2 * tid] * Ab, w1 = dtb[2 * tid + 1] * Ab;
    const float s2 = w0 + w1;
    float inc2 = s2;
#pragma unroll
    for (int o = 1; o < 64; o <<= 1) { const float t = shfl_idx(inc2, tid + o < 64 ? tid + o : tid); if (tid + o < 64) inc2 += t; }
    const float ex2 = inc2 - s2;
    rsb[2 * tid + 1] = ex2 + w1; rsb[2 * tid] = ex2 + w1 + w0;
  }
  HSYNC();
}

DI void ssd_state_item(const Params& p, int layer, int lb, int cid, int h, unsigned char* lds, int tid) {
  bf16_t* XfT = (bf16_t*)lds;
  bf16_t* XbT = (bf16_t*)(lds + 17408);
  bf16_t* BT = (bf16_t*)(lds + 34816);
  float* fl = (float*)(lds + 69632);
  const int lane = tid & 63, w = tid >> 6, l15 = lane & 15, quad = lane >> 4;
  const int row0 = chunk_row0(p, lb, cid);
  const int seqlen = cid < 2 ? CTXL : SEQ;
  const int t0 = cid < 2 ? cid * 128 : (cid - 2) * 128;
  const int grp = h >> 2;
  const float* cw = p.ssd_conv_w + layer * 3 * 2048;
  const float* cb = p.ssd_conv_b + layer * 2048;
  ssd_scan_prep(p, layer, row0, h, fl, lds, tid);
  if (tid < 128) *(f32x4*)(p.CSB + (size_t)((lb * 18 + cid) * 16 + h) * 512 + tid * 4) = *(const f32x4*)(fl + tid * 4);
  const float* dtf = fl; const float* dtb = fl + 128; const float* csf = fl + 256; const float* rsb = fl + 384;
  const float cf_end = csf[127], rb_0 = rsb[0];
#pragma unroll 4
  for (int r = 0; r < 4; ++r) {
    const int unit = tid + 256 * r, cgp = unit & 7, l = unit >> 3;
    const int ci = h * 64 + cgp * 8;
    float o[8];
    conv_silu8(p.U + (size_t)(row0 + l) * USTR + 1024 + ci, (t0 + l) > 0, (t0 + l) < seqlen - 1, cw, cb, ci, o);
    const float wf = __expf(cf_end - csf[l]) * dtf[l], wb = __expf(rb_0 - rsb[l]) * dtb[l];
#pragma unroll
    for (int e = 0; e < 8; ++e) {
      XfT[(cgp * 8 + e) * 136 + l] = f2bf(o[e] * wf);
      XbT[(cgp * 8 + e) * 136 + l] = f2bf(o[e] * wb);
    }
  }
#pragma unroll 4
  for (int r = 0; r < 8; ++r) {
    const int unit = tid + 256 * r, cgp = unit & 15, l = unit >> 4;
    const int ci = 1024 + grp * 128 + cgp * 8;
    float o[8];
    conv_silu8(p.U + (size_t)(row0 + l) * USTR + 1024 + ci, (t0 + l) > 0, (t0 + l) < seqlen - 1, cw, cb, ci, o);
#pragma unroll
    for (int e = 0; e < 8; ++e) BT[(cgp * 8 + e) * 136 + l] = f2bf(o[e]);
  }
  HSYNC();
  f32x4 acc[2][4][2];
#pragma unroll
  for (int d = 0; d < 2; ++d)
#pragma unroll
    for (int pt = 0; pt < 4; ++pt)
#pragma unroll
      for (int n2 = 0; n2 < 2; ++n2) acc[d][pt][n2] = (f32x4){0.f, 0.f, 0.f, 0.f};
#pragma unroll
  for (int ks = 0; ks < 4; ++ks) {
    bf16x8 bb[2];
#pragma unroll
    for (int n2 = 0; n2 < 2; ++n2) bb[n2] = *(const bf16x8*)(BT + ((2 * w + n2) * 16 + l15) * 136 + ks * 32 + quad * 8);
#pragma unroll
    for (int pt = 0; pt < 4; ++pt) {
      const bf16x8 af = *(const bf16x8*)(XfT + (pt * 16 + l15) * 136 + ks * 32 + quad * 8);
      const bf16x8 ab = *(const bf16x8*)(XbT + (pt * 16 + l15) * 136 + ks * 32 + quad * 8);
#pragma unroll
      for (int n2 = 0; n2 < 2; ++n2) {
        acc[0][pt][n2] = MFMA16(af, bb[n2], acc[0][pt][n2]);
        acc[1][pt][n2] = MFMA16(ab, bb[n2], acc[1][pt][n2]);
      }
    }
  }
  HSYNC();
  bf16_t* stg = (bf16_t*)lds;
#pragma unroll
  for (int d = 0; d < 2; ++d)
#pragma unroll
    for (int pt = 0; pt < 4; ++pt)
#pragma unroll
      for (int n2 = 0; n2 < 2; ++n2)
#pragma unroll
        for (int reg = 0; reg < 4; ++reg)
          stg[d * (64 * 136) + (pt * 16 + quad * 4 + reg) * 136 + (2 * w + n2) * 16 + l15] = f2bf(acc[d][pt][n2][reg]);
  HSYNC();
#pragma unroll
  for (int k = 0; k < 8; ++k) {
    const int c = tid + 256 * k, d = c >> 10, pr = (c >> 4) & 63, ch = c & 15;
    bf16_t* sp = (bf16_t*)p.ST + ((size_t)(((lb * 2 + d) * 16 + h) * 18 + cid)) * 8192;
    *(u32x4*)(sp + pr * 128 + ch * 8) = *(const u32x4*)(stg + d * (64 * 136) + pr * 136 + ch * 8);
  }
  if (tid == 0) {
    p.DEC[((lb * 2 + 0) * 16 + h) * 18 + cid] = expf(cf_end);
    p.DEC[((lb * 2 + 1) * 16 + h) * 18 + cid] = expf(rb_0);
  }
  HSYNC();
}

DI void attn_item(const Params& p, int layer, int lb, int h, int qb, bool is_ctx, unsigned char* lds, int tid) {
  bf16_t* Ks = (bf16_t*)lds;
  bf16_t* Vs = (bf16_t*)(lds + 34816);
  float* XB = (float*)lds;
  const int lane = tid & 63, w = tid >> 6, l15 = lane & 15, quad = lane >> 4;
  const int comp = w >> 1, qh = w & 1;
  const int nl = p.nbg * SEQ;
  const int ntiles = is_ctx ? 4 : 36;
  const int qrow0 = (is_ctx ? nl + lb * CTXL : lb * SEQ) + qb * 64;
  const bf16_t* KKp = p.KK + (size_t)(lb * 8 + h) * 2304 * 128;
  const bf16_t* VTp = p.VT + (size_t)(lb * 8 + h) * 128 * 2304;
  bf16x8 Qf[2][2];
#pragma unroll
  for (int qt = 0; qt < 2; ++qt)
#pragma unroll
    for (int ks = 0; ks < 2; ++ks)
      Qf[qt][ks] = *(const bf16x8*)(p.U + (size_t)(qrow0 + qh * 32 + qt * 16 + l15) * USTR + 3072 + h * 128 + comp * 64 + ks * 32 + quad * 8);
  f32x4 O[8][2];
#pragma unroll
  for (int et = 0; et < 8; ++et) { O[et][0] = (f32x4){0.f, 0.f, 0.f, 0.f}; O[et][1] = (f32x4){0.f, 0.f, 0.f, 0.f}; }
  float mrun[2] = {-1e30f, -1e30f}, lsum[2] = {0.f, 0.f};
  const float CS = 0.125f * 1.44269504088896f;
  u32x4 rk[4], rv[4];
#pragma unroll
  for (int r = 0; r < 4; ++r) {
    const int q = tid + 256 * r;
    rk[r] = *(const u32x4*)(KKp + (size_t)(q >> 4) * 128 + (q & 15) * 8);
    rv[r] = *(const u32x4*)(VTp + (size_t)(q >> 3) * 2304 + (q & 7) * 8);
  }
#pragma unroll
  for (int r = 0; r < 4; ++r) {
    const int q = tid + 256 * r;
    *(u32x4*)(Ks + (q >> 4) * 136 + (q & 15) * 8) = rk[r];
    *(u32x4*)(Vs + (q >> 3) * 72 + (q & 7) * 8) = rv[r];
  }
  HSYNC();
  for (int kt = 0; kt < ntiles; ++kt) {
    const int cur = kt & 1;
    if (kt + 1 < ntiles) {
#pragma unroll
      for (int r = 0; r < 4; ++r) {
        const int q = tid + 256 * r;
        rk[r] = *(const u32x4*)(KKp + (size_t)((kt + 1) * 64 + (q >> 4)) * 128 + (q & 15) * 8);
        rv[r] = *(const u32x4*)(VTp + (size_t)(q >> 3) * 2304 + (kt + 1) * 64 + (q & 7) * 8);
      }
    }
    const bf16_t* cK = Ks + cur * 8704;
    const bf16_t* cV = Vs + cur * 9216;
    f32x4 S[4][2];
#pragma unroll
    for (int t = 0; t < 4; ++t) { S[t][0] = (f32x4){0.f, 0.f, 0.f, 0.f}; S[t][1] = (f32x4){0.f, 0.f, 0.f, 0.f}; }
#pragma unroll
    for (int ks = 0; ks < 2; ++ks)
#pragma unroll
      for (int t = 0; t < 4; ++t) {
        const bf16x8 a = *(const bf16x8*)(cK + (t * 16 + l15) * 136 + comp * 64 + ks * 32 + quad * 8);
        S[t][0] = MFMA16(a, Qf[0][ks], S[t][0]);
        S[t][1] = MFMA16(a, Qf[1][ks], S[t][1]);
      }
    bf16x8 Pf[2][2];
#pragma unroll
    for (int qt = 0; qt < 2; ++qt) {
      float mx = S[0][qt][0];
#pragma unroll
      for (int t = 0; t < 4; ++t)
#pragma unroll
        for (int reg = 0; reg < 4; ++reg) mx = fmaxf(mx, S[t][qt][reg]);
      mx = fmaxf(mx, shfl_idx(mx, lane ^ 16));
      mx = fmaxf(mx, shfl_idx(mx, lane ^ 32));
      const float mxc = mx * CS;
      const bool need = mxc - mrun[qt] > 8.f;
      if (__builtin_amdgcn_ballot_w64(need) != 0ull) {
        const float mnew = fmaxf(mrun[qt], mxc);
        const float alpha = __builtin_amdgcn_exp2f(mrun[qt] - mnew);
        mrun[qt] = mnew;
        lsum[qt] *= alpha;
#pragma unroll
        for (int et = 0; et < 8; ++et) { O[et][qt][0] *= alpha; O[et][qt][1] *= alpha; O[et][qt][2] *= alpha; O[et][qt][3] *= alpha; }
      }
      const float mc = mrun[qt];
      float ps = 0.f;
      float pv[4][4];
#pragma unroll
      for (int t = 0; t < 4; ++t)
#pragma unroll
        for (int reg = 0; reg < 4; ++reg) { pv[t][reg] = __builtin_amdgcn_exp2f(S[t][qt][reg] * CS - mc); ps += pv[t][reg]; }
      lsum[qt] += ps;
#pragma unroll
      for (int k2 = 0; k2 < 2; ++k2) {
        u32x4 pk = {pack2(pv[2 * k2][0], pv[2 * k2][1]), pack2(pv[2 * k2][2], pv[2 * k2][3]),
                    pack2(pv[2 * k2 + 1][0], pv[2 * k2 + 1][1]), pack2(pv[2 * k2 + 1][2], pv[2 * k2 + 1][3])};
        Pf[qt][k2] = __builtin_bit_cast(bf16x8, pk);
      }
    }
#pragma unroll
    for (int k2 = 0; k2 < 2; ++k2)
#pragma unroll
      for (int et = 0; et < 8; ++et) {
        const u32x2 a0 = *(const u32x2*)(cV + (et * 16 + l15) * 72 + (2 * k2) * 16 + quad * 4);
        const u32x2 a1 = *(const u32x2*)(cV + (et * 16 + l15) * 72 + (2 * k2 + 1) * 16 + quad * 4);
        const u32x4 a4 = {a0.x, a0.y, a1.x, a1.y};
        const bf16x8 a = __builtin_bit_cast(bf16x8, a4);
        O[et][0] = MFMA16(a, Pf[0][k2], O[et][0]);
        O[et][1] = MFMA16(a, Pf[1][k2], O[et][1]);
      }
    if (kt + 1 < ntiles) {
      bf16_t* nK = Ks + (cur ^ 1) * 8704;
      bf16_t* nV = Vs + (cur ^ 1) * 9216;
#pragma unroll
      for (int r = 0; r < 4; ++r) {
        const int q = tid + 256 * r;
        *(u32x4*)(nK + (q >> 4) * 136 + (q & 15) * 8) = rk[r];
        *(u32x4*)(nV + (q >> 3) * 72 + (q & 7) * 8) = rv[r];
      }
    }
    HSYNC();
  }
  const float lam = p.LAM[layer * 2], oml = p.LAM[layer * 2 + 1];
#pragma unroll
  for (int qt = 0; qt < 2; ++qt) {
    float l = lsum[qt];
    l += shfl_idx(l, lane ^ 16);
    l += shfl_idx(l, lane ^ 32);
    const float inv = (comp == 1 ? lam : 1.f) / l;
#pragma unroll
    for (int et = 0; et < 8; ++et) { O[et][qt][0] *= inv; O[et][qt][1] *= inv; O[et][qt][2] *= inv; O[et][qt][3] *= inv; }
  }
  if (comp == 1) {
#pragma unroll
    for (int qt = 0; qt < 2; ++qt)
#pragma unroll
      for (int et = 0; et < 8; ++et) *(f32x4*)(XB + (qh * 32 + qt * 16 + l15) * 132 + et * 16 + quad * 4) = O[et][qt];
  }
  HSYNC();
  if (comp == 0) {
    const float* sw = p.subln_w + layer * 128;
#pragma unroll
    for (int qt = 0; qt < 2; ++qt) {
      float ss = 0.f;
#pragma unroll
      for (int et = 0; et < 8; ++et) {
        const f32x4 o1 = *(const f32x4*)(XB + (qh * 32 + qt * 16 + l15) * 132 + et * 16 + quad * 4);
        O[et][qt][0] -= o1[0]; O[et][qt][1] -= o1[1]; O[et][qt][2] -= o1[2]; O[et][qt][3] -= o1[3];
        ss += O[et][qt][0] * O[et][qt][0] + O[et][qt][1] * O[et][qt][1] + O[et][qt][2] * O[et][qt][2] + O[et][qt][3] * O[et][qt][3];
      }
      ss += shfl_idx(ss, lane ^ 16);
      ss += shfl_idx(ss, lane ^ 32);
      const float rstd = rsqrtf(ss * (1.f / 128.f) + EPSN) * oml;
      const int row = qrow0 + qh * 32 + qt * 16 + l15;
#pragma unroll
      for (int et = 0; et < 8; ++et) {
        const f32x4 wv = *(const f32x4*)(sw + et * 16 + quad * 4);
        u32x2 pk = {pack2(O[et][qt][0] * rstd * wv[0], O[et][qt][1] * rstd * wv[1]),
                    pack2(O[et][qt][2] * rstd * wv[2], O[et][qt][3] * rstd * wv[3])};
        *(u32x2*)(p.YA + (size_t)row * D + h * 128 + et * 16 + quad * 4) = pk;
      }
    }
  }
  HSYNC();
}

DI void attn_item8(const Params& p, int layer, int lb, int h, int qb, bool is_ctx, unsigned char* lds, int tid) {
  bf16_t* Ks = (bf16_t*)lds;
  bf16_t* Vs = (bf16_t*)(lds + 34816);
  float* XB = (float*)lds;
  const int lane = tid & 63, w = tid >> 6, l15 = lane & 15, quad = lane >> 4;
  const int comp = w >> 2, qh = w & 3;
  const int nl = p.nbg * SEQ;
  const int ntiles = is_ctx ? 4 : 36;
  const int qrow0 = (is_ctx ? nl + lb * CTXL : lb * SEQ) + qb * 128;
  const bf16_t* KKp = p.KK + (size_t)(lb * 8 + h) * 2304 * 128;
  const bf16_t* VTp = p.VT + (size_t)(lb * 8 + h) * 128 * 2304;
  bf16x8 Qf[2][2];
#pragma unroll
  for (int qt = 0; qt < 2; ++qt)
#pragma unroll
    for (int ks = 0; ks < 2; ++ks)
      Qf[qt][ks] = *(const bf16x8*)(p.U + (size_t)(qrow0 + qh * 32 + qt * 16 + l15) * USTR + 3072 + h * 128 + comp * 64 + ks * 32 + quad * 8);
  f32x4 O[8][2];
#pragma unroll
  for (int et = 0; et < 8; ++et) { O[et][0] = (f32x4){0.f, 0.f, 0.f, 0.f}; O[et][1] = (f32x4){0.f, 0.f, 0.f, 0.f}; }
  float mrun[2] = {-1e30f, -1e30f}, lsum[2] = {0.f, 0.f};
  const float CS = 0.125f * 1.44269504088896f;
  u32x4 rk[2], rv[2];
#pragma unroll
  for (int r = 0; r < 2; ++r) {
    const int q = tid + 512 * r;
    rk[r] = *(const u32x4*)(KKp + (size_t)(q >> 4) * 128 + (q & 15) * 8);
    rv[r] = *(const u32x4*)(VTp + (size_t)(q >> 3) * 2304 + (q & 7) * 8);
  }
#pragma unroll
  for (int r = 0; r < 2; ++r) {
    const int q = tid + 512 * r;
    *(u32x4*)(Ks + (q >> 4) * 136 + (q & 15) * 8) = rk[r];
    *(u32x4*)(Vs + (q >> 3) * 72 + (q & 7) * 8) = rv[r];
  }
  __syncthreads();
  for (int kt = 0; kt < ntiles; ++kt) {
    const int cur = kt & 1;
    if (kt + 1 < ntiles) {
#pragma unroll
      for (int r = 0; r < 2; ++r) {
        const int q = tid + 512 * r;
        rk[r] = *(const u32x4*)(KKp + (size_t)((kt + 1) * 64 + (q >> 4)) * 128 + (q & 15) * 8);
        rv[r] = *(const u32x4*)(VTp + (size_t)(q >> 3) * 2304 + (kt + 1) * 64 + (q & 7) * 8);
      }
    }
    const bf16_t* cK = Ks + cur * 8704;
    const bf16_t* cV = Vs + cur * 9216;
    f32x4 S[4][2];
#pragma unroll
    for (int t = 0; t < 4; ++t) { S[t][0] = (f32x4){0.f, 0.f, 0.f, 0.f}; S[t][1] = (f32x4){0.f, 0.f, 0.f, 0.f}; }
#pragma unroll
    for (int ks = 0; ks < 2; ++ks)
#pragma unroll
      for (int t = 0; t < 4; ++t) {
        const bf16x8 a = *(const bf16x8*)(cK + (t * 16 + l15) * 136 + comp * 64 + ks * 32 + quad * 8);
        S[t][0] = MFMA16(a, Qf[0][ks], S[t][0]);
        S[t][1] = MFMA16(a, Qf[1][ks], S[t][1]);
      }
    bf16x8 Pf[2][2];
#pragma unroll
    for (int qt = 0; qt < 2; ++qt) {
      float mx = S[0][qt][0];
#pragma unroll
      for (int t = 0; t < 4; ++t)
#pragma unroll
        for (int reg = 0; reg < 4; ++reg) mx = fmaxf(mx, S[t][qt][reg]);
      mx = fmaxf(mx, shfl_idx(mx, lane ^ 16));
      mx = fmaxf(mx, shfl_idx(mx, lane ^ 32));
      const float mxc = mx * CS;
      const bool need = mxc - mrun[qt] > 8.f;
      if (__builtin_amdgcn_ballot_w64(need) != 0ull) {
        const float mnew = fmaxf(mrun[qt], mxc);
        const float alpha = __builtin_amdgcn_exp2f(mrun[qt] - mnew);
        mrun[qt] = mnew;
        lsum[qt] *= alpha;
#pragma unroll
        for (int et = 0; et < 8; ++et) { O[et][qt][0] *= alpha; O[et][qt][1] *= alpha; O[et][qt][2] *= alpha; O[et][qt][3] *= alpha; }
      }
      const float mc = mrun[qt];
      float ps = 0.f;
      float pv[4][4];
#pragma unroll
      for (int t = 0; t < 4; ++t)
#pragma unroll
        for (int reg = 0; reg < 4; ++reg) { pv[t][reg] = __builtin_amdgcn_exp2f(S[t][qt][reg] * CS - mc); ps += pv[t][reg]; }
      lsum[qt] += ps;
#pragma unroll
      for (int k2 = 0; k2 < 2; ++k2) {
        u32x4 pk = {pack2(pv[2 * k2][0], pv[2 * k2][1]), pack2(pv[2 * k2][2], pv[2 * k2][3]),
                    pack2(pv[2 * k2 + 1][0], pv[2 * k2 + 1][1]), pack2(pv[2 * k2 + 1][2], pv[2 * k2 + 1][3])};
        Pf[qt][k2] = __builtin_bit_cast(bf16x8, pk);
      }
    }
#pragma unroll
    for (int k2 = 0; k2 < 2; ++k2)
#pragma unroll
      for (int et = 0; et < 8; ++et) {
        const u32x2 a0 = *(const u32x2*)(cV + (et * 16 + l15) * 72 + (2 * k2) * 16 + quad * 4);
        const u32x2 a1 = *(const u32x2*)(cV + (et * 16 + l15) * 72 + (2 * k2 + 1) * 16 + quad * 4);
        const u32x4 a4 = {a0.x, a0.y, a1.x, a1.y};
        const bf16x8 a = __builtin_bit_cast(bf16x8, a4);
        O[et][0] = MFMA16(a, Pf[0][k2], O[et][0]);
        O[et][1] = MFMA16(a, Pf[1][k2], O[et][1]);
      }
    if (kt + 1 < ntiles) {
      bf16_t* nK = Ks + (cur ^ 1) * 8704;
      bf16_t* nV = Vs + (cur ^ 1) * 9216;
#pragma unroll
      for (int r = 0; r < 2; ++r) {
        const int q = tid + 512 * r;
        *(u32x4*)(nK + (q >> 4) * 136 + (q & 15) * 8) = rk[r];
        *(u32x4*)(nV + (q >> 3) * 72 + (q & 7) * 8) = rv[r];
      }
    }
    __syncthreads();
  }
  const float lam = p.LAM[layer * 2], oml = p.LAM[layer * 2 + 1];
#pragma unroll
  for (int qt = 0; qt < 2; ++qt) {
    float l = lsum[qt];
    l += shfl_idx(l, lane ^ 16);
    l += shfl_idx(l, lane ^ 32);
    const float inv = (comp == 1 ? lam : 1.f) / l;
#pragma unroll
    for (int et = 0; et < 8; ++et) { O[et][qt][0] *= inv; O[et][qt][1] *= inv; O[et][qt][2] *= inv; O[et][qt][3] *= inv; }
  }
  if (comp == 1) {
#pragma unroll
    for (int qt = 0; qt < 2; ++qt)
#pragma unroll
      for (int et = 0; et < 8; ++et) *(f32x4*)(XB + (qh * 32 + qt * 16 + l15) * 132 + et * 16 + quad * 4) = O[et][qt];
  }
  __syncthreads();
  if (comp == 0) {
    const float* sw = p.subln_w + layer * 128;
#pragma unroll
    for (int qt = 0; qt < 2; ++qt) {
      float ss = 0.f;
#pragma unroll
      for (int et = 0; et < 8; ++et) {
        const f32x4 o1 = *(const f32x4*)(XB + (qh * 32 + qt * 16 + l15) * 132 + et * 16 + quad * 4);
        O[et][qt][0] -= o1[0]; O[et][qt][1] -= o1[1]; O[et][qt][2] -= o1[2]; O[et][qt][3] -= o1[3];
        ss += O[et][qt][0] * O[et][qt][0] + O[et][qt][1] * O[et][qt][1] + O[et][qt][2] * O[et][qt][2] + O[et][qt][3] * O[et][qt][3];
      }
      ss += shfl_idx(ss, lane ^ 16);
      ss += shfl_idx(ss, lane ^ 32);
      const float rstd = rsqrtf(ss * (1.f / 128.f) + EPSN) * oml;
      const int row = qrow0 + qh * 32 + qt * 16 + l15;
#pragma unroll
      for (int et = 0; et < 8; ++et) {
        const f32x4 wv = *(const f32x4*)(sw + et * 16 + quad * 4);
        u32x2 pk = {pack2(O[et][qt][0] * rstd * wv[0], O[et][qt][1] * rstd * wv[1]),
                    pack2(O[et][qt][2] * rstd * wv[2], O[et][qt][3] * rstd * wv[3])};
        *(u32x2*)(p.YA + (size_t)row * D + h * 128 + et * 16 + quad * 4) = pk;
      }
    }
  }
  __syncthreads();
}

DI int inproj_main_tiles(int MT, int NT);
DI void inproj_tile(const Params& p, int layer, int g, int item, unsigned char* lds, int tid_);
DI void mix_phase(const Params& p, int layer, int g, unsigned char* lds, int tid_) {
  const int n_al = p.nbg * 8 * 16;
  const int n_ac = layer == 0 ? p.nbg * 8 * 2 : 0;
  const int n_st = p.nbg * 18 * 16;
  for (int item = blockIdx.x; item < n_al; item += gridDim.x) {
    int tid = tid_;
    asm volatile("" : "+v"(tid));
    attn_item8(p, layer, item >> 7, (item >> 4) & 7, item & 15, false, lds, tid);
  }
  {
    const int cshift = (int)gridDim.x >= 128 ? 64 : 0;
    for (int it = ((int)blockIdx.x - cshift + (int)gridDim.x) % (int)gridDim.x; it < n_ac; it += gridDim.x) {
      int tid = tid_;
      asm volatile("" : "+v"(tid));
      attn_item8(p, layer, it >> 4, (it >> 1) & 7, it & 1, true, lds, tid);
    }
  }
  {
    const int MT = (p.nbg * (SEQ + CTXL)) >> 8, NT = NINP >> 8;
    const int n_main = inproj_main_tiles(MT, NT), ntail = MT * NT - n_main;
    const int back = (int)gridDim.x - 1 - (int)blockIdx.x;
    if (back < ntail) {
      inproj_tile(p, layer, g, n_main + back, lds, tid_);
      __syncthreads();
    }
  }
  unsigned char* vlds = lds + VHALF * LDS_HALF;
  for (int item = VB; item < n_st; item += VG) {
    int tid = tid_ & 255;
    asm volatile("" : "+v"(tid));
    const int hh = item & 15, rest = item >> 4, cid = rest % 18, lb = rest / 18;
    ssd_state_item(p, layer, lb, cid, hh, vlds, tid);
  }
}

DI void recur_phase(const Params& p, int tid) {
  const int total = p.nbg * 2 * 16 * 1024;
  for (int idx = VB * 256 + tid; idx < total; idx += VG * 256) {
    const int lbdh = idx >> 10, e8 = idx & 1023;
    const int dir = (lbdh >> 4) & 1;
    bf16_t* base = (bf16_t*)p.ST + (size_t)lbdh * 18 * 8192 + e8 * 8;
    const float* dec = p.DEC + lbdh * 18;
    u32x4 sv[18];
    float dc[18];
#pragma unroll
    for (int k = 0; k < 18; ++k) {
      const int cid = dir == 0 ? k : (k < 2 ? 1 - k : 19 - k);
      sv[k] = *(const u32x4*)(base + (size_t)cid * 8192);
      dc[k] = dec[cid];
    }
    float zf = 0.f;
    asm volatile("" : "+v"(zf));
    float hst[8] = {zf, zf, zf, zf, zf, zf, zf, zf};
#pragma unroll
    for (int k = 0; k < 18; ++k) {
      const int cid = dir == 0 ? k : (k < 2 ? 1 - k : 19 - k);
      u32x4 pk = {pack2(hst[0], hst[1]), pack2(hst[2], hst[3]), pack2(hst[4], hst[5]), pack2(hst[6], hst[7])};
      *(u32x4*)(base + (size_t)cid * 8192) = pk;
      float sf[8];
      unpack8(sv[k], sf);
#pragma unroll
      for (int e = 0; e < 8; ++e) hst[e] = hst[e] * dc[k] + sf[e];
    }
  }
}

DI void ssd_out_item(const Params& p, int layer, int lb, int cid, int h, unsigned char* lds, int tid) {
  bf16_t* Bs = (bf16_t*)lds;
  bf16_t* XT = (bf16_t*)(lds + 34816);
  float* fl = (float*)(lds + 52224);
  const int lane = tid & 63, w = tid >> 6, l15_ = lane & 15, quad_ = lane >> 4;
  const int row0 = chunk_row0(p, lb, cid);
  const int seqlen = cid < 2 ? CTXL : SEQ;
  const int t0 = cid < 2 ? cid * 128 : (cid - 2) * 128;
  const int grp = h >> 2;
  const float* cw = p.ssd_conv_w + layer * 3 * 2048;
  const float* cb = p.ssd_conv_b + layer * 2048;
  if (tid < 128) *(f32x4*)(fl + tid * 4) = *(const f32x4*)(p.CSB + (size_t)((lb * 18 + cid) * 16 + h) * 512 + tid * 4);
  const float* dtf = fl; const float* dtb = fl + 128; const float* csf = fl + 256; const float* rsb = fl + 384;
#pragma unroll 4
  for (int r = 0; r < 8; ++r) {
    const int unit = tid + 256 * r, cgp = unit & 15, l = unit >> 4;
    const int ci = 1024 + grp * 128 + cgp * 8;
    float o[8];
    conv_silu8(p.U + (size_t)(row0 + l) * USTR + 1024 + ci, (t0 + l) > 0, (t0 + l) < seqlen - 1, cw, cb, ci, o);
    u32x4 pk = {pack2(o[0], o[1]), pack2(o[2], o[3]), pack2(o[4], o[5]), pack2(o[6], o[7])};
    *(u32x4*)(Bs + l * 136 + cgp * 8) = pk;
  }
#pragma unroll 4
  for (int r = 0; r < 4; ++r) {
    const int unit = tid + 256 * r, cgp = unit & 7, l = unit >> 3;
    const int ci = h * 64 + cgp * 8;
    float o[8];
    conv_silu8(p.U + (size_t)(row0 + l) * USTR + 1024 + ci, (t0 + l) > 0, (t0 + l) < seqlen - 1, cw, cb, ci, o);
#pragma unroll
    for (int e = 0; e < 8; ++e) XT[(cgp * 8 + e) * 136 + l] = f2bf(o[e]);
  }
  HSYNC();
  bf16_t* Pw = (bf16_t*)(lds + 54272) + w * (16 * 136);
  const float dsk = p.ssd_d[layer * 16 + h];
#pragma unroll 1
  for (int lt = 0; lt < 2; ++lt) {
    int l15 = l15_, quad = quad_;
    asm volatile("" : "+v"(l15), "+v"(quad));
    const int l = w * 32 + lt * 16 + l15;
    bf16x8 Cf[4];
#pragma unroll
    for (int ks = 0; ks < 4; ++ks) {
      const int ci = 1536 + grp * 128 + ks * 32 + quad * 8;
      float o[8];
      conv_silu8(p.U + (size_t)(row0 + l) * USTR + 1024 + ci, (t0 + l) > 0, (t0 + l) < seqlen - 1, cw, cb, ci, o);
      u32x4 pk = {pack2(o[0], o[1]), pack2(o[2], o[3]), pack2(o[4], o[5]), pack2(o[6], o[7])};
      Cf[ks] = __builtin_bit_cast(bf16x8, pk);
    }
    f32x4 cbT[8];
#pragma unroll
    for (int st = 0; st < 8; ++st) cbT[st] = (f32x4){0.f, 0.f, 0.f, 0.f};
#pragma unroll
    for (int ks = 0; ks < 4; ++ks)
#pragma unroll
      for (int st = 0; st < 8; ++st) {
        const bf16x8 a = *(const bf16x8*)(Bs + (st * 16 + l15) * 136 + ks * 32 + quad * 8);
        cbT[st] = MFMA16(a, Cf[ks], cbT[st]);
      }
    f32x4 Y[4];
#pragma unroll
    for (int pt = 0; pt < 4; ++pt) Y[pt] = (f32x4){0.f, 0.f, 0.f, 0.f};
#pragma unroll
    for (int dir = 0; dir < 2; ++dir) {
      const float cl = dir == 0 ? csf[l] : rsb[l];
#pragma unroll
      for (int st = 0; st < 8; ++st) {
        float pv[4];
#pragma unroll
        for (int reg = 0; reg < 4; ++reg) {
          const int s = st * 16 + quad * 4 + reg;
          const bool ok = dir == 0 ? (s <= l) : (s >= l);
          const float cs_s = dir == 0 ? csf[s] : rsb[s];
          const float dts = dir == 0 ? dtf[s] : dtb[s];
          pv[reg] = ok ? cbT[st][reg] * __expf(fminf(cl - cs_s, 0.f)) * dts : 0.f;
        }
        u32x2 pk = {pack2(pv[0], pv[1]), pack2(pv[2], pv[3])};
        *(u32x2*)(Pw + l15 * 136 + st * 16 + quad * 4) = pk;
      }
      asm volatile("s_waitcnt lgkmcnt(0)" ::: "memory");
#pragma unroll
      for (int ks = 0; ks < 4; ++ks) {
        const bf16x8 b0 = *(const bf16x8*)(Pw + l15 * 136 + ks * 32 + quad * 8);
#pragma unroll
        for (int pt = 0; pt < 4; ++pt) {
          const bf16x8 a = *(const bf16x8*)(XT + (pt * 16 + l15) * 136 + ks * 32 + quad * 8);
          Y[pt] = MFMA16(a, b0, Y[pt]);
        }
      }
      asm volatile("s_waitcnt lgkmcnt(0)" ::: "memory");
    }
#pragma unroll
    for (int dir = 0; dir < 2; ++dir) {
      const bf16_t* hp = (const bf16_t*)p.ST + ((size_t)(((lb * 2 + dir) * 16 + h) * 18 + cid)) * 8192;
      f32x4 T[4];
#pragma unroll
      for (int pt = 0; pt < 4; ++pt) T[pt] = (f32x4){0.f, 0.f, 0.f, 0.f};
#pragma unroll
      for (int ks = 0; ks < 4; ++ks)
#pragma unroll
        for (int pt = 0; pt < 4; ++pt) {
          const bf16x8 a = *(const bf16x8*)(hp + (pt * 16 + l15) * 128 + ks * 32 + quad * 8);
          T[pt] = MFMA16(a, Cf[ks], T[pt]);
        }
      const float e = __expf(dir == 0 ? csf[l] : rsb[l]);
#pragma unroll
      for (int pt = 0; pt < 4; ++pt) { Y[pt][0] += e * T[pt][0]; Y[pt][1] += e * T[pt][1]; Y[pt][2] += e * T[pt][2]; Y[pt][3] += e * T[pt][3]; }
    }
    const int row = row0 + l;
    float ss = 0.f;
#pragma unroll
    for (int pt = 0; pt < 4; ++pt) {
      const int pp = pt * 16 + quad * 4;
      const u32x2 zz = *(const u32x2*)(p.U + (size_t)row * USTR + h * 64 + pp);
      const float z0 = lo_f(zz.x), z1 = hi_f(zz.x), z2 = lo_f(zz.y), z3 = hi_f(zz.y);
      float y0 = Y[pt][0] + dsk * bf2f(XT[(pp + 0) * 136 + l]);
      float y1 = Y[pt][1] + dsk * bf2f(XT[(pp + 1) * 136 + l]);
      float y2 = Y[pt][2] + dsk * bf2f(XT[(pp + 2) * 136 + l]);
      float y3 = Y[pt][3] + dsk * bf2f(XT[(pp + 3) * 136 + l]);
      y0 *= silu_f(z0); y1 *= silu_f(z1); y2 *= silu_f(z2); y3 *= silu_f(z3);
      ss += y0 * y0 + y1 * y1 + y2 * y2 + y3 * y3;
      u32x2 pk = {pack2(y0, y1), pack2(y2, y3)};
      *(u32x2*)(p.YS + (size_t)row * D + h * 64 + pp) = pk;
    }
    ss += shfl_idx(ss, lane ^ 16);
    ss += shfl_idx(ss, lane ^ 32);
    if (quad == 0) p.SSQ[(size_t)row * 16 + h] = ss;
  }
  HSYNC();
}

DI void ssdout_phase(const Params& p, int layer, int g, unsigned char* lds, int tid_) {
  const int cid0 = layer == 0 ? 0 : 2;
  const int ncid = 18 - cid0;
  const int n = p.nbg * ncid * 16;
  for (int item = VB; item < n; item += VG) {
    int tid = tid_;
    asm volatile("" : "+v"(tid));
    const int hh = item & 15, rest = item >> 4, cid = cid0 + rest % ncid, lb = rest / ncid;
    ssd_out_item(p, layer, lb, cid, hh, lds, tid);
  }
}

DI void merge_phase(const Params& p, int layer, int g, int mrows, unsigned char* lds, int tid_) {
  const int MT = mrows >> 7, NT = D >> 6;
  const bf16_t* Bs_ = p.wt_brs + (size_t)layer * D * D;
  const bf16_t* Ba_ = p.wt_bra + (size_t)layer * D * D;
  for (int round = 0; (int)blockIdx.x + round * VG < MT * NT; ++round) {
    const int item = VB + round * VG;
    if (item >= MT * NT) {
      for (int i = 0; i < 2 * (1 + (D >> 6)); ++i) __syncthreads();
      continue;
    }
    int tid = tid_;
    asm volatile("" : "+v"(tid));
    const int lane = tid & 63, w = tid >> 6, wm = w & 1, wn = w >> 1, l15 = lane & 15, quad = lane >> 4;
    const int mt = item % MT, nt = item / MT;
    f32x4 as[2][4], aa[2][4];
    zero_acc<2>(as); zero_acc<2>(aa);
    gemm_mainloop<2>(p.YS + (size_t)mt * 128 * D, D, Bs_ + (size_t)nt * 64 * D, D, D, as, lds, tid);
    gemm_mainloop<2>(p.YA + (size_t)mt * 128 * D, D, Ba_ + (size_t)nt * 64 * D, D, D, aa, lds, tid);
    const int mb = mt * 128 + wm * 64, nb = nt * 64 + wn * 32;
#pragma unroll
    for (int j = 0; j < 4; ++j) {
      const int r = mb + j * 16 + l15;
      float ssq = 0.f;
      const f32x4* sq = (const f32x4*)(p.SSQ + (size_t)r * 16);
#pragma unroll
      for (int q = 0; q < 4; ++q) { const f32x4 t = sq[q]; ssq += t[0] + t[1] + t[2] + t[3]; }
      const float rstd = rsqrtf(ssq * (1.f / D) + EPSN);
#pragma unroll
      for (int i = 0; i < 2; ++i) {
        const int n = nb + i * 16 + quad * 4;
        const u32x2 gs = *(const u32x2*)(p.U + (size_t)r * USTR + 4096 + n);
        const u32x2 ga = *(const u32x2*)(p.U + (size_t)r * USTR + 5120 + n);
        const float m0 = sigm_f(lo_f(gs.x)) * rstd * as[i][j][0] + sigm_f(lo_f(ga.x)) * aa[i][j][0];
        const float m1 = sigm_f(hi_f(gs.x)) * rstd * as[i][j][1] + sigm_f(hi_f(ga.x)) * aa[i][j][1];
        const float m2 = sigm_f(lo_f(gs.y)) * rstd * as[i][j][2] + sigm_f(lo_f(ga.y)) * aa[i][j][2];
        const float m3 = sigm_f(hi_f(gs.y)) * rstd * as[i][j][3] + sigm_f(hi_f(ga.y)) * aa[i][j][3];
        u32x2 pk = {pack2(m0, m1), pack2(m2, m3)};
        *(u32x2*)(p.MG + (size_t)r * D + n) = pk;
      }
    }
  }
}

DI void resid_gemm_phase(const Params& p, int layer, int g, int mrows, const bf16_t* A, int K, const bf16_t* Bt, int gate_off,
                         bool src_is_in, unsigned char* lds, int tid_) {
  const int MT = mrows >> 7, NT = D >> 7;
  for (int round = 0; (int)blockIdx.x + round * VG < MT * NT; ++round) {
    const int item = VB + round * VG;
    if (item >= MT * NT) {
      for (int i = 0; i < 1 + (K >> 6); ++i) __syncthreads();
      continue;
    }
    int tid = tid_;
    asm volatile("" : "+v"(tid));
    const int lane = tid & 63, w = tid >> 6, wm = w & 1, wn = w >> 1, l15 = lane & 15, quad = lane >> 4;
    const int mt = item % MT, nt = item / MT;
    f32x4 acc[4][4];
    zero_acc<4>(acc);
    gemm_mainloop<4>(A + (size_t)mt * 128 * K, K, Bt + (size_t)nt * 128 * K, K, K, acc, lds, tid);
    const int mb = mt * 128 + wm * 64, nb = nt * 128 + wn * 64;
#pragma unroll
    for (int j = 0; j < 4; ++j) {
      const int r = mb + j * 16 + l15;
      const float* src = src_is_in ? xin_row(p, layer, g, r) : xout_row(p, g, r);
      float* dst = xout_row(p, g, r);
      const float* gate = p.MOD + (size_t)(layer * 9 + mod_row(p, g, r)) * 6144 + gate_off;
#pragma unroll
      for (int i = 0; i < 4; ++i) {
        const int n = nb + i * 16 + quad * 4;
        const f32x4 xv = *(const f32x4*)(src + n), gv = *(const f32x4*)(gate + n);
        f32x4 o;
        o[0] = xv[0] + gv[0] * acc[i][j][0]; o[1] = xv[1] + gv[1] * acc[i][j][1];
        o[2] = xv[2] + gv[2] * acc[i][j][2]; o[3] = xv[3] + gv[3] * acc[i][j][3];
        *(f32x4*)(dst + n) = o;
      }
    }
  }
}


DI int g8_lds_byte(int r, int c) {
  const int st = (r >> 4) * 2 + (c >> 5), rr = r & 15, cc = c & 31, ob = rr * 64 + cc * 2;
  return st * 1024 + (ob ^ (((ob >> 9) & 1) << 5));
}
DI void g8_stage_rc(int b, int& R, int& C) {
  const int st = b / 1024, sb = b % 1024, swz = sb ^ (((sb >> 9) & 1) << 5);
  R = (st >> 1) * 16 + swz / 64; C = (st & 1) * 32 + (swz % 64) / 2;
}
DI void gemm8p(const bf16_t* __restrict__ Wp, const bf16_t* __restrict__ Xp, f32x4 (&acc)[2][2][4][2], unsigned char* lds, int tid) {
  constexpr int GK = 1024, GBK = 64, GHALF = 128, GHT = GHALF * GBK;
  bf16_t* shm = (bf16_t*)lds;
#define SA(b, h) (shm + ((b) * 2 + (h)) * GHT)
#define SB(b, h) (shm + (4 + (b) * 2 + (h)) * GHT)
  const int wid = tid >> 6, lane = tid & 63, wr = wid >> 2, wc = wid & 3, fr = lane & 15, fq = lane >> 4;
  int goff0, goff1;
  { int r_, c_; g8_stage_rc(tid * 16, r_, c_); goff0 = r_ * GK + c_; g8_stage_rc(tid * 16 + 8192, r_, c_); goff1 = r_ * GK + c_; }
#define STAGE(P, BASE, br, kt) do { \
    __builtin_amdgcn_global_load_lds((const unsigned*)((BASE) + (br) * GK + (kt) * GBK + goff0), (unsigned*)((char*)(P) + tid * 16), 16, 0, 0); \
    __builtin_amdgcn_global_load_lds((const unsigned*)((BASE) + (br) * GK + (kt) * GBK + goff1), (unsigned*)((char*)(P) + tid * 16 + 8192), 16, 0, 0); } while (0)
#define LDA(dst, b, h) _Pragma("unroll") for (int m = 0; m < 4; ++m) _Pragma("unroll") for (int k = 0; k < 2; ++k) \
    dst[m][k] = *reinterpret_cast<const bf16x8*>((char*)SA(b, h) + g8_lds_byte(wr * 64 + m * 16 + fr, k * 32 + fq * 8))
#define LDB(dst, b, h) _Pragma("unroll") for (int n = 0; n < 2; ++n) _Pragma("unroll") for (int k = 0; k < 2; ++k) \
    dst[n][k] = *reinterpret_cast<const bf16x8*>((char*)SB(b, h) + g8_lds_byte(wc * 32 + n * 16 + fr, k * 32 + fq * 8))
#define MMA(ai, bj, At_, Bt_) do { __builtin_amdgcn_s_setprio(1); \
    _Pragma("unroll") for (int m = 0; m < 4; ++m) _Pragma("unroll") for (int n = 0; n < 2; ++n) _Pragma("unroll") for (int k = 0; k < 2; ++k) \
      acc[ai][bj][m][n] = __builtin_amdgcn_mfma_f32_16x16x32_bf16(At_[m][k], Bt_[n][k], acc[ai][bj][m][n], 0, 0, 0); \
    __builtin_amdgcn_s_setprio(0); } while (0)
#define WAIT_V(n) asm volatile("s_waitcnt vmcnt(" #n ")" ::: "memory")
#define WAIT_L(n) asm volatile("s_waitcnt lgkmcnt(" #n ")" ::: "memory")
#define BAR __builtin_amdgcn_s_barrier()
#define SCHED __builtin_amdgcn_sched_barrier(0)
  bf16x8 At[4][2], B0[2][2], B1[2][2];
  constexpr int nt = GK / GBK;
  STAGE(SB(0, 0), Xp, 0, 0); STAGE(SA(0, 0), Wp, 0, 0);
  STAGE(SB(0, 1), Xp, GHALF, 0); STAGE(SA(0, 1), Wp, GHALF, 0);
  if (wr == 1) BAR;
  WAIT_V(4); BAR;
  STAGE(SB(1, 0), Xp, 0, 1); STAGE(SA(1, 0), Wp, 0, 1); STAGE(SB(1, 1), Xp, GHALF, 1);
  WAIT_V(6); BAR;
  for (int t = 0; t < nt - 2; t += 2) {
    LDB(B0, 0, 0); SCHED; LDA(At, 0, 0); STAGE(SA(1, 1), Wp, GHALF, t + 1);
    WAIT_L(8); BAR; WAIT_L(0); MMA(0, 0, At, B0); BAR; SCHED;
    LDB(B1, 0, 1); STAGE(SB(0, 0), Xp, 0, t + 2);
    BAR; WAIT_L(0); MMA(0, 1, At, B1); BAR;
    LDA(At, 0, 1); STAGE(SA(0, 0), Wp, 0, t + 2);
    BAR; WAIT_L(0); MMA(1, 0, At, B0); BAR; SCHED;
    STAGE(SB(0, 1), Xp, GHALF, t + 2);
    WAIT_V(6); BAR; MMA(1, 1, At, B1); BAR;
    LDB(B0, 1, 0); SCHED; LDA(At, 1, 0); STAGE(SA(0, 1), Wp, GHALF, t + 2);
    WAIT_L(8); BAR; WAIT_L(0); MMA(0, 0, At, B0); BAR; SCHED;
    LDB(B1, 1, 1); STAGE(SB(1, 0), Xp, 0, t + 3);
    BAR; WAIT_L(0); MMA(0, 1, At, B1); BAR;
    LDA(At, 1, 1); STAGE(SA(1, 0), Wp, 0, t + 3);
    BAR; WAIT_L(0); MMA(1, 0, At, B0); BAR; SCHED;
    STAGE(SB(1, 1), Xp, GHALF, t + 3);
    WAIT_V(6); BAR; MMA(1, 1, At, B1); BAR;
  }
  { LDB(B0, 0, 0); LDA(At, 0, 0); STAGE(SA(1, 1), Wp, GHALF, nt - 1);
    BAR; WAIT_L(0); MMA(0, 0, At, B0); BAR;
    LDB(B1, 0, 1); BAR; WAIT_L(0); MMA(0, 1, At, B1); BAR;
    LDA(At, 0, 1); WAIT_V(4); BAR; WAIT_L(0); MMA(1, 0, At, B0); MMA(1, 1, At, B1); BAR; }
  { LDB(B0, 1, 0); LDA(At, 1, 0); WAIT_V(2); BAR; WAIT_L(0); MMA(0, 0, At, B0); BAR;
    LDB(B1, 1, 1); WAIT_V(0); BAR; WAIT_L(0); MMA(0, 1, At, B1); BAR;
    LDA(At, 1, 1); BAR; WAIT_L(0); MMA(1, 0, At, B0); MMA(1, 1, At, B1); BAR; }
  if (wr == 0) BAR;
#undef SA
#undef SB
#undef STAGE
#undef LDA
#undef LDB
#undef MMA
#undef WAIT_V
#undef WAIT_L
#undef BAR
#undef SCHED
}
DI void zero_acc8p(f32x4 (&acc)[2][2][4][2]) {
#pragma unroll
  for (int a = 0; a < 2; ++a)
#pragma unroll
    for (int b = 0; b < 2; ++b)
#pragma unroll
      for (int m = 0; m < 4; ++m) { acc[a][b][m][0] = (f32x4){0.f, 0.f, 0.f, 0.f}; acc[a][b][m][1] = (f32x4){0.f, 0.f, 0.f, 0.f}; }
}

DI int inproj_main_tiles(int MT, int NT) {
  const int total = MT * NT, whole = (total / (int)gridDim.x) * (int)gridDim.x;
  return (whole > 0 && whole / MT >= 25 && total - whole <= (int)gridDim.x) ? whole : total;
}
DI void inproj_tile(const Params& p, int layer, int g, int item, unsigned char* lds, int tid_) {
  const int nl = p.nbg * SEQ, mg = p.nbg * (SEQ + CTXL);
  const int MT = mg >> 8;
  const bf16_t* Wt = p.wt_in + (size_t)layer * NINP * D;
  {
    int tid = tid_;
    asm volatile("" : "+v"(tid));
    const int wid = tid >> 6, lane = tid & 63, wr = wid >> 2, wc = wid & 3, fr = lane & 15, fq = lane >> 4;
    const int mt = item % MT, kpos = item / MT;
    const int nt = kpos == 0 ? 32 : (kpos <= 28 ? kpos + 3 : kpos - 29);
    const int m0 = mt * 256, n0 = nt * 256;
    asm volatile("s_waitcnt vmcnt(0)" ::: "memory");
    __syncthreads();
    f32x4 acc[2][2][4][2];
    zero_acc8p(acc);
    gemm8p(Wt + (size_t)n0 * D, p.H + (size_t)m0 * D, acc, lds, tid);
    const bool lat = m0 < nl;
#pragma unroll
    for (int ai = 0; ai < 2; ++ai) {
      const int c0 = n0 + ai * 128 + wr * 64;
      if (c0 >= 3072 && c0 < 5120 && lat) {
#pragma unroll
        for (int bj = 0; bj < 2; ++bj)
#pragma unroll
          for (int ni = 0; ni < 2; ++ni) {
            const int r = m0 + bj * 128 + wc * 32 + ni * 16 + fr, t = r & (SEQ - 1), pr = t >> 6, pc = t & 63;
#pragma unroll
            for (int j = 0; j < 4; ++j) {
              const int f = fq * 4 + j;
              const float cr = p.ROPE[(pr * 16 + f) * 2], sr = p.ROPE[(pr * 16 + f) * 2 + 1];
              const float cc = p.ROPE[(pc * 16 + f) * 2], sc = p.ROPE[(pc * 16 + f) * 2 + 1];
              float x1 = acc[ai][bj][0][ni][j], x2 = acc[ai][bj][1][ni][j];
              acc[ai][bj][0][ni][j] = x1 * cr - x2 * sr; acc[ai][bj][1][ni][j] = x2 * cr + x1 * sr;
              x1 = acc[ai][bj][2][ni][j]; x2 = acc[ai][bj][3][ni][j];
              acc[ai][bj][2][ni][j] = x1 * cc - x2 * sc; acc[ai][bj][3][ni][j] = x2 * cc + x1 * sc;
            }
            asm volatile("" ::: "memory");
          }
      }
    }
    if (n0 < 5120 || (n0 >= 6144 && n0 < 8192)) {
      bf16_t* stg = (bf16_t*)lds + wid * (64 * 136);
#pragma unroll
      for (int ai = 0; ai < 2; ++ai)
#pragma unroll
        for (int bj = 0; bj < 2; ++bj)
#pragma unroll
          for (int ni = 0; ni < 2; ++ni)
#pragma unroll
            for (int mi = 0; mi < 4; ++mi) {
              const f32x4 v = acc[ai][bj][mi][ni];
              u32x2 pk = {pack2(v[0], v[1]), pack2(v[2], v[3])};
              *(u32x2*)(stg + (bj * 32 + ni * 16 + fr) * 136 + ai * 64 + mi * 16 + fq * 4) = pk;
            }
      __syncthreads();
#pragma unroll
      for (int ai = 0; ai < 2; ++ai) {
        const int c0 = n0 + ai * 128 + wr * 64;
#pragma unroll
        for (int k = 0; k < 8; ++k) {
          const int c = lane + 64 * k, rl = c >> 3, cc = c & 7;
          const u32x4 v = *(const u32x4*)(stg + rl * 136 + ai * 64 + cc * 8);
          const int r = m0 + (rl >> 5) * 128 + wc * 32 + (rl & 31);
          bf16_t* dst;
          if (n0 >= 4096 && n0 < 5120) {
            int lb, kj;
            if (lat) { lb = r >> 11; kj = CTXL + (r & (SEQ - 1)); } else { const int rc = r - nl; lb = rc >> 8; kj = rc & 255; }
            const int hh = (c0 - 4096) >> 7, cd0 = (c0 - 4096) & 127;
            dst = p.KK + ((size_t)(lb * 8 + hh) * 2304 + kj) * 128 + cd0;
          } else {
            dst = p.U + (size_t)r * USTR + (n0 < 4096 ? c0 : c0 - 2048);
          }
          *(u32x4*)(dst + cc * 8) = v;
        }
      }
    } else if (n0 < 6144) {
      bf16_t* stg = (bf16_t*)lds + wid * (128 * 72);
#pragma unroll
      for (int ai = 0; ai < 2; ++ai)
#pragma unroll
        for (int bj = 0; bj < 2; ++bj)
#pragma unroll
          for (int ni = 0; ni < 2; ++ni)
#pragma unroll
            for (int mi = 0; mi < 4; ++mi)
#pragma unroll
              for (int j = 0; j < 4; ++j)
                stg[(ai * 64 + mi * 16 + fq * 4 + j) * 72 + bj * 32 + ni * 16 + fr] = f2bf(acc[ai][bj][mi][ni][j]);
      __syncthreads();
#pragma unroll
      for (int k = 0; k < 16; ++k) {
        const int c = lane + 64 * k, el = c >> 3, cc = c & 7;
        const u32x4 v = *(const u32x4*)(stg + el * 72 + cc * 8);
        const int r = m0 + (cc >> 2) * 128 + wc * 32 + (cc & 3) * 8;
        int lb, kj;
        if (lat) { lb = r >> 11; kj = CTXL + (r & (SEQ - 1)); } else { const int rc = r - nl; lb = rc >> 8; kj = rc & 255; }
        const int n = n0 + (el >> 6) * 128 + wr * 64 + (el & 63);
        const int hh = (n - 5120) >> 7, e = (n - 5120) & 127;
        *(u32x4*)(p.VT + ((size_t)(lb * 8 + hh) * 128 + e) * 2304 + kj) = v;
      }
    } else if (n0 == 8192 && wr == 0) {
#pragma unroll
      for (int bj = 0; bj < 2; ++bj)
#pragma unroll
        for (int ni = 0; ni < 2; ++ni) {
          const int r = m0 + bj * 128 + wc * 32 + ni * 16 + fr;
#pragma unroll
          for (int mi = 0; mi < 2; ++mi) *(f32x4*)(p.DT + (size_t)r * 32 + mi * 16 + fq * 4) = acc[0][bj][mi][ni];
        }
    }
  }
}
DI void inproj_phase(const Params& p, int layer, int g, unsigned char* lds, int tid_) {
  const int MT = (p.nbg * (SEQ + CTXL)) >> 8, NT = NINP >> 8;
  const int n_main = inproj_main_tiles(MT, NT);
  for (int item = blockIdx.x; item < n_main; item += gridDim.x) inproj_tile(p, layer, g, item, lds, tid_);
}

DI void up_phase(const Params& p, int layer, int mrows, unsigned char* lds, int tid_) {
  const int MT = mrows >> 8, NT = DFF2 >> 8;
  const bf16_t* Wt = p.wt_up + (size_t)layer * DFF2 * D;
  bf16_t* UF = p.U;
  for (int item = blockIdx.x; item < MT * NT; item += gridDim.x) {
    int tid = tid_;
    asm volatile("" : "+v"(tid));
    const int wid = tid >> 6, lane = tid & 63, wr = wid >> 2, wc = wid & 3, fr = lane & 15, fq = lane >> 4;
    const int mt = item % MT, nt = item / MT;
    const int m0 = mt * 256, n0 = nt * 256;
    asm volatile("s_waitcnt vmcnt(0)" ::: "memory");
    __syncthreads();
    f32x4 acc[2][2][4][2];
    zero_acc8p(acc);
    gemm8p(Wt + (size_t)n0 * D, p.H + (size_t)m0 * D, acc, lds, tid);
    bf16_t* stg = (bf16_t*)lds + wid * (64 * 136);
#pragma unroll
    for (int ai = 0; ai < 2; ++ai)
#pragma unroll
      for (int bj = 0; bj < 2; ++bj)
#pragma unroll
        for (int ni = 0; ni < 2; ++ni)
#pragma unroll
          for (int mi = 0; mi < 4; ++mi) {
            const f32x4 v = acc[ai][bj][mi][ni];
            u32x2 pk = {pack2(v[0], v[1]), pack2(v[2], v[3])};
            *(u32x2*)(stg + (bj * 32 + ni * 16 + fr) * 136 + ai * 64 + mi * 16 + fq * 4) = pk;
          }
    __syncthreads();
#pragma unroll
    for (int ai = 0; ai < 2; ++ai) {
      const int c0 = n0 + ai * 128 + wr * 64;
#pragma unroll
      for (int k = 0; k < 8; ++k) {
        const int c = lane + 64 * k, rl = c >> 3, cc = c & 7;
        const u32x4 v = *(const u32x4*)(stg + rl * 136 + ai * 64 + cc * 8);
        const int r = m0 + (rl >> 5) * 128 + wc * 32 + (rl & 31);
        *(u32x4*)(UF + (size_t)r * DFF2 + c0 + cc * 8) = v;
      }
    }
  }
}

DI void act_phase(const Params& p, int layer, int mrows, int tid) {
  const bf16_t* __restrict__ UF = p.U;
  bf16_t* __restrict__ HID = (bf16_t*)p.ST;
  const int nl = p.nbg * SEQ;
  const float* __restrict__ cw = p.ffn_conv_w + (size_t)layer * 3 * DFF2;
  const float* __restrict__ cb = p.ffn_conv_b + (size_t)layer * DFF2;
  const u32x4 z4 = {0u, 0u, 0u, 0u};
  constexpr int NCH = DFF / 8;
  const int gid = VB * 256 + tid;
  const int slots = (VG * 256) / NCH;
  const int jc = gid % NCH, rslot = gid / NCH;
  if (rslot >= slots) return;
  const int j0 = jc * 8;
  float w0[2][8], w1[2][8], w2[2][8], bb[2][8];
#pragma unroll
  for (int half = 0; half < 2; ++half) {
    const int ci = half * DFF + j0;
#pragma unroll
    for (int e = 0; e < 8; ++e) { w0[half][e] = cw[ci + e]; w1[half][e] = cw[DFF2 + ci + e]; w2[half][e] = cw[2 * DFF2 + ci + e]; bb[half][e] = cb[ci + e]; }
  }
#pragma unroll 2
  for (int r = rslot; r < mrows; r += slots) {
    int t, sl;
    if (r < nl) { t = r & (SEQ - 1); sl = SEQ; } else { t = (r - nl) & (CTXL - 1); sl = CTXL; }
    const bool hp = t > 0, hn = t < sl - 1;
    const bf16_t* up = UF + (size_t)r * DFF2 + j0;
    float av[8], vv[8], res[8];
#pragma unroll
    for (int half = 0; half < 2; ++half) {
      const bf16_t* q = up + half * DFF;
      float c[8], pv[8], nx[8];
      unpack8(*(const u32x4*)q, c);
      unpack8(hp ? *(const u32x4*)(q - DFF2) : z4, pv);
      unpack8(hn ? *(const u32x4*)(q + DFF2) : z4, nx);
#pragma unroll
      for (int e = 0; e < 8; ++e) {
        const float xx = w0[half][e] * pv[e] + w1[half][e] * c[e] + w2[half][e] * nx[e] + bb[half][e];
        if (half == 0) av[e] = xx; else vv[e] = xx;
      }
    }
#pragma unroll
    for (int e = 0; e < 8; ++e) res[e] = silu_f(av[e]) * vv[e];
    u32x4 pk = {pack2(res[0], res[1]), pack2(res[2], res[3]), pack2(res[4], res[5]), pack2(res[6], res[7])};
    *(u32x4*)(HID + (size_t)r * DFF + j0) = pk;
  }
}

DI void final_phase(const Params& p, int tid) {
  const int lane = tid & 63, w = __builtin_amdgcn_readfirstlane(tid >> 6);
  f32x4 wv[4];
#pragma unroll
  for (int i = 0; i < 4; ++i) wv[i] = *(const f32x4*)(p.final_norm_w + lane * 4 + 256 * i);
  int r = VB * 4 + w;
  f32x4 v[4];
  if (r < 8 * SEQ) {
#pragma unroll
    for (int i = 0; i < 4; ++i) v[i] = *(const f32x4*)(p.out + (size_t)r * D + lane * 4 + 256 * i);
  }
  while (r < 8 * SEQ) {
    const int rn = r + VG * 4;
    f32x4 vn[4];
    if (rn < 8 * SEQ) {
#pragma unroll
      for (int i = 0; i < 4; ++i) vn[i] = *(const f32x4*)(p.out + (size_t)rn * D + lane * 4 + 256 * i);
    }
    float ss = 0.f;
#pragma unroll
    for (int i = 0; i < 4; ++i) ss += v[i][0] * v[i][0] + v[i][1] * v[i][1] + v[i][2] * v[i][2] + v[i][3] * v[i][3];
#pragma unroll
    for (int o = 32; o > 0; o >>= 1) ss += shfl_idx(ss, lane ^ o);
    const float rstd = rsqrtf(ss * (1.f / D) + EPSN);
    float* dst = p.out + (size_t)r * D;
#pragma unroll
    for (int i = 0; i < 4; ++i) {
      f32x4 o;
      o[0] = v[i][0] * rstd * wv[i][0]; o[1] = v[i][1] * rstd * wv[i][1]; o[2] = v[i][2] * rstd * wv[i][2]; o[3] = v[i][3] * rstd * wv[i][3];
      *(f32x4*)(dst + lane * 4 + 256 * i) = o;
    }
#pragma unroll
    for (int i = 0; i < 4; ++i) v[i] = vn[i];
    r = rn;
  }
}


#define XB_TMO      128
#define XB_XCNT(j)  (256  + 64 * (j))
#define XB_XSUB(j)  (1280 + 64 * (j))
#define XB_XGEN(j)  (2304 + 64 * (j))
#define XB_TOP      3328
#define XB_TOPGEN   3392
#define XCD_BAR_WORDS 3456
#define XB_SPIN_CAP (1u << 22)
#define LAS __attribute__((address_space(3)))
DI unsigned xb_ld(unsigned* p) { return __hip_atomic_load(p, __ATOMIC_RELAXED, __HIP_MEMORY_SCOPE_AGENT); }
DI unsigned xb_add(unsigned* p, unsigned v) { return __hip_atomic_fetch_add(p, v, __ATOMIC_RELAXED, __HIP_MEMORY_SCOPE_AGENT); }
DI unsigned xb_xcc_id() { return (unsigned)__builtin_amdgcn_s_getreg((3 << 11) | 20) & 0xFu; }
#define XB_SPIN(cond, bar) do { unsigned _sp = 0; while (cond) { __builtin_amdgcn_s_sleep(1); \
    if ((++_sp & 255u) == 0u) { if (xb_ld(&(bar)[XB_TMO])) break; if (_sp > XB_SPIN_CAP) { atomicAdd(&(bar)[XB_TMO], 1u); break; } } } } while (0)
struct XcdBarrier { unsigned* bar; unsigned x; volatile LAS unsigned* st; };
DI XcdBarrier xcd_barrier_post(unsigned* bar, volatile LAS unsigned* st) {
  XcdBarrier b; b.bar = bar; b.x = xb_xcc_id(); b.st = st;
  if (threadIdx.x == 0) (void)xb_add(&bar[XB_XCNT(b.x)], 1u);
  return b;
}
DI void xcd_barrier_complete(unsigned* bar, unsigned x, unsigned& nloc, unsigned& nx) {
  const unsigned G = gridDim.x * gridDim.y * gridDim.z;
  unsigned sum, cnt, sp = 0u;
  for (;;) {
    sum = 0u; cnt = 0u;
#pragma unroll 1
    for (unsigned j = 0; j < 16; ++j) { const unsigned c = xb_ld(&bar[XB_XCNT(j)]); sum += c; cnt += (c > 0u) ? 1u : 0u; }
    if (sum == G) break;
    __builtin_amdgcn_s_sleep(1);
    if ((++sp & 255u) == 0u) { if (xb_ld(&bar[XB_TMO])) break; if (sp > XB_SPIN_CAP) { atomicAdd(&bar[XB_TMO], 1u); break; } }
  }
  const unsigned mine = xb_ld(&bar[XB_XCNT(x)]);
  nloc = mine > 0u ? mine : 1u; nx = cnt > 0u ? cnt : 1u;
}
template <bool FIRST>
DI void xcd_barrier_t(const XcdBarrier& b) {
  asm volatile("s_waitcnt vmcnt(0)" ::: "memory");
  __syncthreads();
  if (threadIdx.x == 0) {
    unsigned* bar = b.bar;
    __builtin_amdgcn_s_waitcnt(0);
    unsigned nloc = b.st[0], nx = b.st[1];
    if (FIRST) { xcd_barrier_complete(bar, b.x, nloc, nx); b.st[0] = nloc; b.st[1] = nx; }
    const unsigned old = xb_add(&bar[XB_XSUB(b.x)], 1u);
    const unsigned gen = old / nloc;
    if (old + 1u == (gen + 1u) * nloc) {
      __builtin_amdgcn_fence(__ATOMIC_RELEASE, "agent");
      asm volatile("s_waitcnt vmcnt(0)" ::: "memory");
      const unsigned og = xb_add(&bar[XB_TOP], 1u);
      const unsigned tg = og / nx;
      if (og + 1u == (tg + 1u) * nx) xb_add(&bar[XB_TOPGEN], 1u);
      else XB_SPIN(xb_ld(&bar[XB_TOPGEN]) == tg, bar);
      __builtin_amdgcn_fence(__ATOMIC_ACQUIRE, "agent");
      xb_add(&bar[XB_XGEN(b.x)], 1u);
      asm volatile("s_waitcnt vmcnt(0)" ::: "memory");
    } else {
      XB_SPIN(xb_ld(&bar[XB_XGEN(b.x)]) == gen, bar);
      __builtin_amdgcn_fence(__ATOMIC_ACQUIRE, "agent");
      asm volatile("s_waitcnt vmcnt(0)" ::: "memory");
    }
  }
  __syncthreads();
}
DI void xcd_barrier(const XcdBarrier& b) { xcd_barrier_t<false>(b); }

__global__ void __launch_bounds__(512) mega_fwd(Params p) {
  extern __shared__ __attribute__((aligned(16))) unsigned char lds[];
  cg::grid_group grid = cg::this_grid();
  const int tid0 = threadIdx.x;
#define OPQ() ({ int t_ = tid0; asm volatile("" : "+v"(t_)); t_; })
#define OPQV() (OPQ() & 255)
  unsigned char* vlds = lds + VHALF * LDS_HALF;
  volatile LAS unsigned* xst = (volatile LAS unsigned*)(lds + 2 * LDS_HALF);
  if (tid0 == 0) { xst[0] = 0u; xst[1] = 0u; xst[2] = 0u; xst[3] = 0u; xst[4] = 0u; xst[5] = 0u; xst[6] = 0u; xst[7] = 0u; }
  __syncthreads();
  const XcdBarrier xb = xcd_barrier_post(p.BAR, xst);
  phase0(p, vlds, OPQV());
  if (p.pad == 0x7fffffff) grid.sync();
  xcd_barrier_t<true>(xb);
  phase0b(p, OPQV());
  xcd_barrier(xb);
  const int ngroups = 8 / p.nbg;
  const int nl = p.nbg * SEQ, mg = p.nbg * (SEQ + CTXL);
  for (int g = 0; g < ngroups; ++g) {
    for (int layer = 0; layer < 2; ++layer) {
      const int mrows = layer == 0 ? mg : nl;
      norm_phase(p, layer, g, 0, mg, OPQV());
      xcd_barrier(xb);
      inproj_phase(p, layer, g, lds, OPQ());
      xcd_barrier(xb);
      mix_phase(p, layer, g, lds, OPQ());
      xcd_barrier(xb);
      recur_phase(p, OPQV());
      xcd_barrier(xb);
      ssdout_phase(p, layer, g, vlds, OPQV());
      xcd_barrier(xb);
      merge_phase(p, layer, g, mrows, vlds, OPQV());
      xcd_barrier(xb);
      resid_gemm_phase(p, layer, g, mrows, p.MG, D, p.wt_o + (size_t)layer * D * D, 2048, true, vlds, OPQV());
      xcd_barrier(xb);
      norm_phase(p, layer, g, 1, mrows, OPQV());
      xcd_barrier(xb);
      up_phase(p, layer, mrows, lds, OPQ());
      xcd_barrier(xb);
      act_phase(p, layer, mrows, OPQV());
      xcd_barrier(xb);
      resid_gemm_phase(p, layer, g, mrows, (const bf16_t*)p.ST, DFF, p.wt_down + (size_t)layer * D * DFF, 5120, false, vlds, OPQV());
      xcd_barrier(xb);
    }
  }
  final_phase(p, OPQV());
}

static size_t ws_need(int nbg, size_t* offs) {
  size_t o = 0;
  auto take = [&](size_t bytes) { size_t r = o; o += (bytes + 255) & ~(size_t)255; return r; };
  offs[0] = take((size_t)2 * NINP * D * 2);
  offs[1] = take((size_t)2 * D * D * 2);
  offs[2] = take((size_t)2 * D * D * 2);
  offs[3] = take((size_t)2 * D * D * 2);
  offs[4] = take((size_t)2 * DFF2 * D * 2);
  offs[5] = take((size_t)2 * D * DFF * 2);
  const size_t mg = (size_t)nbg * 2304;
  offs[6] = take(mg * USTR * 2);
  offs[7] = take((size_t)nbg * 8 * 2304 * 128 * 2);
  offs[8] = take((size_t)nbg * 8 * 128 * 2304 * 2);
  offs[9] = take(mg * D * 2);
  offs[10] = take(mg * D * 2);
  offs[11] = take(mg * D * 2);
  offs[12] = take(mg * D * 2);
  offs[13] = take(mg * 32 * 4);
  offs[14] = take((size_t)nbg * 2 * 16 * 18 * 8192 * 4);
  offs[15] = take((size_t)nbg * 2 * 16 * 18 * 4);
  offs[16] = take(mg * 16 * 4);
  offs[17] = take((size_t)8 * CTXL * D * 4);
  offs[18] = take((size_t)8 * 2 * 9 * 6144 * 4);
  offs[19] = take((size_t)2 * 9 * 6144 * 4);
  offs[20] = take((size_t)1024 * 2 * 4);
  offs[21] = take(256);
  offs[22] = take(XCD_BAR_WORDS * 4);
  offs[23] = take((size_t)nbg * 18 * 16 * 512 * 4);
  return o;
}

extern "C" void kernel_launch(void* const* d_in, const int* in_sizes, int n_in, void* d_out, int out_size, void* d_ws,
                              size_t ws_size, hipStream_t stream) {
  static int grid_blocks = 0;
  if (grid_blocks == 0) {
    int dev = 0, cus = 0, per_cu = 0;
    hipGetDevice(&dev);
    hipDeviceGetAttribute(&cus, hipDeviceAttributeMultiprocessorCount, dev);
    hipFuncSetAttribute((const void*)mega_fwd, hipFuncAttributeMaxDynamicSharedMemorySize, LDS_BYTES);
    hipOccupancyMaxActiveBlocksPerMultiprocessor(&per_cu, (const void*)mega_fwd, 512, LDS_BYTES);
    if (per_cu < 1) { fprintf(stderr, "occupancy query returned %d\n", per_cu); per_cu = 1; }
    if (per_cu > 1) per_cu = 1;
    grid_blocks = cus * per_cu;
  }
  size_t offs[24];
  int nbg = 8;
  while (nbg > 1 && ws_need(nbg, offs) > ws_size) nbg >>= 1;
  const size_t need = ws_need(nbg, offs);
  if (need > ws_size) { fprintf(stderr, "workspace too small: need %zu have %zu\n", need, ws_size); return; }
  Params p{};
  const float** ins = (const float**)&p.x;
  for (int i = 0; i < 25; ++i) ins[i] = (const float*)d_in[i];
  p.out = (float*)d_out;
  unsigned char* ws = (unsigned char*)d_ws;
  p.wt_in = (bf16_t*)(ws + offs[0]); p.wt_brs = (bf16_t*)(ws + offs[1]); p.wt_bra = (bf16_t*)(ws + offs[2]);
  p.wt_o = (bf16_t*)(ws + offs[3]); p.wt_up = (bf16_t*)(ws + offs[4]); p.wt_down = (bf16_t*)(ws + offs[5]);
  p.U = (bf16_t*)(ws + offs[6]); p.KK = (bf16_t*)(ws + offs[7]); p.VT = (bf16_t*)(ws + offs[8]);
  p.H = (bf16_t*)(ws + offs[9]); p.YS = (bf16_t*)(ws + offs[10]); p.YA = (bf16_t*)(ws + offs[11]); p.MG = (bf16_t*)(ws + offs[12]);
  p.DT = (float*)(ws + offs[13]); p.ST = (float*)(ws + offs[14]); p.DEC = (float*)(ws + offs[15]); p.SSQ = (float*)(ws + offs[16]);
  p.XC = (float*)(ws + offs[17]); p.MODP = (float*)(ws + offs[18]); p.MOD = (float*)(ws + offs[19]);
  p.ROPE = (float*)(ws + offs[20]); p.LAM = (float*)(ws + offs[21]);
  p.BAR = (unsigned*)(ws + offs[22]);
  p.CSB = (float*)(ws + offs[23]);
  p.nbg = nbg; p.pad = 0;
  hipMemsetAsync(p.BAR, 0, XCD_BAR_WORDS * 4, stream);
  void* args[] = {&p};
  hipError_t e = hipLaunchCooperativeKernel((const void*)mega_fwd, dim3(grid_blocks), dim3(512), args, LDS_BYTES, stream);
  if (e != hipSuccess) fprintf(stderr, "cooperative launch failed: %s (grid %d)\n", hipGetErrorString(e), grid_blocks);
}
```

```cpp
#include <hip/hip_runtime.h>
#include <hip/hip_cooperative_groups.h>
#include <cstdio>
#include <cstdint>
namespace cg = cooperative_groups;

#define DI __device__ __forceinline__
typedef unsigned short bf16_t;
typedef short bf16x8 __attribute__((ext_vector_type(8)));
typedef float f32x4 __attribute__((ext_vector_type(4)));
typedef unsigned u32x4 __attribute__((ext_vector_type(4)));
typedef unsigned u32x2 __attribute__((ext_vector_type(2)));

constexpr int D = 1024, SEQ = 2048, CTXL = 256, DFF = 2816, DFF2 = 5632;
constexpr int NIN = 8224, NINP = 8448, USTR = 6144;
constexpr int LDS_HALF = 73728;
constexpr int LDS_BYTES = 2 * LDS_HALF + 32;
#define VHALF __builtin_amdgcn_readfirstlane((int)(threadIdx.x >> 8))
#define VB (VHALF * (int)gridDim.x + (int)blockIdx.x)
#define VG ((int)gridDim.x * 2)
constexpr float EPSN = 1e-6f;
constexpr int CONV_TILES = 9872;

struct Params {
  const float *x, *c, *ctx, *c_ctx, *w_mod, *b_mod, *norm1_w, *w_in, *ssd_conv_w, *ssd_conv_b, *a_log, *dt_bias,
      *ssd_d, *ssd_norm_w, *diff_lambda, *subln_w, *w_br_ssd, *w_br_att, *w_out, *norm2_w, *w_up, *ffn_conv_w,
      *ffn_conv_b, *w_down, *final_norm_w;
  float* out;
  bf16_t *wt_in, *wt_brs, *wt_bra, *wt_o, *wt_up, *wt_down;
  bf16_t *U, *KK, *VT, *H, *YS, *YA, *MG;
  float *DT, *ST, *DEC, *SSQ, *XC, *MODP, *MOD, *ROPE, *LAM, *CSB;
  unsigned* BAR;
  int nbg, pad;
};

typedef __bf16 bf16v2_t __attribute__((ext_vector_type(2)));
typedef float f32v2_t __attribute__((ext_vector_type(2)));
DI unsigned pack2(float a, float b) { f32v2_t v = {a, b}; bf16v2_t r = __builtin_convertvector(v, bf16v2_t); return __builtin_bit_cast(unsigned, r); }
DI bf16_t f2bf(float x) { return (bf16_t)(pack2(x, 0.f) & 0xffffu); }
DI float bf2f(bf16_t h) { return __uint_as_float(((unsigned)h) << 16); }
DI float lo_f(unsigned u) { return __uint_as_float(u << 16); }
DI float hi_f(unsigned u) { return __uint_as_float(u & 0xffff0000u); }
DI void unpack8(u32x4 v, float (&f)[8]) {
  f[0] = lo_f(v.x); f[1] = hi_f(v.x); f[2] = lo_f(v.y); f[3] = hi_f(v.y);
  f[4] = lo_f(v.z); f[5] = hi_f(v.z); f[6] = lo_f(v.w); f[7] = hi_f(v.w);
}
DI float silu_f(float x) { return x * __builtin_amdgcn_rcpf(1.f + __expf(-x)); }
DI float sigm_f(float x) { return __builtin_amdgcn_rcpf(1.f + __expf(-x)); }
DI float softplus_f(float x) { return x > 20.f ? x : log1pf(expf(x)); }
DI float shfl_idx(float v, int src_lane) { return __builtin_bit_cast(float, __builtin_amdgcn_ds_bpermute(src_lane << 2, __builtin_bit_cast(int, v))); }
#define LAS3 __attribute__((address_space(3)))
DI void half_sync(unsigned char* vlds, int tid) {
  __builtin_amdgcn_fence(__ATOMIC_RELEASE, "workgroup");
  if ((tid & 63) == 0) {
    LAS3 unsigned* cnt = (LAS3 unsigned*)((LAS3 unsigned char*)vlds + (VHALF ? (LDS_HALF + 20) : (2 * LDS_HALF + 16)));
    const unsigned old = __hip_atomic_fetch_add(cnt, 1u, __ATOMIC_RELAXED, __HIP_MEMORY_SCOPE_WORKGROUP);
    const unsigned target = (old & ~3u) + 4u;
    while ((int)(__hip_atomic_load(cnt, __ATOMIC_RELAXED, __HIP_MEMORY_SCOPE_WORKGROUP) - target) < 0) __builtin_amdgcn_s_sleep(0);
  }
  __builtin_amdgcn_fence(__ATOMIC_ACQUIRE, "workgroup");
}
#define HSYNC() half_sync(lds, tid)
#define MFMA16(a, b, c) __builtin_amdgcn_mfma_f32_16x16x32_bf16((a), (b), (c), 0, 0, 0)

DI const float* xin_row(const Params& p, int layer, int g, int r) {
  const int nl = p.nbg * SEQ;
  if (r < nl) return (layer == 0 ? p.x : p.out) + ((size_t)g * nl + r) * D;
  return (layer == 0 ? p.ctx : p.XC) + ((size_t)g * p.nbg * CTXL + (r - nl)) * D;
}
DI float* xout_row(const Params& p, int g, int r) {
  const int nl = p.nbg * SEQ;
  if (r < nl) return p.out + ((size_t)g * nl + r) * D;
  return p.XC + ((size_t)g * p.nbg * CTXL + (r - nl)) * D;
}
DI int mod_row(const Params& p, int g, int r) {
  const int nl = p.nbg * SEQ;
  return r < nl ? g * p.nbg + r / SEQ : 8;
}

DI int xcd_lin(int round) {
  const int chunk = gridDim.x >> 3;
  return (round * 8 + (blockIdx.x & 7)) * chunk + (blockIdx.x >> 3);
}
DI void tile_map(int t, int MT, int NT, int& mt, int& nt) {
  const int fb = NT >> 3, rem = NT & 7, full = fb * 8 * MT;
  if (t < full) { const int band = t / (8 * MT), r = t - band * 8 * MT; mt = r >> 3; nt = band * 8 + (r & 7); }
  else { const int r = t - full; mt = r / rem; nt = fb * 8 + r % rem; }
}

template <int NI>
DI void gemm_mainloop(const bf16_t* __restrict__ A, int lda, const bf16_t* __restrict__ B, int ldb, int K,
                      f32x4 (&acc)[NI][4], unsigned char* lds, int tid) {
  bf16_t* sA = (bf16_t*)lds;
  bf16_t* sB = (bf16_t*)(lds + 32768);
  const int lane = tid & 63, w = tid >> 6, wm = w & 1, wn = w >> 1, l15 = lane & 15, quad = lane >> 4;
  u32x4 ra0[4], rb0[NI], ra1[4], rb1[NI];
  const int nk = K >> 6;
  const int srow = tid >> 3, skc = (tid & 7) * 8;
  const bf16_t* Ap = A + (size_t)srow * lda + skc;
  const bf16_t* Bp = B + (size_t)srow * ldb + skc;
  const int soff = srow * 64 + (((tid & 7) ^ (srow & 7)) * 8);
  const int sw7 = l15 & 7;
#define G_LOAD(RA, RB, KT)                                                              \
  _Pragma("unroll") for (int r = 0; r < 4; ++r) {                                       \
    RA[r] = *(const u32x4*)(Ap + (size_t)(32 * r) * lda + (KT) * 64);                   \
    if (r < NI) RB[r] = *(const u32x4*)(Bp + (size_t)(32 * r) * ldb + (KT) * 64);       \
  }
#define G_STORE(RA, RB, BUF)                                                            \
  _Pragma("unroll") for (int r = 0; r < 4; ++r) {                                       \
    *(u32x4*)(sA + (BUF) * 8192 + soff + 32 * r * 64) = RA[r];                          \
    if (r < NI) *(u32x4*)(sB + (BUF) * 8192 + soff + 32 * r * 64) = RB[r];              \
  }
#define G_COMPUTE(BUF)                                                                  \
  {                                                                                     \
    const bf16_t* cA = sA + (BUF) * 8192;                                               \
    const bf16_t* cB = sB + (BUF) * 8192;                                               \
    _Pragma("unroll") for (int ks = 0; ks < 2; ++ks) {                                  \
      bf16x8 af[NI], bfr[4];                                                            \
      _Pragma("unroll") for (int i = 0; i < NI; ++i)                                    \
        af[i] = *(const bf16x8*)(cB + (wn * (NI * 16) + i * 16 + l15) * 64 + (((ks * 4 + quad) ^ sw7) * 8)); \
      _Pragma("unroll") for (int j = 0; j < 4; ++j)                                     \
        bfr[j] = *(const bf16x8*)(cA + (wm * 64 + j * 16 + l15) * 64 + (((ks * 4 + quad) ^ sw7) * 8)); \
      _Pragma("unroll") for (int i = 0; i < NI; ++i)                                    \
        _Pragma("unroll") for (int j = 0; j < 4; ++j) acc[i][j] = MFMA16(af[i], bfr[j], acc[i][j]); \
    }                                                                                   \
  }
  G_LOAD(ra0, rb0, 0);
  if (nk > 1) { G_LOAD(ra1, rb1, 1); }
  G_STORE(ra0, rb0, 0);
  __syncthreads();
  for (int kt = 0; kt < nk; kt += 2) {
    if (kt + 2 < nk) { G_LOAD(ra0, rb0, kt + 2); }
    G_COMPUTE(0);
    if (kt + 1 < nk) { G_STORE(ra1, rb1, 1); }
    __syncthreads();
    if (kt + 1 < nk) {
      if (kt + 3 < nk) { G_LOAD(ra1, rb1, kt + 3); }
      G_COMPUTE(1);
      if (kt + 2 < nk) { G_STORE(ra0, rb0, 0); }
      __syncthreads();
    }
  }
#undef G_LOAD
#undef G_STORE
#undef G_COMPUTE
}

template <int NI>
DI void zero_acc(f32x4 (&acc)[NI][4]) {
#pragma unroll
  for (int i = 0; i < NI; ++i)
#pragma unroll
    for (int j = 0; j < 4; ++j) acc[i][j] = (f32x4){0.f, 0.f, 0.f, 0.f};
}

DI void phase0(const Params& p, unsigned char* lds, int tid) {
  if (VB == 0) {
    for (int idx = tid; idx < 1024; idx += 256) {
      const int pos = idx >> 4, f = idx & 15;
      const float inv = powf(10000.f, -(float)f / 16.f);
      const float ang = (float)pos * inv;
      p.ROPE[idx * 2] = cosf(ang);
      p.ROPE[idx * 2 + 1] = sinf(ang);
    }
    if (tid < 2) {
      const float* lf = p.diff_lambda + tid * 256;
      float s1 = 0.f, s2 = 0.f;
      for (int i = 0; i < 64; ++i) { s1 += lf[i] * lf[64 + i]; s2 += lf[128 + i] * lf[192 + i]; }
      const float lam_init = 0.8f - 0.6f * expf(-0.3f * (float)tid);
      p.LAM[tid * 2] = expf(s1) - expf(s2) + lam_init;
      p.LAM[tid * 2 + 1] = 1.f - lam_init;
    }
  }
  {
    const u32x4 z = {0u, 0u, 0u, 0u};
    for (int i = VB * 256 + tid; i < 2 * 28672; i += VG * 256) {
      const int layer = i / 28672, e = i % 28672;
      *(u32x4*)(p.wt_in + (size_t)layer * NINP * D + (size_t)NIN * D + (size_t)e * 8) = z;
    }
  }
  float* sc = (float*)lds;
  for (int item = VB; item < 384; item += VG) {
    const int l = item / 192, rem = item % 192, nc = rem >> 3, kc = rem & 7;
    for (int idx = tid; idx < 1152; idx += 256) {
      const int r = idx >> 7, k = idx & 127;
      const float cv = r < 8 ? p.c[r * D + kc * 128 + k] : p.c_ctx[kc * 128 + k];
      sc[idx] = cv / (1.f + expf(-cv));
    }
    HSYNC();
    float a0 = 0, a1 = 0, a2 = 0, a3 = 0, a4 = 0, a5 = 0, a6 = 0, a7 = 0, a8 = 0;
    const int n = nc * 256 + tid;
    const float* wp = p.w_mod + ((size_t)l * D + kc * 128) * 6144 + n;
#pragma unroll 8
    for (int k = 0; k < 128; ++k) {
      const float wv = wp[(size_t)k * 6144];
      a0 += sc[k] * wv; a1 += sc[128 + k] * wv; a2 += sc[256 + k] * wv; a3 += sc[384 + k] * wv; a4 += sc[512 + k] * wv;
      a5 += sc[640 + k] * wv; a6 += sc[768 + k] * wv; a7 += sc[896 + k] * wv; a8 += sc[1024 + k] * wv;
    }
    float* op = p.MODP + ((size_t)(kc * 2 + l) * 9) * 6144 + n;
    op[0] = a0; op[6144] = a1; op[2 * 6144] = a2; op[3 * 6144] = a3; op[4 * 6144] = a4;
    op[5 * 6144] = a5; op[6 * 6144] = a6; op[7 * 6144] = a7; op[8 * 6144] = a8;
    HSYNC();
  }
  float* tile = (float*)lds;
  for (int item = VB; item < 2 * CONV_TILES; item += VG) {
    const int layer = item / CONV_TILES;
    int t = item % CONV_TILES;
    const float* src; bf16_t* dst; const float* scale = nullptr; int ld, sc0, dr0, ncols, K;
    if (t < 4112) {
      src = p.w_in + (size_t)layer * D * NIN; dst = p.wt_in + (size_t)layer * NINP * D; ld = NIN; K = D;
      if (t < 1536) { sc0 = 0; dr0 = 0; ncols = 3072; }
      else if (t < 3072) { t -= 1536; sc0 = 3104; dr0 = 3072; ncols = 3072; }
      else if (t < 4096) { t -= 3072; sc0 = 6176; dr0 = 6144; ncols = 2048; }
      else { t -= 4096; sc0 = 3072; dr0 = 8192; ncols = 32; }
    } else if (t < 4112 + 1536) {
      t -= 4112; const int which = t >> 9; t &= 511;
      ld = D; K = D; sc0 = 0; dr0 = 0; ncols = D;
      if (which == 0) { src = p.w_br_ssd + (size_t)layer * D * D; dst = p.wt_brs + (size_t)layer * D * D; scale = p.ssd_norm_w + layer * D; }
      else if (which == 1) { src = p.w_br_att + (size_t)layer * D * D; dst = p.wt_bra + (size_t)layer * D * D; }
      else { src = p.w_out + (size_t)layer * D * D; dst = p.wt_o + (size_t)layer * D * D; }
    } else if (t < 4112 + 1536 + 2816) {
      t -= 4112 + 1536;
      src = p.w_up + (size_t)layer * D * DFF2; dst = p.wt_up + (size_t)layer * DFF2 * D; ld = DFF2; K = D; sc0 = 0; dr0 = 0; ncols = DFF2;
    } else {
      t -= 4112 + 1536 + 2816;
      src = p.w_down + (size_t)layer * DFF * D; dst = p.wt_down + (size_t)layer * D * DFF; ld = D; K = DFF; sc0 = 0; dr0 = 0; ncols = D;
    }
    const int nct = ncols >> 5;
    const int tn = t % nct, tk = t / nct;
    const int k0 = tk * 64, n0 = tn * 32;
#pragma unroll
    for (int i = 0; i < 2; ++i) {
      const int kk = (tid >> 3) + 32 * i, n4 = (tid & 7) * 4;
      f32x4 v = *(const f32x4*)(src + (size_t)(k0 + kk) * ld + sc0 + n0 + n4);
      if (scale) { const float sv = scale[k0 + kk]; v[0] *= sv; v[1] *= sv; v[2] *= sv; v[3] *= sv; }
      tile[kk * 33 + n4] = v[0]; tile[kk * 33 + n4 + 1] = v[1]; tile[kk * 33 + n4 + 2] = v[2]; tile[kk * 33 + n4 + 3] = v[3];
    }
    HSYNC();
    {
      const int nn = tid >> 3, k8 = (tid & 7) * 8;
      const float* tp = tile + k8 * 33 + nn;
      u32x4 pk = {pack2(tp[0], tp[33]), pack2(tp[66], tp[99]), pack2(tp[132], tp[165]), pack2(tp[198], tp[231])};
      *(u32x4*)(dst + (size_t)(dr0 + n0 + nn) * K + k0 + k8) = pk;
    }
    HSYNC();
  }
}

DI void phase0b(const Params& p, int tid) {
  for (int i = VB * 256 + tid; i < 2 * 9 * 6144; i += VG * 256) {
    const int n = i % 6144, lr = i / 6144, l = lr / 9, r = lr % 9;
    float s = p.b_mod[l * 6144 + n];
#pragma unroll
    for (int kc = 0; kc < 8; ++kc) s += p.MODP[((size_t)(kc * 2 + l) * 9 + r) * 6144 + n];
    p.MOD[i] = s;
  }
}

DI void norm_phase(const Params& p, int layer, int g, int which, int nrows, int tid) {
  const int lane = tid & 63, w = __builtin_amdgcn_readfirstlane(tid >> 6);
  const float* nw = (which == 0 ? p.norm1_w : p.norm2_w) + layer * D;
  bf16_t* __restrict__ Hout = p.H;
  const int nwaves = VG * 4, rpw = (nrows + nwaves - 1) / nwaves;
  int r = (VB * 4 + w) * rpw;
  const int rend = r + rpw < nrows ? r + rpw : nrows;
  f32x4 wv[4], sh[4], scv[4];
#pragma unroll
  for (int i = 0; i < 4; ++i) wv[i] = *(const f32x4*)(nw + lane * 4 + 256 * i);
  int cur_mod = -1;
  f32x4 v[4];
  if (r < rend) {
    const float* src = which == 0 ? xin_row(p, layer, g, r) : xout_row(p, g, r);
#pragma unroll
    for (int i = 0; i < 4; ++i) v[i] = *(const f32x4*)(src + lane * 4 + 256 * i);
  }
  while (r < rend) {
    const int rn = r + 1;
    f32x4 vn[4];
    if (rn < rend) {
      const float* srcn = which == 0 ? xin_row(p, layer, g, rn) : xout_row(p, g, rn);
#pragma unroll
      for (int i = 0; i < 4; ++i) vn[i] = *(const f32x4*)(srcn + lane * 4 + 256 * i);
    }
    const int mr = mod_row(p, g, r);
    if (mr != cur_mod) {
      cur_mod = mr;
      const float* mod = p.MOD + (size_t)(layer * 9 + mr) * 6144 + (which ? 3072 : 0);
#pragma unroll
      for (int i = 0; i < 4; ++i) { const int col = lane * 4 + 256 * i; sh[i] = *(const f32x4*)(mod + col); scv[i] = *(const f32x4*)(mod + 1024 + col); }
    }
    float ss = 0.f;
#pragma unroll
    for (int i = 0; i < 4; ++i) ss += v[i][0] * v[i][0] + v[i][1] * v[i][1] + v[i][2] * v[i][2] + v[i][3] * v[i][3];
#pragma unroll
    for (int o = 32; o > 0; o >>= 1) ss += shfl_idx(ss, lane ^ o);
    const float rstd = rsqrtf(ss * (1.f / D) + EPSN);
#pragma unroll
    for (int i = 0; i < 4; ++i) {
      const int col = lane * 4 + 256 * i;
      float o0 = v[i][0] * rstd * wv[i][0] * (1.f + scv[i][0]) + sh[i][0];
      float o1 = v[i][1] * rstd * wv[i][1] * (1.f + scv[i][1]) + sh[i][1];
      float o2 = v[i][2] * rstd * wv[i][2] * (1.f + scv[i][2]) + sh[i][2];
      float o3 = v[i][3] * rstd * wv[i][3] * (1.f + scv[i][3]) + sh[i][3];
      u32x2 pk = {pack2(o0, o1), pack2(o2, o3)};
      *(u32x2*)(Hout + (size_t)r * D + col) = pk;
    }
#pragma unroll
    for (int i = 0; i < 4; ++i) v[i] = vn[i];
    r = rn;
  }
}


DI void conv_silu8(const bf16_t* __restrict__ Up, bool hp, bool hn, const float* __restrict__ cw, const float* __restrict__ cb,
                   int ci, float (&o)[8]) {
  const u32x4 z4 = {0u, 0u, 0u, 0u};
  const u32x4 cur = *(const u32x4*)Up;
  const u32x4 prv = hp ? *(const u32x4*)(Up - USTR) : z4;
  const u32x4 nxt = hn ? *(const u32x4*)(Up + USTR) : z4;
  float c[8], pv[8], nx[8];
  unpack8(cur, c); unpack8(prv, pv); unpack8(nxt, nx);
  const f32x4 w0a = *(const f32x4*)(cw + ci), w0b = *(const f32x4*)(cw + ci + 4);
  const f32x4 w1a = *(const f32x4*)(cw + 2048 + ci), w1b = *(const f32x4*)(cw + 2048 + ci + 4);
  const f32x4 w2a = *(const f32x4*)(cw + 4096 + ci), w2b = *(const f32x4*)(cw + 4096 + ci + 4);
  const f32x4 ba = *(const f32x4*)(cb + ci), bb = *(const f32x4*)(cb + ci + 4);
#pragma unroll
  for (int e = 0; e < 4; ++e) {
    const float xa = w0a[e] * pv[e] + w1a[e] * c[e] + w2a[e] * nx[e] + ba[e];
    const float xb = w0b[e] * pv[4 + e] + w1b[e] * c[4 + e] + w2b[e] * nx[4 + e] + bb[e];
    o[e] = silu_f(xa); o[4 + e] = silu_f(xb);
  }
}

DI int chunk_row0(const Params& p, int lb, int cid) {
  return cid < 2 ? p.nbg * SEQ + lb * CTXL + cid * 128 : lb * SEQ + (cid - 2) * 128;
}

DI void ssd_scan_prep(const Params& p, int layer, int row0, int h, float* fl, unsigned char* lds, int tid) {
  float* dtf = fl; float* dtb = fl + 128; float* csf = fl + 256; float* rsb = fl + 384;
  if (tid < 128) {
    const float rf = p.DT[(size_t)(row0 + tid) * 32 + h] + p.dt_bias[layer * 32 + h];
    const float rb = p.DT[(size_t)(row0 + tid) * 32 + 16 + h] + p.dt_bias[layer * 32 + 16 + h];
    dtf[tid] = softplus_f(rf); dtb[tid] = softplus_f(rb);
  }
  HSYNC();
  if (tid < 64) {
    const float Af = -expf(p.a_log[layer * 32 + h]), Ab = -expf(p.a_log[layer * 32 + 16 + h]);
    const float v0 = dtf[2 * tid] * Af, v1 = dtf[2 * tid + 1] * Af;
    const float s = v0 + v1;
    float inc = s;
#pragma unroll
    for (int o = 1; o < 64; o <<= 1) { const float t = shfl_idx(inc, tid >= o ? tid - o : tid); if (tid >= o) inc += t; }
    const float ex = inc - s;
    csf[2 * tid] = ex + v0; csf[2 * tid + 1] = ex + v0 + v1;
    const float w0 = dtb[2 * tid] * Ab, w1 = dtb[2 * tid + 1] * Ab;
    const float s2 = w0 + w1;
    float inc2 = s2;
#pragma unroll
    for (int o = 1; o < 64; o <<= 1) { const float t = shfl_idx(inc2, tid + o < 64 ? tid + o : tid); if (tid + o < 64) inc2 += t; }
    const float ex2 = inc2 - s2;
    rsb[2 * tid + 1] = ex2 + w1; rsb[2 * tid] = ex2 + w1 + w0;
  }
  HSYNC();
}

DI void ssd_state_item(const Params& p, int layer, int lb, int cid, int h, unsigned char* lds, int tid) {
  bf16_t* XfT = (bf16_t*)lds;
  bf16_t* XbT = (bf16_t*)(lds + 17408);
  bf16_t* BT = (bf16_t*)(lds + 34816);
  float* fl = (float*)(lds + 69632);
  const int lane = tid & 63, w = tid >> 6, l15 = lane & 15, quad = lane >> 4;
  const int row0 = chunk_row0(p, lb, cid);
  const int seqlen = cid < 2 ? CTXL : SEQ;
  const int t0 = cid < 2 ? cid * 128 : (cid - 2) * 128;
  const int grp = h >> 2;
  const float* cw = p.ssd_conv_w + layer * 3 * 2048;
  const float* cb = p.ssd_conv_b + layer * 2048;
  ssd_scan_prep(p, layer, row0, h, fl, lds, tid);
  if (tid < 128) *(f32x4*)(p.CSB + (size_t)((lb * 18 + cid) * 16 + h) * 512 + tid * 4) = *(const f32x4*)(fl + tid * 4);
  const float* dtf = fl; const float* dtb = fl + 128; const float* csf = fl + 256; const float* rsb = fl + 384;
  const float cf_end = csf[127], rb_0 = rsb[0];
#pragma unroll 4
  for (int r = 0; r < 4; ++r) {
    const int unit = tid + 256 * r, cgp = unit & 7, l = unit >> 3;
    const int ci = h * 64 + cgp * 8;
    float o[8];
    conv_silu8(p.U + (size_t)(row0 + l) * USTR + 1024 + ci, (t0 + l) > 0, (t0 + l) < seqlen - 1, cw, cb, ci, o);
    const float wf = __expf(cf_end - csf[l]) * dtf[l], wb = __expf(rb_0 - rsb[l]) * dtb[l];
#pragma unroll
    for (int e = 0; e < 8; ++e) {
      XfT[(cgp * 8 + e) * 136 + l] = f2bf(o[e] * wf);
      XbT[(cgp * 8 + e) * 136 + l] = f2bf(o[e] * wb);
    }
  }
#pragma unroll 4
  for (int r = 0; r < 8; ++r) {
    const int unit = tid + 256 * r, cgp = unit & 15, l = unit >> 4;
    const int ci = 1024 + grp * 128 + cgp * 8;
    float o[8];
    conv_silu8(p.U + (size_t)(row0 + l) * USTR + 1024 + ci, (t0 + l) > 0, (t0 + l) < seqlen - 1, cw, cb, ci, o);
#pragma unroll
    for (int e = 0; e < 8; ++e) BT[(cgp * 8 + e) * 136 + l] = f2bf(o[e]);
  }
  HSYNC();
  f32x4 acc[2][4][2];
#pragma unroll
  for (int d = 0; d < 2; ++d)
#pragma unroll
    for (int pt = 0; pt < 4; ++pt)
#pragma unroll
      for (int n2 = 0; n2 < 2; ++n2) acc[d][pt][n2] = (f32x4){0.f, 0.f, 0.f, 0.f};
#pragma unroll
  for (int ks = 0; ks < 4; ++ks) {
    bf16x8 bb[2];
#pragma unroll
    for (int n2 = 0; n2 < 2; ++n2) bb[n2] = *(const bf16x8*)(BT + ((2 * w + n2) * 16 + l15) * 136 + ks * 32 + quad * 8);
#pragma unroll
    for (int pt = 0; pt < 4; ++pt) {
      const bf16x8 af = *(const bf16x8*)(XfT + (pt * 16 + l15) * 136 + ks * 32 + quad * 8);
      const bf16x8 ab = *(const bf16x8*)(XbT + (pt * 16 + l15) * 136 + ks * 32 + quad * 8);
#pragma unroll
      for (int n2 = 0; n2 < 2; ++n2) {
        acc[0][pt][n2] = MFMA16(af, bb[n2], acc[0][pt][n2]);
        acc[1][pt][n2] = MFMA16(ab, bb[n2], acc[1][pt][n2]);
      }
    }
  }
  HSYNC();
  bf16_t* stg = (bf16_t*)lds;
#pragma unroll
  for (int d = 0; d < 2; ++d)
#pragma unroll
    for (int pt = 0; pt < 4; ++pt)
#pragma unroll
      for (int n2 = 0; n2 < 2; ++n2)
#pragma unroll
        for (int reg = 0; reg < 4; ++reg)
          stg[d * (64 * 136) + (pt * 16 + quad * 4 + reg) * 136 + (2 * w + n2) * 16 + l15] = f2bf(acc[d][pt][n2][reg]);
  HSYNC();
#pragma unroll
  for (int k = 0; k < 8; ++k) {
    const int c = tid + 256 * k, d = c >> 10, pr = (c >> 4) & 63, ch = c & 15;
    bf16_t* sp = (bf16_t*)p.ST + ((size_t)(((lb * 2 + d) * 16 + h) * 18 + cid)) * 8192;
    *(u32x4*)(sp + pr * 128 + ch * 8) = *(const u32x4*)(stg + d * (64 * 136) + pr * 136 + ch * 8);
  }
  if (tid == 0) {
    p.DEC[((lb * 2 + 0) * 16 + h) * 18 + cid] = expf(cf_end);
    p.DEC[((lb * 2 + 1) * 16 + h) * 18 + cid] = expf(rb_0);
  }
  HSYNC();
}

DI void attn_item(const Params& p, int layer, int lb, int h, int qb, bool is_ctx, unsigned char* lds, int tid) {
  bf16_t* Ks = (bf16_t*)lds;
  bf16_t* Vs = (bf16_t*)(lds + 34816);
  float* XB = (float*)lds;
  const int lane = tid & 63, w = tid >> 6, l15 = lane & 15, quad = lane >> 4;
  const int comp = w >> 1, qh = w & 1;
  const int nl = p.nbg * SEQ;
  const int ntiles = is_ctx ? 4 : 36;
  const int qrow0 = (is_ctx ? nl + lb * CTXL : lb * SEQ) + qb * 64;
  const bf16_t* KKp = p.KK + (size_t)(lb * 8 + h) * 2304 * 128;
  const bf16_t* VTp = p.VT + (size_t)(lb * 8 + h) * 128 * 2304;
  bf16x8 Qf[2][2];
#pragma unroll
  for (int qt = 0; qt < 2; ++qt)
#pragma unroll
    for (int ks = 0; ks < 2; ++ks)
      Qf[qt][ks] = *(const bf16x8*)(p.U + (size_t)(qrow0 + qh * 32 + qt * 16 + l15) * USTR + 3072 + h * 128 + comp * 64 + ks * 32 + quad * 8);
  f32x4 O[8][2];
#pragma unroll
  for (int et = 0; et < 8; ++et) { O[et][0] = (f32x4){0.f, 0.f, 0.f, 0.f}; O[et][1] = (f32x4){0.f, 0.f, 0.f, 0.f}; }
  float mrun[2] = {-1e30f, -1e30f}, lsum[2] = {0.f, 0.f};
  const float CS = 0.125f * 1.44269504088896f;
  u32x4 rk[4], rv[4];
#pragma unroll
  for (int r = 0; r < 4; ++r) {
    const int q = tid + 256 * r;
    rk[r] = *(const u32x4*)(KKp + (size_t)(q >> 4) * 128 + (q & 15) * 8);
    rv[r] = *(const u32x4*)(VTp + (size_t)(q >> 3) * 2304 + (q & 7) * 8);
  }
#pragma unroll
  for (int r = 0; r < 4; ++r) {
    const int q = tid + 256 * r;
    *(u32x4*)(Ks + (q >> 4) * 136 + (q & 15) * 8) = rk[r];
    *(u32x4*)(Vs + (q >> 3) * 72 + (q & 7) * 8) = rv[r];
  }
  HSYNC();
  for (int kt = 0; kt < ntiles; ++kt) {
    const int cur = kt & 1;
    if (kt + 1 < ntiles) {
#pragma unroll
      for (int r = 0; r < 4; ++r) {
        const int q = tid + 256 * r;
        rk[r] = *(const u32x4*)(KKp + (size_t)((kt + 1) * 64 + (q >> 4)) * 128 + (q & 15) * 8);
        rv[r] = *(const u32x4*)(VTp + (size_t)(q >> 3) * 2304 + (kt + 1) * 64 + (q & 7) * 8);
      }
    }
    const bf16_t* cK = Ks + cur * 8704;
    const bf16_t* cV = Vs + cur * 9216;
    f32x4 S[4][2];
#pragma unroll
    for (int t = 0; t < 4; ++t) { S[t][0] = (f32x4){0.f, 0.f, 0.f, 0.f}; S[t][1] = (f32x4){0.f, 0.f, 0.f, 0.f}; }
#pragma unroll
    for (int ks = 0; ks < 2; ++ks)
#pragma unroll
      for (int t = 0; t < 4; ++t) {
        const bf16x8 a = *(const bf16x8*)(cK + (t * 16 + l15) * 136 + comp * 64 + ks * 32 + quad * 8);
        S[t][0] = MFMA16(a, Qf[0][ks], S[t][0]);
        S[t][1] = MFMA16(a, Qf[1][ks], S[t][1]);
      }
    bf16x8 Pf[2][2];
#pragma unroll
    for (int qt = 0; qt < 2; ++qt) {
      float mx = S[0][qt][0];
#pragma unroll
      for (int t = 0; t < 4; ++t)
#pragma unroll
        for (int reg = 0; reg < 4; ++reg) mx = fmaxf(mx, S[t][qt][reg]);
      mx = fmaxf(mx, shfl_idx(mx, lane ^ 16));
      mx = fmaxf(mx, shfl_idx(mx, lane ^ 32));
      const float mxc = mx * CS;
      const bool need = mxc - mrun[qt] > 8.f;
      if (__builtin_amdgcn_ballot_w64(need) != 0ull) {
        const float mnew = fmaxf(mrun[qt], mxc);
        const float alpha = __builtin_amdgcn_exp2f(mrun[qt] - mnew);
        mrun[qt] = mnew;
        lsum[qt] *= alpha;
#pragma unroll
        for (int et = 0; et < 8; ++et) { O[et][qt][0] *= alpha; O[et][qt][1] *= alpha; O[et][qt][2] *= alpha; O[et][qt][3] *= alpha; }
      }
      const float mc = mrun[qt];
      float ps = 0.f;
      float pv[4][4];
#pragma unroll
      for (int t = 0; t < 4; ++t)
#pragma unroll
        for (int reg = 0; reg < 4; ++reg) { pv[t][reg] = __builtin_amdgcn_exp2f(S[t][qt][reg] * CS - mc); ps += pv[t][reg]; }
      lsum[qt] += ps;
#pragma unroll
      for (int k2 = 0; k2 < 2; ++k2) {
        u32x4 pk = {pack2(pv[2 * k2][0], pv[2 * k2][1]), pack2(pv[2 * k2][2], pv[2 * k2][3]),
                    pack2(pv[2 * k2 + 1][0], pv[2 * k2 + 1][1]), pack2(pv[2 * k2 + 1][2], pv[2 * k2 + 1][3])};
        Pf[qt][k2] = __builtin_bit_cast(bf16x8, pk);
      }
    }
#pragma unroll
    for (int k2 = 0; k2 < 2; ++k2)
#pragma unroll
      for (int et = 0; et < 8; ++et) {
        const u32x2 a0 = *(const u32x2*)(cV + (et * 16 + l15) * 72 + (2 * k2) * 16 + quad * 4);
        const u32x2 a1 = *(const u32x2*)(cV + (et * 16 + l15) * 72 + (2 * k2 + 1) * 16 + quad * 4);
        const u32x4 a4 = {a0.x, a0.y, a1.x, a1.y};
        const bf16x8 a = __builtin_bit_cast(bf16x8, a4);
        O[et][0] = MFMA16(a, Pf[0][k2], O[et][0]);
        O[et][1] = MFMA16(a, Pf[1][k2], O[et][1]);
      }
    if (kt + 1 < ntiles) {
      bf16_t* nK = Ks + (cur ^ 1) * 8704;
      bf16_t* nV = Vs + (cur ^ 1) * 9216;
#pragma unroll
      for (int r = 0; r < 4; ++r) {
        const int q = tid + 256 * r;
        *(u32x4*)(nK + (q >> 4) * 136 + (q & 15) * 8) = rk[r];
        *(u32x4*)(nV + (q >> 3) * 72 + (q & 7) * 8) = rv[r];
      }
    }
    HSYNC();
  }
  const float lam = p.LAM[layer * 2], oml = p.LAM[layer * 2 + 1];
#pragma unroll
  for (int qt = 0; qt < 2; ++qt) {
    float l = lsum[qt];
    l += shfl_idx(l, lane ^ 16);
    l += shfl_idx(l, lane ^ 32);
    const float inv = (comp == 1 ? lam : 1.f) / l;
#pragma unroll
    for (int et = 0; et < 8; ++et) { O[et][qt][0] *= inv; O[et][qt][1] *= inv; O[et][qt][2] *= inv; O[et][qt][3] *= inv; }
  }
  if (comp == 1) {
#pragma unroll
    for (int qt = 0; qt < 2; ++qt)
#pragma unroll
      for (int et = 0; et < 8; ++et) *(f32x4*)(XB + (qh * 32 + qt * 16 + l15) * 132 + et * 16 + quad * 4) = O[et][qt];
  }
  HSYNC();
  if (comp == 0) {
    const float* sw = p.subln_w + layer * 128;
#pragma unroll
    for (int qt = 0; qt < 2; ++qt) {
      float ss = 0.f;
#pragma unroll
      for (int et = 0; et < 8; ++et) {
        const f32x4 o1 = *(const f32x4*)(XB + (qh * 32 + qt * 16 + l15) * 132 + et * 16 + quad * 4);
        O[et][qt][0] -= o1[0]; O[et][qt][1] -= o1[1]; O[et][qt][2] -= o1[2]; O[et][qt][3] -= o1[3];
        ss += O[et][qt][0] * O[et][qt][0] + O[et][qt][1] * O[et][qt][1] + O[et][qt][2] * O[et][qt][2] + O[et][qt][3] * O[et][qt][3];
      }
      ss += shfl_idx(ss, lane ^ 16);
      ss += shfl_idx(ss, lane ^ 32);
      const float rstd = rsqrtf(ss * (1.f / 128.f) + EPSN) * oml;
      const int row = qrow0 + qh * 32 + qt * 16 + l15;
#pragma unroll
      for (int et = 0; et < 8; ++et) {
        const f32x4 wv = *(const f32x4*)(sw + et * 16 + quad * 4);
        u32x2 pk = {pack2(O[et][qt][0] * rstd * wv[0], O[et][qt][1] * rstd * wv[1]),
                    pack2(O[et][qt][2] * rstd * wv[2], O[et][qt][3] * rstd * wv[3])};
        *(u32x2*)(p.YA + (size_t)row * D + h * 128 + et * 16 + quad * 4) = pk;
      }
    }
  }
  HSYNC();
}

DI void attn_item8(const Params& p, int layer, int lb, int h, int qb, bool is_ctx, unsigned char* lds, int tid) {
  bf16_t* Ks = (bf16_t*)lds;
  bf16_t* Vs = (bf16_t*)(lds + 34816);
  float* XB = (float*)lds;
  const int lane = tid & 63, w = tid >> 6, l15 = lane & 15, quad = lane >> 4;
  const int comp = w >> 2, qh = w & 3;
  const int nl = p.nbg * SEQ;
  const int ntiles = is_ctx ? 4 : 36;
  const int qrow0 = (is_ctx ? nl + lb * CTXL : lb * SEQ) + qb * 128;
  const bf16_t* KKp = p.KK + (size_t)(lb * 8 + h) * 2304 * 128;
  const bf16_t* VTp = p.VT + (size_t)(lb * 8 + h) * 128 * 2304;
  bf16x8 Qf[2][2];
#pragma unroll
  for (int qt = 0; qt < 2; ++qt)
#pragma unroll
    for (int ks = 0; ks < 2; ++ks)
      Qf[qt][ks] = *(const bf16x8*)(p.U + (size_t)(qrow0 + qh * 32 + qt * 16 + l15) * USTR + 3072 + h * 128 + comp * 64 + ks * 32 + quad * 8);
  f32x4 O[8][2];
#pragma unroll
  for (int et = 0; et < 8; ++et) { O[et][0] = (f32x4){0.f, 0.f, 0.f, 0.f}; O[et][1] = (f32x4){0.f, 0.f, 0.f, 0.f}; }
  float mrun[2] = {-1e30f, -1e30f}, lsum[2] = {0.f, 0.f};
  const float CS = 0.125f * 1.44269504088896f;
  u32x4 rk[2], rv[2];
#pragma unroll
  for (int r = 0; r < 2; ++r) {
    const int q = tid + 512 * r;
    rk[r] = *(const u32x4*)(KKp + (size_t)(q >> 4) * 128 + (q & 15) * 8);
    rv[r] = *(const u32x4*)(VTp + (size_t)(q >> 3) * 2304 + (q & 7) * 8);
  }
#pragma unroll
  for (int r = 0; r < 2; ++r) {
    const int q = tid + 512 * r;
    *(u32x4*)(Ks + (q >> 4) * 136 + (q & 15) * 8) = rk[r];
    *(u32x4*)(Vs + (q >> 3) * 72 + (q & 7) * 8) = rv[r];
  }
  __syncthreads();
  for (int kt = 0; kt < ntiles; ++kt) {
    const int cur = kt & 1;
    if (kt + 1 < ntiles) {
#pragma unroll
      for (int r = 0; r < 2; ++r) {
        const int q = tid + 512 * r;
        rk[r] = *(const u32x4*)(KKp + (size_t)((kt + 1) * 64 + (q >> 4)) * 128 + (q & 15) * 8);
        rv[r] = *(const u32x4*)(VTp + (size_t)(q >> 3) * 2304 + (kt + 1) * 64 + (q & 7) * 8);
      }
    }
    const bf16_t* cK = Ks + cur * 8704;
    const bf16_t* cV = Vs + cur * 9216;
    f32x4 S[4][2];
#pragma unroll
    for (int t = 0; t < 4; ++t) { S[t][0] = (f32x4){0.f, 0.f, 0.f, 0.f}; S[t][1] = (f32x4){0.f, 0.f, 0.f, 0.f}; }
#pragma unroll
    for (int ks = 0; ks < 2; ++ks)
#pragma unroll
      for (int t = 0; t < 4; ++t) {
        const bf16x8 a = *(const bf16x8*)(cK + (t * 16 + l15) * 136 + comp * 64 + ks * 32 + quad * 8);
        S[t][0] = MFMA16(a, Qf[0][ks], S[t][0]);
        S[t][1] = MFMA16(a, Qf[1][ks], S[t][1]);
      }
    bf16x8 Pf[2][2];
#pragma unroll
    for (int qt = 0; qt < 2; ++qt) {
      float mx = S[0][qt][0];
#pragma unroll
      for (int t = 0; t < 4; ++t)
#pragma unroll
        for (int reg = 0; reg < 4; ++reg) mx = fmaxf(mx, S[t][qt][reg]);
      mx = fmaxf(mx, shfl_idx(mx, lane ^ 16));
      mx = fmaxf(mx, shfl_idx(mx, lane ^ 32));
      const float mxc = mx * CS;
      const bool need = mxc - mrun[qt] > 8.f;
      if (__builtin_amdgcn_ballot_w64(need) != 0ull) {
        const float mnew = fmaxf(mrun[qt], mxc);
        const float alpha = __builtin_amdgcn_exp2f(mrun[qt] - mnew);
        mrun[qt] = mnew;
        lsum[qt] *= alpha;
#pragma unroll
        for (int et = 0; et < 8; ++et) { O[et][qt][0] *= alpha; O[et][qt][1] *= alpha; O[et][qt][2] *= alpha; O[et][qt][3] *= alpha; }
      }
      const float mc = mrun[qt];
      float ps = 0.f;
      float pv[4][4];
#pragma unroll
      for (int t = 0; t < 4; ++t)
#pragma unroll
        for (int reg = 0; reg < 4; ++reg) { pv[t][reg] = __builtin_amdgcn_exp2f(S[t][qt][reg] * CS - mc); ps += pv[t][reg]; }
      lsum[qt] += ps;
#pragma unroll
      for (int k2 = 0; k2 < 2; ++k2) {
        u32x4 pk = {pack2(pv[2 * k2][0], pv[2 * k2][1]), pack2(pv[2 * k2][2], pv[2 * k2][3]),
                    pack2(pv[2 * k2 + 1][0], pv[2 * k2 + 1][1]), pack2(pv[2 * k2 + 1][2], pv[2 * k2 + 1][3])};
        Pf[qt][k2] = __builtin_bit_cast(bf16x8, pk);
      }
    }
#pragma unroll
    for (int k2 = 0; k2 < 2; ++k2)
#pragma unroll
      for (int et = 0; et < 8; ++et) {
        const u32x2 a0 = *(const u32x2*)(cV + (et * 16 + l15) * 72 + (2 * k2) * 16 + quad * 4);
        const u32x2 a1 = *(const u32x2*)(cV + (et * 16 + l15) * 72 + (2 * k2 + 1) * 16 + quad * 4);
        const u32x4 a4 = {a0.x, a0.y, a1.x, a1.y};
        const bf16x8 a = __builtin_bit_cast(bf16x8, a4);
        O[et][0] = MFMA16(a, Pf[0][k2], O[et][0]);
        O[et][1] = MFMA16(a, Pf[1][k2], O[et][1]);
      }
    if (kt + 1 < ntiles) {
      bf16_t* nK = Ks + (cur ^ 1) * 8704;
      bf16_t* nV = Vs + (cur ^ 1) * 9216;
#pragma unroll
      for (int r = 0; r < 2; ++r) {
        const int q = tid + 512 * r;
        *(u32x4*)(nK + (q >> 4) * 136 + (q & 15) * 8) = rk[r];
        *(u32x4*)(nV + (q >> 3) * 72 + (q & 7) * 8) = rv[r];
      }
    }
    __syncthreads();
  }
  const float lam = p.LAM[layer * 2], oml = p.LAM[layer * 2 + 1];
#pragma unroll
  for (int qt = 0; qt < 2; ++qt) {
    float l = lsum[qt];
    l += shfl_idx(l, lane ^ 16);
    l += shfl_idx(l, lane ^ 32);
    const float inv = (comp == 1 ? lam : 1.f) / l;
#pragma unroll
    for (int et = 0; et < 8; ++et) { O[et][qt][0] *= inv; O[et][qt][1] *= inv; O[et][qt][2] *= inv; O[et][qt][3] *= inv; }
  }
  if (comp == 1) {
#pragma unroll
    for (int qt = 0; qt < 2; ++qt)
#pragma unroll
      for (int et = 0; et < 8; ++et) *(f32x4*)(XB + (qh * 32 + qt * 16 + l15) * 132 + et * 16 + quad * 4) = O[et][qt];
  }
  __syncthreads();
  if (comp == 0) {
    const float* sw = p.subln_w + layer * 128;
#pragma unroll
    for (int qt = 0; qt < 2; ++qt) {
      float ss = 0.f;
#pragma unroll
      for (int et = 0; et < 8; ++et) {
        const f32x4 o1 = *(const f32x4*)(XB + (qh * 32 + qt * 16 + l15) * 132 + et * 16 + quad * 4);
        O[et][qt][0] -= o1[0]; O[et][qt][1] -= o1[1]; O[et][qt][2] -= o1[2]; O[et][qt][3] -= o1[3];
        ss += O[et][qt][0] * O[et][qt][0] + O[et][qt][1] * O[et][qt][1] + O[et][qt][2] * O[et][qt][2] + O[et][qt][3] * O[et][qt][3];
      }
      ss += shfl_idx(ss, lane ^ 16);
      ss += shfl_idx(ss, lane ^ 32);
      const float rstd = rsqrtf(ss * (1.f / 128.f) + EPSN) * oml;
      const int row = qrow0 + qh * 32 + qt * 16 + l15;
#pragma unroll
      for (int et = 0; et < 8; ++et) {
        const f32x4 wv = *(const f32x4*)(sw + et * 16 + quad * 4);
        u32x2 pk = {pack2(O[et][qt][0] * rstd * wv[0], O[et][qt][1] * rstd * wv[1]),
                    pack2(O[et][qt][2] * rstd * wv[2], O[et][qt][3] * rstd * wv[3])};
        *(u32x2*)(p.YA + (size_t)row * D + h * 128 + et * 16 + quad * 4) = pk;
      }
    }
  }
  __syncthreads();
}

DI int inproj_main_tiles(int MT, int NT);
DI void inproj_tile(const Params& p, int layer, int g, int item, unsigned char* lds, int tid_);
DI void mix_phase(const Params& p, int layer, int g, unsigned char* lds, int tid_) {
  const int n_al = p.nbg * 8 * 16;
  const int n_ac = layer == 0 ? p.nbg * 8 * 2 : 0;
  const int n_st = p.nbg * 18 * 16;
  for (int item = blockIdx.x; item < n_al; item += gridDim.x) {
    int tid = tid_;
    asm volatile("" : "+v"(tid));
    attn_item8(p, layer, item >> 7, (item >> 4) & 7, item & 15, false, lds, tid);
  }
  {
    const int cshift = (int)gridDim.x >= 128 ? 64 : 0;
    for (int it = ((int)blockIdx.x - cshift + (int)gridDim.x) % (int)gridDim.x; it < n_ac; it += gridDim.x) {
      int tid = tid_;
      asm volatile("" : "+v"(tid));
      attn_item8(p, layer, it >> 4, (it >> 1) & 7, it & 1, true, lds, tid);
    }
  }
  {
    const int MT = (p.nbg * (SEQ + CTXL)) >> 8, NT = NINP >> 8;
    const int n_main = inproj_main_tiles(MT, NT), ntail = MT * NT - n_main;
    const int back = (int)gridDim.x - 1 - (int)blockIdx.x;
    if (back < ntail) {
      inproj_tile(p, layer, g, n_main + back, lds, tid_);
      __syncthreads();
    }
  }
  unsigned char* vlds = lds + VHALF * LDS_HALF;
  for (int item = VB; item < n_st; item += VG) {
    int tid = tid_ & 255;
    asm volatile("" : "+v"(tid));
    const int hh = item & 15, rest = item >> 4, cid = rest % 18, lb = rest / 18;
    ssd_state_item(p, layer, lb, cid, hh, vlds, tid);
  }
}

DI void recur_phase(const Params& p, int tid) {
  const int total = p.nbg * 2 * 16 * 1024;
  for (int idx = VB * 256 + tid; idx < total; idx += VG * 256) {
    const int lbdh = idx >> 10, e8 = idx & 1023;
    const int dir = (lbdh >> 4) & 1;
    bf16_t* base = (bf16_t*)p.ST + (size_t)lbdh * 18 * 8192 + e8 * 8;
    const float* dec = p.DEC + lbdh * 18;
    u32x4 sv[18];
    float dc[18];
#pragma unroll
    for (int k = 0; k < 18; ++k) {
      const int cid = dir == 0 ? k : (k < 2 ? 1 - k : 19 - k);
      sv[k] = *(const u32x4*)(base + (size_t)cid * 8192);
      dc[k] = dec[cid];
    }
    float zf = 0.f;
    asm volatile("" : "+v"(zf));
    float hst[8] = {zf, zf, zf, zf, zf, zf, zf, zf};
#pragma unroll
    for (int k = 0; k < 18; ++k) {
      const int cid = dir == 0 ? k : (k < 2 ? 1 - k : 19 - k);
      u32x4 pk = {pack2(hst[0], hst[1]), pack2(hst[2], hst[3]), pack2(hst[4], hst[5]), pack2(hst[6], hst[7])};
      *(u32x4*)(base + (size_t)cid * 8192) = pk;
      float sf[8];
      unpack8(sv[k], sf);
#pragma unroll
      for (int e = 0; e < 8; ++e) hst[e] = hst[e] * dc[k] + sf[e];
    }
  }
}

DI void ssd_out_item(const Params& p, int layer, int lb, int cid, int h, unsigned char* lds, int tid) {
  bf16_t* Bs = (bf16_t*)lds;
  bf16_t* XT = (bf16_t*)(lds + 34816);
  float* fl = (float*)(lds + 52224);
  const int lane = tid & 63, w = tid >> 6, l15_ = lane & 15, quad_ = lane >> 4;
  const int row0 = chunk_row0(p, lb, cid);
  const int seqlen = cid < 2 ? CTXL : SEQ;
  const int t0 = cid < 2 ? cid * 128 : (cid - 2) * 128;
  const int grp = h >> 2;
  const float* cw = p.ssd_conv_w + layer * 3 * 2048;
  const float* cb = p.ssd_conv_b + layer * 2048;
  if (tid < 128) *(f32x4*)(fl + tid * 4) = *(const f32x4*)(p.CSB + (size_t)((lb * 18 + cid) * 16 + h) * 512 + tid * 4);
  const float* dtf = fl; const float* dtb = fl + 128; const float* csf = fl + 256; const float* rsb = fl + 384;
#pragma unroll 4
  for (int r = 0; r < 8; ++r) {
    const int unit = tid + 256 * r, cgp = unit & 15, l = unit >> 4;
    const int ci = 1024 + grp * 128 + cgp * 8;
    float o[8];
    conv_silu8(p.U + (size_t)(row0 + l) * USTR + 1024 + ci, (t0 + l) > 0, (t0 + l) < seqlen - 1, cw, cb, ci, o);
    u32x4 pk = {pack2(o[0], o[1]), pack2(o[2], o[3]), pack2(o[4], o[5]), pack2(o[6], o[7])};
    *(u32x4*)(Bs + l * 136 + cgp * 8) = pk;
  }
#pragma unroll 4
  for (int r = 0; r < 4; ++r) {
    const int unit = tid + 256 * r, cgp = unit & 7, l = unit >> 3;
    const int ci = h * 64 + cgp * 8;
    float o[8];
    conv_silu8(p.U + (size_t)(row0 + l) * USTR + 1024 + ci, (t0 + l) > 0, (t0 + l) < seqlen - 1, cw, cb, ci, o);
#pragma unroll
    for (int e = 0; e < 8; ++e) XT[(cgp * 8 + e) * 136 + l] = f2bf(o[e]);
  }
  HSYNC();
  bf16_t* Pw = (bf16_t*)(lds + 54272) + w * (16 * 136);
  const float dsk = p.ssd_d[layer * 16 + h];
#pragma unroll 1
  for (int lt = 0; lt < 2; ++lt) {
    int l15 = l15_, quad = quad_;
    asm volatile("" : "+v"(l15), "+v"(quad));
    const int l = w * 32 + lt * 16 + l15;
    bf16x8 Cf[4];
#pragma unroll
    for (int ks = 0; ks < 4; ++ks) {
      const int ci = 1536 + grp * 128 + ks * 32 + quad * 8;
      float o[8];
      conv_silu8(p.U + (size_t)(row0 + l) * USTR + 1024 + ci, (t0 + l) > 0, (t0 + l) < seqlen - 1, cw, cb, ci, o);
      u32x4 pk = {pack2(o[0], o[1]), pack2(o[2], o[3]), pack2(o[4], o[5]), pack2(o[6], o[7])};
      Cf[ks] = __builtin_bit_cast(bf16x8, pk);
    }
    f32x4 cbT[8];
#pragma unroll
    for (int st = 0; st < 8; ++st) cbT[st] = (f32x4){0.f, 0.f, 0.f, 0.f};
#pragma unroll
    for (int ks = 0; ks < 4; ++ks)
#pragma unroll
      for (int st = 0; st < 8; ++st) {
        const bf16x8 a = *(const bf16x8*)(Bs + (st * 16 + l15) * 136 + ks * 32 + quad * 8);
        cbT[st] = MFMA16(a, Cf[ks], cbT[st]);
      }
    f32x4 Y[4];
#pragma unroll
    for (int pt = 0; pt < 4; ++pt) Y[pt] = (f32x4){0.f, 0.f, 0.f, 0.f};
#pragma unroll
    for (int dir = 0; dir < 2; ++dir) {
      const float cl = dir == 0 ? csf[l] : rsb[l];
#pragma unroll
      for (int st = 0; st < 8; ++st) {
        float pv[4];
#pragma unroll
        for (int reg = 0; reg < 4; ++reg) {
          const int s = st * 16 + quad * 4 + reg;
          const bool ok = dir == 0 ? (s <= l) : (s >= l);
          const float cs_s = dir == 0 ? csf[s] : rsb[s];
          const float dts = dir == 0 ? dtf[s] : dtb[s];
          pv[reg] = ok ? cbT[st][reg] * __expf(fminf(cl - cs_s, 0.f)) * dts : 0.f;
        }
        u32x2 pk = {pack2(pv[0], pv[1]), pack2(pv[2], pv[3])};
        *(u32x2*)(Pw + l15 * 136 + st * 16 + quad * 4) = pk;
      }
      asm volatile("s_waitcnt lgkmcnt(0)" ::: "memory");
#pragma unroll
      for (int ks = 0; ks < 4; ++ks) {
        const bf16x8 b0 = *(const bf16x8*)(Pw + l15 * 136 + ks * 32 + quad * 8);
#pragma unroll
        for (int pt = 0; pt < 4; ++pt) {
          const bf16x8 a = *(const bf16x8*)(XT + (pt * 16 + l15) * 136 + ks * 32 + quad * 8);
          Y[pt] = MFMA16(a, b0, Y[pt]);
        }
      }
      asm volatile("s_waitcnt lgkmcnt(0)" ::: "memory");
    }
#pragma unroll
    for (int dir = 0; dir < 2; ++dir) {
      const bf16_t* hp = (const bf16_t*)p.ST + ((size_t)(((lb * 2 + dir) * 16 + h) * 18 + cid)) * 8192;
      f32x4 T[4];
#pragma unroll
      for (int pt = 0; pt < 4; ++pt) T[pt] = (f32x4){0.f, 0.f, 0.f, 0.f};
#pragma unroll
      for (int ks = 0; ks < 4; ++ks)
#pragma unroll
        for (int pt = 0; pt < 4; ++pt) {
          const bf16x8 a = *(const bf16x8*)(hp + (pt * 16 + l15) * 128 + ks * 32 + quad * 8);
          T[pt] = MFMA16(a, Cf[ks], T[pt]);
        }
      const float e = __expf(dir == 0 ? csf[l] : rsb[l]);
#pragma unroll
      for (int pt = 0; pt < 4; ++pt) { Y[pt][0] += e * T[pt][0]; Y[pt][1] += e * T[pt][1]; Y[pt][2] += e * T[pt][2]; Y[pt][3] += e * T[pt][3]; }
    }
    const int row = row0 + l;
    float ss = 0.f;
#pragma unroll
    for (int pt = 0; pt < 4; ++pt) {
      const int pp = pt * 16 + quad * 4;
      const u32x2 zz = *(const u32x2*)(p.U + (size_t)row * USTR + h * 64 + pp);
      const float z0 = lo_f(zz.x), z1 = hi_f(zz.x), z2 = lo_f(zz.y), z3 = hi_f(zz.y);
      float y0 = Y[pt][0] + dsk * bf2f(XT[(pp + 0) * 136 + l]);
      float y1 = Y[pt][1] + dsk * bf2f(XT[(pp + 1) * 136 + l]);
      float y2 = Y[pt][2] + dsk * bf2f(XT[(pp + 2) * 136 + l]);
      float y3 = Y[pt][3] + dsk * bf2f(XT[(pp + 3) * 136 + l]);
      y0 *= silu_f(z0); y1 *= silu_f(z1); y2 *= silu_f(z2); y3 *= silu_f(z3);
      ss += y0 * y0 + y1 * y1 + y2 * y2 + y3 * y3;
      u32x2 pk = {pack2(y0, y1), pack2(y2, y3)};
      *(u32x2*)(p.YS + (size_t)row * D + h * 64 + pp) = pk;
    }
    ss += shfl_idx(ss, lane ^ 16);
    ss += shfl_idx(ss, lane ^ 32);
    if (quad == 0) p.SSQ[(size_t)row * 16 + h] = ss;
  }
  HSYNC();
}

DI void ssdout_phase(const Params& p, int layer, int g, unsigned char* lds, int tid_) {
  const int cid0 = layer == 0 ? 0 : 2;
  const int ncid = 18 - cid0;
  const int n = p.nbg * ncid * 16;
  for (int item = VB; item < n; item += VG) {
    int tid = tid_;
    asm volatile("" : "+v"(tid));
    const int hh = item & 15, rest = item >> 4, cid = cid0 + rest % ncid, lb = rest / ncid;
    ssd_out_item(p, layer, lb, cid, hh, lds, tid);
  }
}

DI void merge_phase(const Params& p, int layer, int g, int mrows, unsigned char* lds, int tid_) {
  const int MT = mrows >> 7, NT = D >> 6;
  const bf16_t* Bs_ = p.wt_brs + (size_t)layer * D * D;
  const bf16_t* Ba_ = p.wt_bra + (size_t)layer * D * D;
  for (int round = 0; (int)blockIdx.x + round * VG < MT * NT; ++round) {
    const int item = VB + round * VG;
    if (item >= MT * NT) {
      for (int i = 0; i < 2 * (1 + (D >> 6)); ++i) __syncthreads();
      continue;
    }
    int tid = tid_;
    asm volatile("" : "+v"(tid));
    const int lane = tid & 63, w = tid >> 6, wm = w & 1, wn = w >> 1, l15 = lane & 15, quad = lane >> 4;
    const int mt = item % MT, nt = item / MT;
    f32x4 as[2][4], aa[2][4];
    zero_acc<2>(as); zero_acc<2>(aa);
    gemm_mainloop<2>(p.YS + (size_t)mt * 128 * D, D, Bs_ + (size_t)nt * 64 * D, D, D, as, lds, tid);
    gemm_mainloop<2>(p.YA + (size_t)mt * 128 * D, D, Ba_ + (size_t)nt * 64 * D, D, D, aa, lds, tid);
    const int mb = mt * 128 + wm * 64, nb = nt * 64 + wn * 32;
#pragma unroll
    for (int j = 0; j < 4; ++j) {
      const int r = mb + j * 16 + l15;
      float ssq = 0.f;
      const f32x4* sq = (const f32x4*)(p.SSQ + (size_t)r * 16);
#pragma unroll
      for (int q = 0; q < 4; ++q) { const f32x4 t = sq[q]; ssq += t[0] + t[1] + t[2] + t[3]; }
      const float rstd = rsqrtf(ssq * (1.f / D) + EPSN);
#pragma unroll
      for (int i = 0; i < 2; ++i) {
        const int n = nb + i * 16 + quad * 4;
        const u32x2 gs = *(const u32x2*)(p.U + (size_t)r * USTR + 4096 + n);
        const u32x2 ga = *(const u32x2*)(p.U + (size_t)r * USTR + 5120 + n);
        const float m0 = sigm_f(lo_f(gs.x)) * rstd * as[i][j][0] + sigm_f(lo_f(ga.x)) * aa[i][j][0];
        const float m1 = sigm_f(hi_f(gs.x)) * rstd * as[i][j][1] + sigm_f(hi_f(ga.x)) * aa[i][j][1];
        const float m2 = sigm_f(lo_f(gs.y)) * rstd * as[i][j][2] + sigm_f(lo_f(ga.y)) * aa[i][j][2];
        const float m3 = sigm_f(hi_f(gs.y)) * rstd * as[i][j][3] + sigm_f(hi_f(ga.y)) * aa[i][j][3];
        u32x2 pk = {pack2(m0, m1), pack2(m2, m3)};
        *(u32x2*)(p.MG + (size_t)r * D + n) = pk;
      }
    }
  }
}

DI void resid_gemm_phase(const Params& p, int layer, int g, int mrows, const bf16_t* A, int K, const bf16_t* Bt, int gate_off,
                         bool src_is_in, unsigned char* lds, int tid_) {
  const int MT = mrows >> 7, NT = D >> 7;
  for (int round = 0; (int)blockIdx.x + round * VG < MT * NT; ++round) {
    const int item = VB + round * VG;
    if (item >= MT * NT) {
      for (int i = 0; i < 1 + (K >> 6); ++i) __syncthreads();
      continue;
    }
    int tid = tid_;
    asm volatile("" : "+v"(tid));
    const int lane = tid & 63, w = tid >> 6, wm = w & 1, wn = w >> 1, l15 = lane & 15, quad = lane >> 4;
    const int mt = item % MT, nt = item / MT;
    f32x4 acc[4][4];
    zero_acc<4>(acc);
    gemm_mainloop<4>(A + (size_t)mt * 128 * K, K, Bt + (size_t)nt * 128 * K, K, K, acc, lds, tid);
    const int mb = mt * 128 + wm * 64, nb = nt * 128 + wn * 64;
    const float* gate = p.MOD + (size_t)(layer * 9 + mod_row(p, g, mt * 128)) * 6144 + gate_off;
    f32x4 gv[4];
#pragma unroll
    for (int i = 0; i < 4; ++i) gv[i] = *(const f32x4*)(gate + nb + i * 16 + quad * 4);
#pragma unroll
    for (int j = 0; j < 4; ++j) {
      const int r = mb + j * 16 + l15;
      const float* src = src_is_in ? xin_row(p, layer, g, r) : xout_row(p, g, r);
      float* dst = xout_row(p, g, r);
#pragma unroll
      for (int i = 0; i < 4; ++i) {
        const int n = nb + i * 16 + quad * 4;
        const f32x4 xv = *(const f32x4*)(src + n);
        f32x4 o;
        o[0] = xv[0] + gv[i][0] * acc[i][j][0]; o[1] = xv[1] + gv[i][1] * acc[i][j][1];
        o[2] = xv[2] + gv[i][2] * acc[i][j][2]; o[3] = xv[3] + gv[i][3] * acc[i][j][3];
        *(f32x4*)(dst + n) = o;
      }
    }
  }
}


DI int g8_lds_byte(int r, int c) {
  const int st = (r >> 4) * 2 + (c >> 5), rr = r & 15, cc = c & 31, ob = rr * 64 + cc * 2;
  return st * 1024 + (ob ^ (((ob >> 9) & 1) << 5));
}
DI void g8_stage_rc(int b, int& R, int& C) {
  const int st = b / 1024, sb = b % 1024, swz = sb ^ (((sb >> 9) & 1) << 5);
  R = (st >> 1) * 16 + swz / 64; C = (st & 1) * 32 + (swz % 64) / 2;
}
DI void gemm8p(const bf16_t* __restrict__ Wp, const bf16_t* __restrict__ Xp, f32x4 (&acc)[2][2][4][2], unsigned char* lds, int tid) {
  constexpr int GK = 1024, GBK = 64, GHALF = 128, GHT = GHALF * GBK;
  bf16_t* shm = (bf16_t*)lds;
#define SA(b, h) (shm + ((b) * 2 + (h)) * GHT)
#define SB(b, h) (shm + (4 + (b) * 2 + (h)) * GHT)
  const int wid = tid >> 6, lane = tid & 63, wr = wid >> 2, wc = wid & 3, fr = lane & 15, fq = lane >> 4;
  int goff0, goff1;
  { int r_, c_; g8_stage_rc(tid * 16, r_, c_); goff0 = r_ * GK + c_; g8_stage_rc(tid * 16 + 8192, r_, c_); goff1 = r_ * GK + c_; }
#define STAGE(P, BASE, br, kt) do { \
    __builtin_amdgcn_global_load_lds((const unsigned*)((BASE) + (br) * GK + (kt) * GBK + goff0), (unsigned*)((char*)(P) + tid * 16), 16, 0, 0); \
    __builtin_amdgcn_global_load_lds((const unsigned*)((BASE) + (br) * GK + (kt) * GBK + goff1), (unsigned*)((char*)(P) + tid * 16 + 8192), 16, 0, 0); } while (0)
#define LDA(dst, b, h) _Pragma("unroll") for (int m = 0; m < 4; ++m) _Pragma("unroll") for (int k = 0; k < 2; ++k) \
    dst[m][k] = *reinterpret_cast<const bf16x8*>((char*)SA(b, h) + g8_lds_byte(wr * 64 + m * 16 + fr, k * 32 + fq * 8))
#define LDB(dst, b, h) _Pragma("unroll") for (int n = 0; n < 2; ++n) _Pragma("unroll") for (int k = 0; k < 2; ++k) \
    dst[n][k] = *reinterpret_cast<const bf16x8*>((char*)SB(b, h) + g8_lds_byte(wc * 32 + n * 16 + fr, k * 32 + fq * 8))
#define MMA(ai, bj, At_, Bt_) do { __builtin_amdgcn_s_setprio(1); \
    _Pragma("unroll") for (int m = 0; m < 4; ++m) _Pragma("unroll") for (int n = 0; n < 2; ++n) _Pragma("unroll") for (int k = 0; k < 2; ++k) \
      acc[ai][bj][m][n] = __builtin_amdgcn_mfma_f32_16x16x32_bf16(At_[m][k], Bt_[n][k], acc[ai][bj][m][n], 0, 0, 0); \
    __builtin_amdgcn_s_setprio(0); } while (0)
#define WAIT_V(n) asm volatile("s_waitcnt vmcnt(" #n ")" ::: "memory")
#define WAIT_L(n) asm volatile("s_waitcnt lgkmcnt(" #n ")" ::: "memory")
#define BAR __builtin_amdgcn_s_barrier()
#define SCHED __builtin_amdgcn_sched_barrier(0)
  bf16x8 At[4][2], B0[2][2], B1[2][2];
  constexpr int nt = GK / GBK;
  STAGE(SB(0, 0), Xp, 0, 0); STAGE(SA(0, 0), Wp, 0, 0);
  STAGE(SB(0, 1), Xp, GHALF, 0); STAGE(SA(0, 1), Wp, GHALF, 0);
  if (wr == 1) BAR;
  WAIT_V(4); BAR;
  STAGE(SB(1, 0), Xp, 0, 1); STAGE(SA(1, 0), Wp, 0, 1); STAGE(SB(1, 1), Xp, GHALF, 1);
  WAIT_V(6); BAR;
  for (int t = 0; t < nt - 2; t += 2) {
    LDB(B0, 0, 0); SCHED; LDA(At, 0, 0); STAGE(SA(1, 1), Wp, GHALF, t + 1);
    WAIT_L(8); BAR; WAIT_L(0); MMA(0, 0, At, B0); BAR; SCHED;
    LDB(B1, 0, 1); STAGE(SB(0, 0), Xp, 0, t + 2);
    BAR; WAIT_L(0); MMA(0, 1, At, B1); BAR;
    LDA(At, 0, 1); STAGE(SA(0, 0), Wp, 0, t + 2);
    BAR; WAIT_L(0); MMA(1, 0, At, B0); BAR; SCHED;
    STAGE(SB(0, 1), Xp, GHALF, t + 2);
    WAIT_V(6); BAR; MMA(1, 1, At, B1); BAR;
    LDB(B0, 1, 0); SCHED; LDA(At, 1, 0); STAGE(SA(0, 1), Wp, GHALF, t + 2);
    WAIT_L(8); BAR; WAIT_L(0); MMA(0, 0, At, B0); BAR; SCHED;
    LDB(B1, 1, 1); STAGE(SB(1, 0), Xp, 0, t + 3);
    BAR; WAIT_L(0); MMA(0, 1, At, B1); BAR;
    LDA(At, 1, 1); STAGE(SA(1, 0), Wp, 0, t + 3);
    BAR; WAIT_L(0); MMA(1, 0, At, B0); BAR; SCHED;
    STAGE(SB(1, 1), Xp, GHALF, t + 3);
    WAIT_V(6); BAR; MMA(1, 1, At, B1); BAR;
  }
  { LDB(B0, 0, 0); LDA(At, 0, 0); STAGE(SA(1, 1), Wp, GHALF, nt - 1);
    BAR; WAIT_L(0); MMA(0, 0, At, B0); BAR;
    LDB(B1, 0, 1); BAR; WAIT_L(0); MMA(0, 1, At, B1); BAR;
    LDA(At, 0, 1); WAIT_V(4); BAR; WAIT_L(0); MMA(1, 0, At, B0); MMA(1, 1, At, B1); BAR; }
  { LDB(B0, 1, 0); LDA(At, 1, 0); WAIT_V(2); BAR; WAIT_L(0); MMA(0, 0, At, B0); BAR;
    LDB(B1, 1, 1); WAIT_V(0); BAR; WAIT_L(0); MMA(0, 1, At, B1); BAR;
    LDA(At, 1, 1); BAR; WAIT_L(0); MMA(1, 0, At, B0); MMA(1, 1, At, B1); BAR; }
  if (wr == 0) BAR;
#undef SA
#undef SB
#undef STAGE
#undef LDA
#undef LDB
#undef MMA
#undef WAIT_V
#undef WAIT_L
#undef BAR
#undef SCHED
}
DI void zero_acc8p(f32x4 (&acc)[2][2][4][2]) {
#pragma unroll
  for (int a = 0; a < 2; ++a)
#pragma unroll
    for (int b = 0; b < 2; ++b)
#pragma unroll
      for (int m = 0; m < 4; ++m) { acc[a][b][m][0] = (f32x4){0.f, 0.f, 0.f, 0.f}; acc[a][b][m][1] = (f32x4){0.f, 0.f, 0.f, 0.f}; }
}

DI int inproj_main_tiles(int MT, int NT) {
  const int total = MT * NT, whole = (total / (int)gridDim.x) * (int)gridDim.x;
  return (whole > 0 && whole / MT >= 25 && total - whole <= (int)gridDim.x) ? whole : total;
}
DI void inproj_tile(const Params& p, int layer, int g, int item, unsigned char* lds, int tid_) {
  const int nl = p.nbg * SEQ, mg = p.nbg * (SEQ + CTXL);
  const int MT = mg >> 8;
  const bf16_t* Wt = p.wt_in + (size_t)layer * NINP * D;
  {
    int tid = tid_;
    asm volatile("" : "+v"(tid));
    const int wid = tid >> 6, lane = tid & 63, wr = wid >> 2, wc = wid & 3, fr = lane & 15, fq = lane >> 4;
    const int mt = item % MT, kpos = item / MT;
    const int nt = kpos == 0 ? 32 : (kpos <= 28 ? kpos + 3 : kpos - 29);
    const int m0 = mt * 256, n0 = nt * 256;
    asm volatile("s_waitcnt vmcnt(0)" ::: "memory");
    __syncthreads();
    f32x4 acc[2][2][4][2];
    zero_acc8p(acc);
    gemm8p(Wt + (size_t)n0 * D, p.H + (size_t)m0 * D, acc, lds, tid);
    const bool lat = m0 < nl;
#pragma unroll
    for (int ai = 0; ai < 2; ++ai) {
      const int c0 = n0 + ai * 128 + wr * 64;
      if (c0 >= 3072 && c0 < 5120 && lat) {
#pragma unroll
        for (int bj = 0; bj < 2; ++bj)
#pragma unroll
          for (int ni = 0; ni < 2; ++ni) {
            const int r = m0 + bj * 128 + wc * 32 + ni * 16 + fr, t = r & (SEQ - 1), pr = t >> 6, pc = t & 63;
#pragma unroll
            for (int j = 0; j < 4; ++j) {
              const int f = fq * 4 + j;
              const float cr = p.ROPE[(pr * 16 + f) * 2], sr = p.ROPE[(pr * 16 + f) * 2 + 1];
              const float cc = p.ROPE[(pc * 16 + f) * 2], sc = p.ROPE[(pc * 16 + f) * 2 + 1];
              float x1 = acc[ai][bj][0][ni][j], x2 = acc[ai][bj][1][ni][j];
              acc[ai][bj][0][ni][j] = x1 * cr - x2 * sr; acc[ai][bj][1][ni][j] = x2 * cr + x1 * sr;
              x1 = acc[ai][bj][2][ni][j]; x2 = acc[ai][bj][3][ni][j];
              acc[ai][bj][2][ni][j] = x1 * cc - x2 * sc; acc[ai][bj][3][ni][j] = x2 * cc + x1 * sc;
            }
            asm volatile("" ::: "memory");
          }
      }
    }
    if (n0 < 5120 || (n0 >= 6144 && n0 < 8192)) {
      bf16_t* stg = (bf16_t*)lds + wid * (64 * 136);
#pragma unroll
      for (int ai = 0; ai < 2; ++ai)
#pragma unroll
        for (int bj = 0; bj < 2; ++bj)
#pragma unroll
          for (int ni = 0; ni < 2; ++ni)
#pragma unroll
            for (int mi = 0; mi < 4; ++mi) {
              const f32x4 v = acc[ai][bj][mi][ni];
              u32x2 pk = {pack2(v[0], v[1]), pack2(v[2], v[3])};
              *(u32x2*)(stg + (bj * 32 + ni * 16 + fr) * 136 + ai * 64 + mi * 16 + fq * 4) = pk;
            }
      __syncthreads();
#pragma unroll
      for (int ai = 0; ai < 2; ++ai) {
        const int c0 = n0 + ai * 128 + wr * 64;
#pragma unroll
        for (int k = 0; k < 8; ++k) {
          const int c = lane + 64 * k, rl = c >> 3, cc = c & 7;
          const u32x4 v = *(const u32x4*)(stg + rl * 136 + ai * 64 + cc * 8);
          const int r = m0 + (rl >> 5) * 128 + wc * 32 + (rl & 31);
          bf16_t* dst;
          if (n0 >= 4096 && n0 < 5120) {
            int lb, kj;
            if (lat) { lb = r >> 11; kj = CTXL + (r & (SEQ - 1)); } else { const int rc = r - nl; lb = rc >> 8; kj = rc & 255; }
            const int hh = (c0 - 4096) >> 7, cd0 = (c0 - 4096) & 127;
            dst = p.KK + ((size_t)(lb * 8 + hh) * 2304 + kj) * 128 + cd0;
          } else {
            dst = p.U + (size_t)r * USTR + (n0 < 4096 ? c0 : c0 - 2048);
          }
          *(u32x4*)(dst + cc * 8) = v;
        }
      }
    } else if (n0 < 6144) {
      bf16_t* stg = (bf16_t*)lds + wid * (128 * 72);
#pragma unroll
      for (int ai = 0; ai < 2; ++ai)
#pragma unroll
        for (int bj = 0; bj < 2; ++bj)
#pragma unroll
          for (int ni = 0; ni < 2; ++ni)
#pragma unroll
            for (int mi = 0; mi < 4; ++mi)
#pragma unroll
              for (int j = 0; j < 4; ++j)
                stg[(ai * 64 + mi * 16 + fq * 4 + j) * 72 + bj * 32 + ni * 16 + fr] = f2bf(acc[ai][bj][mi][ni][j]);
      __syncthreads();
#pragma unroll
      for (int k = 0; k < 16; ++k) {
        const int c = lane + 64 * k, el = c >> 3, cc = c & 7;
        const u32x4 v = *(const u32x4*)(stg + el * 72 + cc * 8);
        const int r = m0 + (cc >> 2) * 128 + wc * 32 + (cc & 3) * 8;
        int lb, kj;
        if (lat) { lb = r >> 11; kj = CTXL + (r & (SEQ - 1)); } else { const int rc = r - nl; lb = rc >> 8; kj = rc & 255; }
        const int n = n0 + (el >> 6) * 128 + wr * 64 + (el & 63);
        const int hh = (n - 5120) >> 7, e = (n - 5120) & 127;
        *(u32x4*)(p.VT + ((size_t)(lb * 8 + hh) * 128 + e) * 2304 + kj) = v;
      }
    } else if (n0 == 8192 && wr == 0) {
#pragma unroll
      for (int bj = 0; bj < 2; ++bj)
#pragma unroll
        for (int ni = 0; ni < 2; ++ni) {
          const int r = m0 + bj * 128 + wc * 32 + ni * 16 + fr;
#pragma unroll
          for (int mi = 0; mi < 2; ++mi) *(f32x4*)(p.DT + (size_t)r * 32 + mi * 16 + fq * 4) = acc[0][bj][mi][ni];
        }
    }
  }
}
DI void inproj_phase(const Params& p, int layer, int g, unsigned char* lds, int tid_) {
  const int MT = (p.nbg * (SEQ + CTXL)) >> 8, NT = NINP >> 8;
  const int n_main = inproj_main_tiles(MT, NT);
  for (int item = blockIdx.x; item < n_main; item += gridDim.x) inproj_tile(p, layer, g, item, lds, tid_);
}

DI void up_phase(const Params& p, int layer, int mrows, unsigned char* lds, int tid_) {
  const int MT = mrows >> 8, NT = DFF2 >> 8;
  const bf16_t* Wt = p.wt_up + (size_t)layer * DFF2 * D;
  bf16_t* UF = p.U;
  for (int item = blockIdx.x; item < MT * NT; item += gridDim.x) {
    int tid = tid_;
    asm volatile("" : "+v"(tid));
    const int wid = tid >> 6, lane = tid & 63, wr = wid >> 2, wc = wid & 3, fr = lane & 15, fq = lane >> 4;
    const int mt = item % MT, nt = item / MT;
    const int m0 = mt * 256, n0 = nt * 256;
    asm volatile("s_waitcnt vmcnt(0)" ::: "memory");
    __syncthreads();
    f32x4 acc[2][2][4][2];
    zero_acc8p(acc);
    gemm8p(Wt + (size_t)n0 * D, p.H + (size_t)m0 * D, acc, lds, tid);
    bf16_t* stg = (bf16_t*)lds + wid * (64 * 136);
#pragma unroll
    for (int ai = 0; ai < 2; ++ai)
#pragma unroll
      for (int bj = 0; bj < 2; ++bj)
#pragma unroll
        for (int ni = 0; ni < 2; ++ni)
#pragma unroll
          for (int mi = 0; mi < 4; ++mi) {
            const f32x4 v = acc[ai][bj][mi][ni];
            u32x2 pk = {pack2(v[0], v[1]), pack2(v[2], v[3])};
            *(u32x2*)(stg + (bj * 32 + ni * 16 + fr) * 136 + ai * 64 + mi * 16 + fq * 4) = pk;
          }
    __syncthreads();
#pragma unroll
    for (int ai = 0; ai < 2; ++ai) {
      const int c0 = n0 + ai * 128 + wr * 64;
#pragma unroll
      for (int k = 0; k < 8; ++k) {
        const int c = lane + 64 * k, rl = c >> 3, cc = c & 7;
        const u32x4 v = *(const u32x4*)(stg + rl * 136 + ai * 64 + cc * 8);
        const int r = m0 + (rl >> 5) * 128 + wc * 32 + (rl & 31);
        *(u32x4*)(UF + (size_t)r * DFF2 + c0 + cc * 8) = v;
      }
    }
  }
}

DI void act_phase(const Params& p, int layer, int mrows, int tid) {
  const bf16_t* __restrict__ UF = p.U;
  bf16_t* __restrict__ HID = (bf16_t*)p.ST;
  const int nl = p.nbg * SEQ;
  const float* __restrict__ cw = p.ffn_conv_w + (size_t)layer * 3 * DFF2;
  const float* __restrict__ cb = p.ffn_conv_b + (size_t)layer * DFF2;
  const u32x4 z4 = {0u, 0u, 0u, 0u};
  constexpr int NCH = DFF / 8;
  const int gid = VB * 256 + tid;
  const int slots = (VG * 256) / NCH;
  const int jc = gid % NCH, rslot = gid / NCH;
  if (rslot >= slots) return;
  const int j0 = jc * 8;
  float w0[2][8], w1[2][8], w2[2][8], bb[2][8];
#pragma unroll
  for (int half = 0; half < 2; ++half) {
    const int ci = half * DFF + j0;
#pragma unroll
    for (int e = 0; e < 8; ++e) { w0[half][e] = cw[ci + e]; w1[half][e] = cw[DFF2 + ci + e]; w2[half][e] = cw[2 * DFF2 + ci + e]; bb[half][e] = cb[ci + e]; }
  }
#pragma unroll 2
  for (int r = rslot; r < mrows; r += slots) {
    int t, sl;
    if (r < nl) { t = r & (SEQ - 1); sl = SEQ; } else { t = (r - nl) & (CTXL - 1); sl = CTXL; }
    const bool hp = t > 0, hn = t < sl - 1;
    const bf16_t* up = UF + (size_t)r * DFF2 + j0;
    float av[8], vv[8], res[8];
#pragma unroll
    for (int half = 0; half < 2; ++half) {
      const bf16_t* q = up + half * DFF;
      float c[8], pv[8], nx[8];
      unpack8(*(const u32x4*)q, c);
      unpack8(hp ? *(const u32x4*)(q - DFF2) : z4, pv);
      unpack8(hn ? *(const u32x4*)(q + DFF2) : z4, nx);
#pragma unroll
      for (int e = 0; e < 8; ++e) {
        const float xx = w0[half][e] * pv[e] + w1[half][e] * c[e] + w2[half][e] * nx[e] + bb[half][e];
        if (half == 0) av[e] = xx; else vv[e] = xx;
      }
    }
#pragma unroll
    for (int e = 0; e < 8; ++e) res[e] = silu_f(av[e]) * vv[e];
    u32x4 pk = {pack2(res[0], res[1]), pack2(res[2], res[3]), pack2(res[4], res[5]), pack2(res[6], res[7])};
    *(u32x4*)(HID + (size_t)r * DFF + j0) = pk;
  }
}

DI void final_phase(const Params& p, int tid) {
  const int lane = tid & 63, w = __builtin_amdgcn_readfirstlane(tid >> 6);
  f32x4 wv[4];
#pragma unroll
  for (int i = 0; i < 4; ++i) wv[i] = *(const f32x4*)(p.final_norm_w + lane * 4 + 256 * i);
  int r = VB * 4 + w;
  f32x4 v[4];
  if (r < 8 * SEQ) {
#pragma unroll
    for (int i = 0; i < 4; ++i) v[i] = *(const f32x4*)(p.out + (size_t)r * D + lane * 4 + 256 * i);
  }
  while (r < 8 * SEQ) {
    const int rn = r + VG * 4;
    f32x4 vn[4];
    if (rn < 8 * SEQ) {
#pragma unroll
      for (int i = 0; i < 4; ++i) vn[i] = *(const f32x4*)(p.out + (size_t)rn * D + lane * 4 + 256 * i);
    }
    float ss = 0.f;
#pragma unroll
    for (int i = 0; i < 4; ++i) ss += v[i][0] * v[i][0] + v[i][1] * v[i][1] + v[i][2] * v[i][2] + v[i][3] * v[i][3];
#pragma unroll
    for (int o = 32; o > 0; o >>= 1) ss += shfl_idx(ss, lane ^ o);
    const float rstd = rsqrtf(ss * (1.f / D) + EPSN);
    float* dst = p.out + (size_t)r * D;
#pragma unroll
    for (int i = 0; i < 4; ++i) {
      f32x4 o;
      o[0] = v[i][0] * rstd * wv[i][0]; o[1] = v[i][1] * rstd * wv[i][1]; o[2] = v[i][2] * rstd * wv[i][2]; o[3] = v[i][3] * rstd * wv[i][3];
      *(f32x4*)(dst + lane * 4 + 256 * i) = o;
    }
#pragma unroll
    for (int i = 0; i < 4; ++i) v[i] = vn[i];
    r = rn;
  }
}


#define XB_TMO      128
#define XB_XCNT(j)  (256  + 64 * (j))
#define XB_XSUB(j)  (1280 + 64 * (j))
#define XB_XGEN(j)  (2304 + 64 * (j))
#define XB_TOP      3328
#define XB_TOPGEN   3392
#define XCD_BAR_WORDS 3456
#define XB_SPIN_CAP (1u << 22)
#define LAS __attribute__((address_space(3)))
DI unsigned xb_ld(unsigned* p) { return __hip_atomic_load(p, __ATOMIC_RELAXED, __HIP_MEMORY_SCOPE_AGENT); }
DI unsigned xb_add(unsigned* p, unsigned v) { return __hip_atomic_fetch_add(p, v, __ATOMIC_RELAXED, __HIP_MEMORY_SCOPE_AGENT); }
DI unsigned xb_xcc_id() { return (unsigned)__builtin_amdgcn_s_getreg((3 << 11) | 20) & 0xFu; }
#define XB_SPIN(cond, bar) do { unsigned _sp = 0; while (cond) { __builtin_amdgcn_s_sleep(1); \
    if ((++_sp & 255u) == 0u) { if (xb_ld(&(bar)[XB_TMO])) break; if (_sp > XB_SPIN_CAP) { atomicAdd(&(bar)[XB_TMO], 1u); break; } } } } while (0)
struct XcdBarrier { unsigned* bar; unsigned x; volatile LAS unsigned* st; };
DI XcdBarrier xcd_barrier_post(unsigned* bar, volatile LAS unsigned* st) {
  XcdBarrier b; b.bar = bar; b.x = xb_xcc_id(); b.st = st;
  if (threadIdx.x == 0) (void)xb_add(&bar[XB_XCNT(b.x)], 1u);
  return b;
}
DI void xcd_barrier_complete(unsigned* bar, unsigned x, unsigned& nloc, unsigned& nx) {
  const unsigned G = gridDim.x * gridDim.y * gridDim.z;
  unsigned sum, cnt, sp = 0u;
  for (;;) {
    sum = 0u; cnt = 0u;
#pragma unroll 1
    for (unsigned j = 0; j < 16; ++j) { const unsigned c = xb_ld(&bar[XB_XCNT(j)]); sum += c; cnt += (c > 0u) ? 1u : 0u; }
    if (sum == G) break;
    __builtin_amdgcn_s_sleep(1);
    if ((++sp & 255u) == 0u) { if (xb_ld(&bar[XB_TMO])) break; if (sp > XB_SPIN_CAP) { atomicAdd(&bar[XB_TMO], 1u); break; } }
  }
  const unsigned mine = xb_ld(&bar[XB_XCNT(x)]);
  nloc = mine > 0u ? mine : 1u; nx = cnt > 0u ? cnt : 1u;
}
template <bool FIRST>
DI void xcd_barrier_t(const XcdBarrier& b) {
  asm volatile("s_waitcnt vmcnt(0)" ::: "memory");
  __syncthreads();
  if (threadIdx.x == 0) {
    unsigned* bar = b.bar;
    __builtin_amdgcn_s_waitcnt(0);
    unsigned nloc = b.st[0], nx = b.st[1];
    if (FIRST) { xcd_barrier_complete(bar, b.x, nloc, nx); b.st[0] = nloc; b.st[1] = nx; }
    const unsigned old = xb_add(&bar[XB_XSUB(b.x)], 1u);
    const unsigned gen = old / nloc;
    if (old + 1u == (gen + 1u) * nloc) {
      __builtin_amdgcn_fence(__ATOMIC_RELEASE, "agent");
      asm volatile("s_waitcnt vmcnt(0)" ::: "memory");
      const unsigned og = xb_add(&bar[XB_TOP], 1u);
      const unsigned tg = og / nx;
      if (og + 1u == (tg + 1u) * nx) xb_add(&bar[XB_TOPGEN], 1u);
      else XB_SPIN(xb_ld(&bar[XB_TOPGEN]) == tg, bar);
      __builtin_amdgcn_fence(__ATOMIC_ACQUIRE, "agent");
      xb_add(&bar[XB_XGEN(b.x)], 1u);
      asm volatile("s_waitcnt vmcnt(0)" ::: "memory");
    } else {
      XB_SPIN(xb_ld(&bar[XB_XGEN(b.x)]) == gen, bar);
      __builtin_amdgcn_fence(__ATOMIC_ACQUIRE, "agent");
      asm volatile("s_waitcnt vmcnt(0)" ::: "memory");
    }
  }
  __syncthreads();
}
DI void xcd_barrier(const XcdBarrier& b) { xcd_barrier_t<false>(b); }

__global__ void __launch_bounds__(512) mega_fwd(Params p) {
  extern __shared__ __attribute__((aligned(16))) unsigned char lds[];
  cg::grid_group grid = cg::this_grid();
  const int tid0 = threadIdx.x;
#define OPQ() ({ int t_ = tid0; asm volatile("" : "+v"(t_)); t_; })
#define OPQV() (OPQ() & 255)
  unsigned char* vlds = lds + VHALF * LDS_HALF;
  volatile LAS unsigned* xst = (volatile LAS unsigned*)(lds + 2 * LDS_HALF);
  if (tid0 == 0) { xst[0] = 0u; xst[1] = 0u; xst[2] = 0u; xst[3] = 0u; xst[4] = 0u; xst[5] = 0u; xst[6] = 0u; xst[7] = 0u; }
  __syncthreads();
  const XcdBarrier xb = xcd_barrier_post(p.BAR, xst);
  phase0(p, vlds, OPQV());
  if (p.pad == 0x7fffffff) grid.sync();
  xcd_barrier_t<true>(xb);
  phase0b(p, OPQV());
  xcd_barrier(xb);
  const int ngroups = 8 / p.nbg;
  const int nl = p.nbg * SEQ, mg = p.nbg * (SEQ + CTXL);
  for (int g = 0; g < ngroups; ++g) {
    for (int layer = 0; layer < 2; ++layer) {
      const int mrows = layer == 0 ? mg : nl;
      norm_phase(p, layer, g, 0, mg, OPQV());
      xcd_barrier(xb);
      inproj_phase(p, layer, g, lds, OPQ());
      xcd_barrier(xb);
      mix_phase(p, layer, g, lds, OPQ());
      xcd_barrier(xb);
      recur_phase(p, OPQV());
      xcd_barrier(xb);
      ssdout_phase(p, layer, g, vlds, OPQV());
      xcd_barrier(xb);
      merge_phase(p, layer, g, mrows, vlds, OPQV());
      xcd_barrier(xb);
      resid_gemm_phase(p, layer, g, mrows, p.MG, D, p.wt_o + (size_t)layer * D * D, 2048, true, vlds, OPQV());
      xcd_barrier(xb);
      norm_phase(p, layer, g, 1, mrows, OPQV());
      xcd_barrier(xb);
      up_phase(p, layer, mrows, lds, OPQ());
      xcd_barrier(xb);
      act_phase(p, layer, mrows, OPQV());
      xcd_barrier(xb);
      resid_gemm_phase(p, layer, g, mrows, (const bf16_t*)p.ST, DFF, p.wt_down + (size_t)layer * D * DFF, 5120, false, vlds, OPQV());
      xcd_barrier(xb);
    }
  }
  final_phase(p, OPQV());
}

static size_t ws_need(int nbg, size_t* offs) {
  size_t o = 0;
  auto take = [&](size_t bytes) { size_t r = o; o += (bytes + 255) & ~(size_t)255; return r; };
  offs[0] = take((size_t)2 * NINP * D * 2);
  offs[1] = take((size_t)2 * D * D * 2);
  offs[2] = take((size_t)2 * D * D * 2);
  offs[3] = take((size_t)2 * D * D * 2);
  offs[4] = take((size_t)2 * DFF2 * D * 2);
  offs[5] = take((size_t)2 * D * DFF * 2);
  const size_t mg = (size_t)nbg * 2304;
  offs[6] = take(mg * USTR * 2);
  offs[7] = take((size_t)nbg * 8 * 2304 * 128 * 2);
  offs[8] = take((size_t)nbg * 8 * 128 * 2304 * 2);
  offs[9] = take(mg * D * 2);
  offs[10] = take(mg * D * 2);
  offs[11] = take(mg * D * 2);
  offs[12] = take(mg * D * 2);
  offs[13] = take(mg * 32 * 4);
  offs[14] = take((size_t)nbg * 2 * 16 * 18 * 8192 * 4);
  offs[15] = take((size_t)nbg * 2 * 16 * 18 * 4);
  offs[16] = take(mg * 16 * 4);
  offs[17] = take((size_t)8 * CTXL * D * 4);
  offs[18] = take((size_t)8 * 2 * 9 * 6144 * 4);
  offs[19] = take((size_t)2 * 9 * 6144 * 4);
  offs[20] = take((size_t)1024 * 2 * 4);
  offs[21] = take(256);
  offs[22] = take(XCD_BAR_WORDS * 4);
  offs[23] = take((size_t)nbg * 18 * 16 * 512 * 4);
  return o;
}

extern "C" void kernel_launch(void* const* d_in, const int* in_sizes, int n_in, void* d_out, int out_size, void* d_ws,
                              size_t ws_size, hipStream_t stream) {
  static int grid_blocks = 0;
  if (grid_blocks == 0) {
    int dev = 0, cus = 0, per_cu = 0;
    hipGetDevice(&dev);
    hipDeviceGetAttribute(&cus, hipDeviceAttributeMultiprocessorCount, dev);
    hipFuncSetAttribute((const void*)mega_fwd, hipFuncAttributeMaxDynamicSharedMemorySize, LDS_BYTES);
    hipOccupancyMaxActiveBlocksPerMultiprocessor(&per_cu, (const void*)mega_fwd, 512, LDS_BYTES);
    if (per_cu < 1) { fprintf(stderr, "occupancy query returned %d\n", per_cu); per_cu = 1; }
    if (per_cu > 1) per_cu = 1;
    grid_blocks = cus * per_cu;
  }
  size_t offs[24];
  int nbg = 8;
  while (nbg > 1 && ws_need(nbg, offs) > ws_size) nbg >>= 1;
  const size_t need = ws_need(nbg, offs);
  if (need > ws_size) { fprintf(stderr, "workspace too small: need %zu have %zu\n", need, ws_size); return; }
  Params p{};
  const float** ins = (const float**)&p.x;
  for (int i = 0; i < 25; ++i) ins[i] = (const float*)d_in[i];
  p.out = (float*)d_out;
  unsigned char* ws = (unsigned char*)d_ws;
  p.wt_in = (bf16_t*)(ws + offs[0]); p.wt_brs = (bf16_t*)(ws + offs[1]); p.wt_bra = (bf16_t*)(ws + offs[2]);
  p.wt_o = (bf16_t*)(ws + offs[3]); p.wt_up = (bf16_t*)(ws + offs[4]); p.wt_down = (bf16_t*)(ws + offs[5]);
  p.U = (bf16_t*)(ws + offs[6]); p.KK = (bf16_t*)(ws + offs[7]); p.VT = (bf16_t*)(ws + offs[8]);
  p.H = (bf16_t*)(ws + offs[9]); p.YS = (bf16_t*)(ws + offs[10]); p.YA = (bf16_t*)(ws + offs[11]); p.MG = (bf16_t*)(ws + offs[12]);
  p.DT = (float*)(ws + offs[13]); p.ST = (float*)(ws + offs[14]); p.DEC = (float*)(ws + offs[15]); p.SSQ = (float*)(ws + offs[16]);
  p.XC = (float*)(ws + offs[17]); p.MODP = (float*)(ws + offs[18]); p.MOD = (float*)(ws + offs[19]);
  p.ROPE = (float*)(ws + offs[20]); p.LAM = (float*)(ws + offs[21]);
  p.BAR = (unsigned*)(ws + offs[22]);
  p.CSB = (float*)(ws + offs[23]);
  p.nbg = nbg; p.pad = 0;
  hipMemsetAsync(p.BAR, 0, XCD_BAR_WORDS * 4, stream);
  void* args[] = {&p};
  hipError_t e = hipLaunchCooperativeKernel((const void*)mega_fwd, dim3(grid_blocks), dim3(512), args, LDS_BYTES, stream);
  if (e != hipSuccess) fprintf(stderr, "cooperative launch failed: %s (grid %d)\n", hipGetErrorString(e), grid_blocks);
}
```
